# Optimizing an MI355X kernel written in HIP

```python
import math
import jax, jax.numpy as jnp
from jax import lax
import numpy as np

D_MODEL = 1024
BATCH = 8
SEQ = 4096
DEPTH = 1

MIX_WIDTH = D_MODEL
SGU_WIDTH = MIX_WIDTH // 2
SGU_HEADS = 4
SGU_HEAD_DIM = SGU_WIDTH // SGU_HEADS
SGU_CHUNK = 128
RET_WIDTH = MIX_WIDTH - SGU_WIDTH
RET_HEADS = 4
RET_HEAD_DIM = RET_WIDTH // RET_HEADS
RET_CHUNK = 128
ROPE_BASE = 10000.0
IN_WIDTH = 2 * SGU_WIDTH + 4 * RET_WIDTH
IN_SPLITS = (SGU_WIDTH, 2 * SGU_WIDTH, 2 * SGU_WIDTH + RET_WIDTH,
             2 * SGU_WIDTH + 2 * RET_WIDTH, 2 * SGU_WIDTH + 3 * RET_WIDTH)
PEER_HEADS = 8
PEER_N_KEYS = 128
PEER_N_EXPERTS = PEER_N_KEYS * PEER_N_KEYS
PEER_TOPK = 16
PEER_QUERY_DIM = 256
PEER_KEY_DIM = PEER_QUERY_DIM // 2
PEER_TOKEN_BLOCK = 128
LN_EPS = 1e-5
GN_EPS = 1e-5
DEEPNORM_ALPHA = (2.0 * DEPTH) ** 0.25
DEEPNORM_BETA = (8.0 * DEPTH) ** -0.25

kernel_name = "hybrid_sgu_retention_peer_deepnorm"


def _layer_norm(x, w, b):
    xf = x.astype(jnp.float32)
    mu = xf.mean(-1, keepdims=True)
    var = jnp.square(xf - mu).mean(-1, keepdims=True)
    return ((xf - mu) * lax.rsqrt(var + LN_EPS) * w + b).astype(x.dtype)


def _rotary(x):
    s, dh = x.shape[1], x.shape[-1]
    half = dh // 2
    inv = ROPE_BASE ** (-jnp.arange(half, dtype=jnp.float32) / half)
    ang = jnp.arange(s, dtype=jnp.float32)[:, None] * inv[None, :]
    cos = jnp.cos(ang)[:, None, :]
    sin = jnp.sin(ang)[:, None, :]
    x1, x2 = x[..., :half], x[..., half:]
    return jnp.concatenate([x1 * cos - x2 * sin, x1 * sin + x2 * cos], -1).astype(x.dtype)


def _spatial_gating_group(u, v, ln_w, ln_b, w_s, b_s):
    u = jax.nn.gelu(u, approximate=False)
    v = _layer_norm(jax.nn.gelu(v, approximate=False), ln_w, ln_b)
    b, s, w = v.shape
    c = s // SGU_CHUNK
    vr = v.reshape(b, c, SGU_CHUNK, SGU_HEADS, SGU_HEAD_DIM)
    mixed = jnp.einsum('hlm,bcmhd->bclhd', w_s, vr) + b_s.T[None, None, :, :, None]
    return u * mixed.reshape(b, s, w).astype(u.dtype)


def _retention_one_direction(q, k, v, log_g, include_diag):
    b, h, s, dk = q.shape
    dv = v.shape[-1]
    L = RET_CHUNK
    c = s // L
    q = q.reshape(b, h, c, L, dk)
    k = k.reshape(b, h, c, L, dk)
    v = v.reshape(b, h, c, L, dv)
    pos = jnp.arange(L, dtype=jnp.float32)
    diff = pos[:, None] - pos[None, :]
    mask = (diff >= 0) if include_diag else (diff > 0)
    decay = jnp.where(mask[None], jnp.exp(jnp.maximum(diff, 0.0)[None] * log_g[:, None, None]), 0.0)
    scores = jnp.einsum('bhcld,bhcmd->bhclm', q, k) * decay[None, :, None]
    o_inner = jnp.einsum('bhclm,bhcmv->bhclv', scores, v)
    k_w = jnp.exp((L - 1 - pos)[None, :] * log_g[:, None])
    chunk_state = jnp.einsum('bhcld,bhclv->bhcdv', k * k_w[None, :, None, :, None], v)
    g_chunk = jnp.exp(L * log_g)[:, None, None]

    def step(state, s_c):
        return g_chunk * state + s_c, state

    _, prev = lax.scan(step, jnp.zeros_like(chunk_state[:, :, 0]), jnp.moveaxis(chunk_state, 2, 0))
    prev = jnp.moveaxis(prev, 0, 2)
    q_w = jnp.exp((pos + 1.0)[None, :] * log_g[:, None])
    o_cross = jnp.einsum('bhcld,bhcdv->bhclv', q * q_w[None, :, None, :, None], prev)
    return (o_inner + o_cross).reshape(b, h, s, dv)


def _retention_group(q, k, v, g, decay_fwd, decay_bwd, gn_w):
    b, s, _ = q.shape
    out_dtype = q.dtype
    q = _rotary(q.reshape(b, s, RET_HEADS, RET_HEAD_DIM))
    k = _rotary(k.reshape(b, s, RET_HEADS, RET_HEAD_DIM)) * (RET_HEAD_DIM ** -0.5)
    v = v.reshape(b, s, RET_HEADS, RET_HEAD_DIM)
    q, k, v = (t.transpose(0, 2, 1, 3) for t in (q, k, v))
    lg_f = jax.nn.log_sigmoid(decay_fwd.astype(jnp.float32))
    lg_b = jax.nn.log_sigmoid(decay_bwd.astype(jnp.float32))
    o_f = _retention_one_direction(q, k, v, lg_f, True)
    flip = lambda t: jnp.flip(t, axis=2)
    o_b = flip(_retention_one_direction(flip(q), flip(k), flip(v), lg_b, False))
    o = (o_f + o_b).transpose(0, 2, 1, 3).astype(jnp.float32)
    mu = o.mean(-1, keepdims=True)
    var = jnp.square(o - mu).mean(-1, keepdims=True)
    on = ((o - mu) * lax.rsqrt(var + GN_EPS)).reshape(b, s, RET_WIDTH) * gn_w
    return (jax.nn.silu(g.astype(jnp.float32)) * on).astype(out_dtype)


def _peer(h, w_q, sub_keys, u_tab, v_tab):
    b, s, d = h.shape
    q = (h @ w_q).reshape(b, s, PEER_HEADS, 2, PEER_KEY_DIM)
    scores = jnp.einsum('bshpd,hpnd->bshpn', q, sub_keys)
    top_s, top_i = lax.top_k(scores, PEER_TOPK)
    cand_s = top_s[..., 0, :, None] + top_s[..., 1, None, :]
    cand_i = top_i[..., 0, :, None] * PEER_N_KEYS + top_i[..., 1, None, :]
    cand_s = cand_s.reshape(b, s, PEER_HEADS, PEER_TOPK * PEER_TOPK)
    cand_i = cand_i.reshape(b, s, PEER_HEADS, PEER_TOPK * PEER_TOPK)
    best_s, best_pos = lax.top_k(cand_s, PEER_TOPK)
    expert_idx = jnp.take_along_axis(cand_i, best_pos, axis=-1)
    gates = jax.nn.softmax(best_s.astype(jnp.float32), axis=-1)
    n_blocks = (b * s) // PEER_TOKEN_BLOCK
    n_sel = PEER_HEADS * PEER_TOPK
    xb = h.reshape(n_blocks, PEER_TOKEN_BLOCK, d)
    ib = expert_idx.reshape(n_blocks, PEER_TOKEN_BLOCK, n_sel)
    gb = gates.reshape(n_blocks, PEER_TOKEN_BLOCK, n_sel).astype(h.dtype)

    def block(args):
        xt, it, gt = args
        act = jax.nn.gelu(jnp.einsum('td,ted->te', xt, u_tab[it]), approximate=False)
        return jnp.einsum('te,ted->td', gt * act, v_tab[it])

    out = lax.map(block, (xb, ib, gb))
    return out.reshape(b, s, d)


def setup_inputs(seed: int = 0) -> dict:
    key = jax.random.key(seed)
    ks = jax.random.split(key, 20)
    f32 = jnp.float32
    nrm = lambda k, shape, scale: jax.random.normal(k, shape, f32) * scale
    base_decay = jnp.asarray(np.log(2.0 ** (5.0 + np.arange(RET_HEADS)) - 1.0), f32)
    return {
        "x": jax.random.normal(ks[0], (BATCH, SEQ, D_MODEL), f32),
        "w_in": nrm(ks[1], (DEPTH, D_MODEL, IN_WIDTH), D_MODEL ** -0.5),
        "sgu_ln_w": 1.0 + nrm(ks[2], (DEPTH, SGU_WIDTH), 0.02),
        "sgu_ln_b": nrm(ks[3], (DEPTH, SGU_WIDTH), 0.02),
        "sgu_w_s": nrm(ks[4], (DEPTH, SGU_HEADS, SGU_CHUNK, SGU_CHUNK), SGU_CHUNK ** -0.5),
        "sgu_b": 1.0 + nrm(ks[5], (DEPTH, SGU_HEADS, SGU_CHUNK), 0.02),
        "ret_decay_fwd": base_decay[None] + nrm(ks[6], (DEPTH, RET_HEADS), 0.05),
        "ret_decay_bwd": base_decay[None] + nrm(ks[7], (DEPTH, RET_HEADS), 0.05),
        "ret_gn_w": 1.0 + nrm(ks[8], (DEPTH, RET_WIDTH), 0.02),
        "w_out": nrm(ks[9], (DEPTH, MIX_WIDTH, D_MODEL), DEEPNORM_BETA * MIX_WIDTH ** -0.5),
        "ln1_w": 1.0 + nrm(ks[10], (DEPTH, D_MODEL), 0.02),
        "ln1_b": nrm(ks[11], (DEPTH, D_MODEL), 0.02),
        "peer_w_q": nrm(ks[12], (DEPTH, D_MODEL, PEER_HEADS * PEER_QUERY_DIM), D_MODEL ** -0.5),
        "peer_sub_keys": nrm(ks[13], (DEPTH, PEER_HEADS, 2, PEER_N_KEYS, PEER_KEY_DIM), PEER_KEY_DIM ** -0.5),
        "peer_u": nrm(ks[14], (DEPTH, PEER_N_EXPERTS, D_MODEL), D_MODEL ** -0.5),
        "peer_v": nrm(ks[15], (DEPTH, PEER_N_EXPERTS, D_MODEL), DEEPNORM_BETA),
        "ln2_w": 1.0 + nrm(ks[16], (DEPTH, D_MODEL), 0.02),
        "ln2_b": nrm(ks[17], (DEPTH, D_MODEL), 0.02),
    }


def reference(x, w_in, sgu_ln_w, sgu_ln_b, sgu_w_s, sgu_b, ret_decay_fwd, ret_decay_bwd, ret_gn_w,
              w_out, ln1_w, ln1_b, peer_w_q, peer_sub_keys, peer_u, peer_v, ln2_w, ln2_b):
    for l in range(DEPTH):
        proj = x @ w_in[l]
        a_u, a_v, r_q, r_k, r_v, r_g = jnp.split(proj, IN_SPLITS, axis=-1)
        a_out = _spatial_gating_group(a_u, a_v, sgu_ln_w[l], sgu_ln_b[l], sgu_w_s[l], sgu_b[l])
        r_out = _retention_group(r_q, r_k, r_v, r_g, ret_decay_fwd[l], ret_decay_bwd[l], ret_gn_w[l])
        mixed = jnp.concatenate([a_out, r_out], axis=-1) @ w_out[l]
        h = _layer_norm(DEEPNORM_ALPHA * x + mixed, ln1_w[l], ln1_b[l])
        ffn = _peer(h, peer_w_q[l], peer_sub_keys[l], peer_u[l], peer_v[l])
        x = _layer_norm(DEEPNORM_ALPHA * h + ffn, ln2_w[l], ln2_b[l])
    return x
```

```cpp
#include <hip/hip_runtime.h>
#include <cstdio>
#include <cstdint>
#include <cmath>
namespace pg8 {
#define PG8_LAS __attribute__((address_space(3)))
typedef unsigned short bf16_t;
typedef short bf16x8 __attribute__((ext_vector_type(8)));
typedef float f32x4 __attribute__((ext_vector_type(4)));
typedef unsigned u32x4 __attribute__((ext_vector_type(4)));
constexpr int BM = 256, BK = 64, HALF = 128, HTB = HALF * BK * 2  , STAGE_BYTES = 8 * HTB, NXCD = 8, WGM = 8;

__host__ __device__ __forceinline__ int lds_byte(int r, int c) { const int st = (r >> 4) * 2 + (c >> 5), rr = r & 15, cc = c & 31, ob = rr * 64 + cc * 2; return st * 1024 + (ob ^ (((ob >> 9) & 1) << 5)); }
__host__ __device__ __forceinline__ void stage_rc(int b, int& R, int& C) { const int st = b / 1024, sb = b % 1024, swz = sb ^ (((sb >> 9) & 1) << 5); R = (st >> 1) * 16 + swz / 64; C = (st & 1) * 32 + (swz % 64) / 2; }
__host__ __device__ __forceinline__ int perm32(int rho) { const int n = rho >> 4, i = rho & 15; return 8 * (i >> 2) + 4 * n + (i & 3); }

struct Unit { int pm, pn; };
struct Gemm { const bf16_t* A; const bf16_t* Bt; int M, N, K; };

struct StaticOrder {
    int nM, nN, nwg, G, c;
    __host__ __device__ void init(int M, int N, int G_, int c_) { nM = M / BM; nN = N / BM; nwg = nM * nN; G = G_; c = c_; }
    __host__ __device__ bool next(int i, Unit& u) const {
        const long L = (long)i * G + c; if (L >= nwg) return false;
        int wgid = (int)L; { const int q = nwg / NXCD, r = nwg % NXCD, xcd = wgid % NXCD, off = wgid / NXCD; wgid = (xcd < r ? xcd * (q + 1) : r * (q + 1) + (xcd - r) * q) + off; }
        const int nig = WGM * nN, gid = wgid / nig, fm = gid * WGM, gsz = (nM - fm) < WGM ? (nM - fm) : WGM;
        u.pm = fm + ((wgid % nig) % gsz); u.pn = (wgid % nig) / gsz; return true;
    }
    __device__ __forceinline__ void a_ready(const Unit&) const {}
    __device__ __forceinline__ void done(const Unit&) const {}
};

__device__ __forceinline__ unsigned cvt_pk_bf16(float lo, float hi) { unsigned r; asm volatile("v_cvt_pk_bf16_f32 %0, %1, %2" : "=v"(r) : "v"(lo), "v"(hi)); return r; }
typedef float f32x2 __attribute__((ext_vector_type(2)));
__device__ __forceinline__ f32x2 gelu_pk(f32x2 v) {
    const f32x2 av = __builtin_elementwise_abs(v), d = av * 0.2316418882f + 1.0f;
    f32x2 t; t.x = __builtin_amdgcn_rcpf(d.x); t.y = __builtin_amdgcn_rcpf(d.y);
    f32x2 q = t * 0.5307027145f + (-0.7265760135f); q = q * t + 0.7107068705f; q = q * t + (-0.142248368f); q = q * t + 0.127414796f; q = q * t;
    const f32x2 s = (v * v) * (-0.72134752044f);
    f32x2 e; e.x = __builtin_amdgcn_exp2f(s.x); e.y = __builtin_amdgcn_exp2f(s.y);
    const f32x2 m = v * (q * e), r = v - m;
    f32x2 o; o.x = v.x < 0.f ? m.x : r.x; o.y = v.y < 0.f ? m.y : r.y; return o;
}

__device__ __forceinline__ float silu_f(float v) { return v * __builtin_amdgcn_rcpf(1.0f + __expf(-v)); }
struct EpiProj {
    static constexpr bool PERM = true, AFTER_DRAIN = false;
    bf16_t* O; const float* rope;
    __device__ __forceinline__ void operator()(const f32x4 (&acc)[2][2][4][2], const Unit& u, int wr, int wc, int fr, int fq) const {
        const int sec = u.pn >> 1;
        const int row0 = u.pm * BM + wr * 64 + fr, col0 = u.pn * BM + wc * 32 + 8 * fq;
        const int i0 = wc * 16 + 4 * fq;
#pragma unroll
        for (int ai = 0; ai < 2; ++ai)
#pragma unroll
            for (int m = 0; m < 4; ++m) {
                const int row = row0 + ai * HALF + m * 16;
                bf16_t* rowp = O + (size_t)row * 3072 + col0;
                f32x4 r0 = (f32x4){1.f, 0.f, 1.f, 0.f}, r1 = r0;
                if (sec == 2 || sec == 3) { const f32x4* rp = (const f32x4*)(rope + ((size_t)(row & 4095) * 64 + i0) * 2); r0 = rp[0]; r1 = rp[1]; }
#pragma unroll
                for (int bj = 0; bj < 2; ++bj) {
                    f32x4 v0 = acc[ai][bj][m][0], v1 = acc[ai][bj][m][1];
                    if (sec <= 1) {
                        f32x2 a = gelu_pk((f32x2){v0[0], v0[1]}), b = gelu_pk((f32x2){v0[2], v0[3]}), c = gelu_pk((f32x2){v1[0], v1[1]}), d = gelu_pk((f32x2){v1[2], v1[3]});
                        v0 = (f32x4){a.x, a.y, b.x, b.y}; v1 = (f32x4){c.x, c.y, d.x, d.y};
                    } else if (sec <= 3) {
                        const float sc = (sec == 3) ? 0.08838834764831845f : 1.0f;
                        f32x4 w0, w1;
                        w0[0] = (v0[0] * r0[0] - v0[1] * r0[1]) * sc; w0[1] = (v0[0] * r0[1] + v0[1] * r0[0]) * sc;
                        w0[2] = (v0[2] * r0[2] - v0[3] * r0[3]) * sc; w0[3] = (v0[2] * r0[3] + v0[3] * r0[2]) * sc;
                        w1[0] = (v1[0] * r1[0] - v1[1] * r1[1]) * sc; w1[1] = (v1[0] * r1[1] + v1[1] * r1[0]) * sc;
                        w1[2] = (v1[2] * r1[2] - v1[3] * r1[3]) * sc; w1[3] = (v1[2] * r1[3] + v1[3] * r1[2]) * sc;
                        v0 = w0; v1 = w1;
                    } else if (sec == 5) {
#pragma unroll
                        for (int j = 0; j < 4; ++j) { v0[j] = silu_f(v0[j]); v1[j] = silu_f(v1[j]); }
                    }
                    u32x4 w; w.x = cvt_pk_bf16(v0[0], v0[1]); w.y = cvt_pk_bf16(v0[2], v0[3]); w.z = cvt_pk_bf16(v1[0], v1[1]); w.w = cvt_pk_bf16(v1[2], v1[3]);
                    *(u32x4*)(rowp + bj * HALF) = w;
                }
            }
    }
};
struct EpiPlainBf16 {
    static constexpr bool PERM = true, AFTER_DRAIN = false;
    bf16_t* O; int ldc;
    __device__ __forceinline__ void operator()(const f32x4 (&acc)[2][2][4][2], const Unit& u, int wr, int wc, int fr, int fq) const {
        const int row0 = u.pm * BM + wr * 64 + fr, col0 = u.pn * BM + wc * 32 + 8 * fq;
#pragma unroll
        for (int ai = 0; ai < 2; ++ai)
#pragma unroll
            for (int m = 0; m < 4; ++m) { bf16_t* rowp = O + (size_t)(row0 + ai * HALF + m * 16) * ldc + col0;
#pragma unroll
                for (int bj = 0; bj < 2; ++bj) { const f32x4 v0 = acc[ai][bj][m][0], v1 = acc[ai][bj][m][1];
                    u32x4 w; w.x = cvt_pk_bf16(v0[0], v0[1]); w.y = cvt_pk_bf16(v0[2], v0[3]); w.z = cvt_pk_bf16(v1[0], v1[1]); w.w = cvt_pk_bf16(v1[2], v1[3]);
                    *(u32x4*)(rowp + bj * HALF) = w; } }
    }
};
struct EpiResF32 {
    static constexpr bool PERM = false, AFTER_DRAIN = false;
    const float* X; float* Z; int ldc; float alpha;
    __device__ __forceinline__ void operator()(const f32x4 (&acc)[2][2][4][2], const Unit& u, int wr, int wc, int fr, int fq) const {
        const int row0 = u.pm * BM + wr * 64 + fr, col0 = u.pn * BM + wc * 32 + 4 * fq;
#pragma unroll
        for (int ai = 0; ai < 2; ++ai)
#pragma unroll
            for (int m = 0; m < 4; ++m) { const size_t off = (size_t)(row0 + ai * HALF + m * 16) * ldc + col0;
#pragma unroll
                for (int bj = 0; bj < 2; ++bj)
#pragma unroll
                    for (int n = 0; n < 2; ++n) { const f32x4 xv = *(const f32x4*)(X + off + bj * HALF + n * 16); *(f32x4*)(Z + off + bj * HALF + n * 16) = acc[ai][bj][m][n] + xv * alpha; } }
    }
};
template <class Epi, class Sched, bool ALIGN_EPI = false, bool SP2 = false>
__device__ __forceinline__ void gemm_phase(PG8_LAS unsigned char* lds, const Gemm g, const Sched& S, const Epi& E) {
    const int tid = threadIdx.x, wid = __builtin_amdgcn_readfirstlane(tid >> 6), lane = tid & 63, wr = wid >> 2, wc = wid & 3, fr = lane & 15, fq = lane >> 4;
    const int K = g.K, nt = K / BK;
    unsigned voffA[2], voffB[2];
#pragma unroll
    for (int i = 0; i < 2; ++i) { int R, C; stage_rc(tid * 16 + i * 8192, R, C); const int Rb = Epi::PERM ? ((R & ~31) + perm32(R & 31)) : R;
        voffA[i] = (unsigned)(R * K + C) * 2u; voffB[i] = (unsigned)(Rb * K + C) * 2u; }
    const size_t kstep = (size_t)(BK * 2);
    const size_t hstep = (size_t)HALF * K * 2;
    const size_t tstep = 2 * hstep;
    const unsigned ldsw = (unsigned)wid * 1024u;
    const int aoff = lds_byte(wr * 64 + fr, fq * 8), boff = lds_byte(wc * 32 + fr, fq * 8);
#define PG8_SA(b, h) (((b) * 2 + (h)) * HTB)
#define PG8_SB(b, h) ((4 + (b) * 2 + (h)) * HTB)
#define PG8_STAGE(bufoff, gbase, voff) do { _Pragma("unroll") for (int _i = 0; _i < 2; ++_i) \
        __builtin_amdgcn_global_load_lds((const unsigned*)((const char*)(gbase) + (voff)[_i]), (PG8_LAS unsigned*)(lds + (bufoff) + ldsw + _i * 8192), 16, 0, 0); } while (0)
#define PG8_LDA(dst, b, h) do { _Pragma("unroll") for (int m = 0; m < 4; ++m) _Pragma("unroll") for (int k = 0; k < 2; ++k) dst[m][k] = *(const PG8_LAS bf16x8*)(lds + PG8_SA(b, h) + aoff + m * 2048 + k * 1024); } while (0)
#define PG8_LDB(dst, b, h) do { _Pragma("unroll") for (int n = 0; n < 2; ++n) _Pragma("unroll") for (int k = 0; k < 2; ++k) dst[n][k] = *(const PG8_LAS bf16x8*)(lds + PG8_SB(b, h) + boff + n * 2048 + k * 1024); } while (0)
#define PG8_MMA(ai, bj, At, Bt) do { __builtin_amdgcn_s_setprio(1); _Pragma("unroll") for (int m = 0; m < 4; ++m) _Pragma("unroll") for (int n = 0; n < 2; ++n) _Pragma("unroll") for (int k = 0; k < 2; ++k) \
        acc[ai][bj][m][n] = __builtin_amdgcn_mfma_f32_16x16x32_bf16(Bt[n][k], At[m][k], acc[ai][bj][m][n], 0, 0, 0); __builtin_amdgcn_s_setprio(0); } while (0)
#define PG8_WAIT_V(n) asm volatile("s_waitcnt vmcnt(" #n ")" ::: "memory")
#define PG8_WAIT_L(n) asm volatile("s_waitcnt lgkmcnt(" #n ")" ::: "memory")
#define PG8_BAR __builtin_amdgcn_s_barrier()
#define PG8_SCHED __builtin_amdgcn_sched_barrier(0)
    Unit cur, nxt; int ui = 0;
    if (!S.next(0, cur)) return;
    f32x4 acc[2][2][4][2];
#pragma unroll
    for (int a = 0; a < 2; ++a)
#pragma unroll
        for (int b = 0; b < 2; ++b)
#pragma unroll
            for (int m = 0; m < 4; ++m)
#pragma unroll
                for (int n = 0; n < 2; ++n) acc[a][b][m][n] = (f32x4){0.f, 0.f, 0.f, 0.f};
    bf16x8 At[4][2], B0[2][2], B1[2][2];
    const char* cA = (const char*)g.A + (size_t)cur.pm * tstep; const char* cB = (const char*)g.Bt + (size_t)cur.pn * tstep;
    S.a_ready(cur);
    if constexpr (SP2) {
        PG8_STAGE(PG8_SB(0, 0), cB, voffB); PG8_STAGE(PG8_SB(0, 1), cB + hstep, voffB); PG8_STAGE(PG8_SA(0, 0), cA, voffA); PG8_STAGE(PG8_SA(0, 1), cA + hstep, voffA);
        if (wr == 1) PG8_BAR;
        PG8_WAIT_V(2); PG8_BAR;
        PG8_STAGE(PG8_SB(1, 0), cB + kstep, voffB); PG8_STAGE(PG8_SA(1, 0), cA + kstep, voffA); PG8_STAGE(PG8_SB(1, 1), cB + hstep + kstep, voffB);
        PG8_WAIT_V(6); PG8_BAR;
    } else {
        PG8_STAGE(PG8_SB(0, 0), cB, voffB); PG8_STAGE(PG8_SA(0, 0), cA, voffA); PG8_STAGE(PG8_SB(0, 1), cB + hstep, voffB); PG8_STAGE(PG8_SA(0, 1), cA + hstep, voffA);
        if (wr == 1) PG8_BAR;
        PG8_WAIT_V(4); PG8_BAR;
        PG8_STAGE(PG8_SB(1, 0), cB + kstep, voffB); PG8_STAGE(PG8_SA(1, 0), cA + kstep, voffA); PG8_STAGE(PG8_SB(1, 1), cB + hstep + kstep, voffB);
        PG8_WAIT_V(6); PG8_BAR;
    }
    for (;;) {
        const bool has_next = S.next(ui + 1, nxt);
        const char* nA = has_next ? (const char*)g.A + (size_t)nxt.pm * tstep : cA; const char* nB = has_next ? (const char*)g.Bt + (size_t)nxt.pn * tstep : cB;
        for (int t = 0; t < nt; t += 2) {
            const bool last = (t == nt - 2);
            const char* a1 = cA + (size_t)(t + 1) * kstep;
            const char* a2 = last ? nA : cA + (size_t)(t + 2) * kstep; const char* b2 = last ? nB : cB + (size_t)(t + 2) * kstep;
            const char* a3 = a2 + kstep; const char* b3 = b2 + kstep;
            if (last && has_next) S.a_ready(nxt);
            if constexpr (SP2) {
            PG8_LDB(B0, 0, 0); PG8_LDB(B1, 0, 1); PG8_SCHED; PG8_LDA(At, 0, 0); PG8_STAGE(PG8_SA(1, 1), a1 + hstep, voffA);
            PG8_WAIT_V(8); PG8_WAIT_L(0); PG8_BAR; PG8_MMA(0, 0, At, B0); PG8_MMA(0, 1, At, B1); PG8_BAR; PG8_SCHED;
            PG8_LDA(At, 0, 1); PG8_STAGE(PG8_SB(0, 0), b2, voffB); PG8_STAGE(PG8_SB(0, 1), b2 + hstep, voffB); PG8_STAGE(PG8_SA(0, 0), a2, voffA);
            PG8_WAIT_V(8); PG8_WAIT_L(0); PG8_BAR; PG8_MMA(1, 0, At, B0); PG8_MMA(1, 1, At, B1); PG8_BAR; PG8_SCHED;
            PG8_LDB(B0, 1, 0); PG8_LDB(B1, 1, 1); PG8_SCHED; PG8_LDA(At, 1, 0); PG8_STAGE(PG8_SA(0, 1), a2 + hstep, voffA);
            PG8_WAIT_V(8); PG8_WAIT_L(0); PG8_BAR; PG8_MMA(0, 0, At, B0); PG8_MMA(0, 1, At, B1); PG8_BAR; PG8_SCHED;
            PG8_LDA(At, 1, 1); PG8_STAGE(PG8_SB(1, 0), b3, voffB); PG8_STAGE(PG8_SB(1, 1), b3 + hstep, voffB); PG8_STAGE(PG8_SA(1, 0), a3, voffA);
            PG8_WAIT_V(8); PG8_WAIT_L(0); PG8_BAR; PG8_MMA(1, 0, At, B0); PG8_MMA(1, 1, At, B1); PG8_BAR; PG8_SCHED;
            } else {
            PG8_LDB(B0, 0, 0); PG8_SCHED; PG8_LDA(At, 0, 0); PG8_STAGE(PG8_SA(1, 1), a1 + hstep, voffA);
            PG8_WAIT_L(8); PG8_BAR; PG8_WAIT_L(0); PG8_MMA(0, 0, At, B0); PG8_BAR; PG8_SCHED;
            PG8_LDB(B1, 0, 1); PG8_STAGE(PG8_SB(0, 0), b2, voffB);
            PG8_BAR; PG8_WAIT_L(0); PG8_MMA(0, 1, At, B1); PG8_BAR;
            PG8_LDA(At, 0, 1); PG8_STAGE(PG8_SA(0, 0), a2, voffA);
            PG8_BAR; PG8_WAIT_L(0); PG8_MMA(1, 0, At, B0); PG8_BAR; PG8_SCHED;
            PG8_STAGE(PG8_SB(0, 1), b2 + hstep, voffB);
            PG8_WAIT_V(6); PG8_BAR; PG8_MMA(1, 1, At, B1); PG8_BAR;
            PG8_LDB(B0, 1, 0); PG8_SCHED; PG8_LDA(At, 1, 0); PG8_STAGE(PG8_SA(0, 1), a2 + hstep, voffA);
            PG8_WAIT_L(8); PG8_BAR; PG8_WAIT_L(0); PG8_MMA(0, 0, At, B0); PG8_BAR; PG8_SCHED;
            PG8_LDB(B1, 1, 1); PG8_STAGE(PG8_SB(1, 0), b3, voffB);
            PG8_BAR; PG8_WAIT_L(0); PG8_MMA(0, 1, At, B1); PG8_BAR;
            PG8_LDA(At, 1, 1); PG8_STAGE(PG8_SA(1, 0), a3, voffA);
            PG8_BAR; PG8_WAIT_L(0); PG8_MMA(1, 0, At, B0); PG8_BAR; PG8_SCHED;
            PG8_STAGE(PG8_SB(1, 1), b3 + hstep, voffB);
            PG8_WAIT_V(6); PG8_BAR; PG8_MMA(1, 1, At, B1); PG8_BAR;
            }
        }
        if constexpr (ALIGN_EPI) { if (wr == 0) PG8_BAR; }
        if constexpr (!Epi::AFTER_DRAIN) { E(acc, cur, wr, wc, fr, fq); S.done(cur); }
        if (!has_next) break;
#pragma unroll
        for (int a = 0; a < 2; ++a)
#pragma unroll
            for (int b = 0; b < 2; ++b)
#pragma unroll
                for (int m = 0; m < 4; ++m)
#pragma unroll
                    for (int n = 0; n < 2; ++n) acc[a][b][m][n] = (f32x4){0.f, 0.f, 0.f, 0.f};
        cur = nxt; cA = nA; cB = nB; ++ui;
        if constexpr (ALIGN_EPI) { if (wr == 1) PG8_BAR; }
    }
    PG8_WAIT_V(0);
    if constexpr (!ALIGN_EPI) { if (wr == 0) PG8_BAR; }
    PG8_BAR;
    if constexpr (Epi::AFTER_DRAIN) { E.fused(acc, cur, wr, wc, fr, fq, lds, wid, lane); S.done(cur); }
#undef PG8_SA
#undef PG8_SB
#undef PG8_STAGE
#undef PG8_LDA
#undef PG8_LDB
#undef PG8_MMA
#undef PG8_WAIT_V
#undef PG8_WAIT_L
#undef PG8_BAR
#undef PG8_SCHED
}
}
constexpr int NWAVES = 8, NTHREADS = 512;
constexpr int BATCH = 8, SEQ = 4096, D = 1024, M = BATCH * SEQ;
constexpr int INW = 3072;
constexpr int NCHUNK = M / 128;
constexpr int PEER_H = 8, PEER_K = 16, NSEL = 128, NEXP = 16384;
constexpr float LN_EPS = 1e-5f, GN_EPS = 1e-5f;
constexpr float ALPHA = 1.189207115002721f;

constexpr size_t MiB = 1u << 20;
constexpr size_t WS_CTL = 0, CTL_ZERO_BYTES = 1 * MiB;
constexpr size_t WS_SKB = 1 * MiB;
constexpr size_t WS_WSB = 1 * MiB + 512 * 1024;
constexpr size_t WS_ROPE = 2 * MiB;
constexpr size_t WS_WIN = 4 * MiB;
constexpr size_t WS_WOUT = 10 * MiB;
constexpr size_t WS_WQ = 12 * MiB;
constexpr size_t WS_UT = 16 * MiB;
constexpr size_t WS_VT = 48 * MiB;
constexpr size_t WS_PROJ = 80 * MiB;
constexpr size_t WS_Z = 80 * MiB;
constexpr size_t WS_IDX = 80 * MiB;
constexpr size_t WS_GATE = 96 * MiB;
constexpr size_t WS_H = 208 * MiB;
constexpr size_t WS_XB = 272 * MiB;
constexpr size_t WS_Y = 272 * MiB;
constexpr size_t WS_ST = 336 * MiB;
constexpr size_t WS_PREV = 400 * MiB;
constexpr size_t WS_QP = 336 * MiB;
constexpr size_t WS_END = 464 * MiB;

constexpr int LDS_BYTES = 147456;

#define GAS __attribute__((address_space(1)))
#define LAS __attribute__((address_space(3)))
typedef unsigned short bf16;
typedef unsigned v4u __attribute__((ext_vector_type(4)));
typedef float f32x4 __attribute__((ext_vector_type(4)));

__device__ __forceinline__ unsigned f2bf(float f) { unsigned u = __builtin_bit_cast(unsigned, f); return (u + 0x7fffu + ((u >> 16) & 1u)) >> 16; }
__device__ __forceinline__ unsigned pk2(float lo, float hi) { return f2bf(lo) | (f2bf(hi) << 16); }
__device__ __forceinline__ float bf2f(unsigned short b) { return __builtin_bit_cast(float, (unsigned)b << 16); }
__device__ __forceinline__ float bflo(unsigned w) { return __builtin_bit_cast(float, w << 16); }
__device__ __forceinline__ float bfhi(unsigned w) { return __builtin_bit_cast(float, w & 0xffff0000u); }
__device__ __forceinline__ float wave_sum(float v) {
#pragma unroll
    for (int o = 1; o < 64; o <<= 1) v += __shfl_xor(v, o);
    return v;
}
__device__ __forceinline__ float gelu_exact(float v) { return 0.5f * v * (1.0f + erff(v * 0.70710678118654752f)); }
__device__ __forceinline__ float log_sigmoid_f(float x) { return -log1pf(expf(-x)); }

struct Args {
    const float* in[18]; float* out; unsigned char* ws; int ph_lo, ph_hi;
};

template <int MODE>
__device__ __forceinline__ int dst_row(int n) {
    if (MODE == 1 && n >= 1024 && n < 2048) { const int j = n & 127; return (n & ~127) + ((j < 64) ? 2 * j : 2 * (j - 64) + 1); }
    return n;
}
template <int MODE>
__device__ __forceinline__ void p0_transpose_item(const float* W, int K, int N, bf16* WT, LAS float* scr, int item, int lane) {
    const int nblk = N / 32, kb = item / nblk, nb = item % nblk, k0 = 64 * kb, n0 = 32 * nb;
#pragma unroll 8
    for (int i = 0; i < 32; ++i) { const int kk = 2 * i + (lane >> 5); scr[kk * 33 + (lane & 31)] = W[(size_t)(k0 + kk) * N + n0 + (lane & 31)]; }
    asm volatile("s_waitcnt lgkmcnt(0)" ::: "memory");
    const int c = lane & 7;
#pragma unroll
    for (int j = 0; j < 4; ++j) { const int n = (lane >> 3) + 8 * j; const LAS float* s = scr + (8 * c) * 33 + n;
        v4u o; o.x = pk2(s[0 * 33], s[1 * 33]); o.y = pk2(s[2 * 33], s[3 * 33]); o.z = pk2(s[4 * 33], s[5 * 33]); o.w = pk2(s[6 * 33], s[7 * 33]);
        *(GAS v4u*)(WT + (size_t)dst_row<MODE>(n0 + n) * K + k0 + 8 * c) = o; }
    asm volatile("s_waitcnt lgkmcnt(0)" ::: "memory");
}
__device__ __forceinline__ void p0_convert(const float* src, bf16* dst, size_t n8, size_t gt, size_t ngt) {
    for (size_t i = gt; i < n8; i += ngt) {
        const f32x4 a = *(const f32x4*)(src + i * 8), b = *(const f32x4*)(src + i * 8 + 4);
        v4u o; o.x = pk2(a[0], a[1]); o.y = pk2(a[2], a[3]); o.z = pk2(b[0], b[1]); o.w = pk2(b[2], b[3]);
        *(v4u*)(dst + i * 8) = o;
    }
}

template <int PH_LO, int PH_HI>
__global__ void __launch_bounds__(NTHREADS, 2) fwd_kernel(Args args) {
    extern __shared__ __attribute__((aligned(16))) unsigned char lds_raw[];
    LAS unsigned char* lds = (LAS unsigned char*)lds_raw;
    LAS float* sm = (LAS float*)lds_raw;
    const int tid = threadIdx.x, lane = tid & 63, wave = __builtin_amdgcn_readfirstlane(tid >> 6);
    const int G = gridDim.x, bx = blockIdx.x;
    const int gw = bx * NWAVES + wave, NGW = G * NWAVES;
    const size_t gt = (size_t)bx * NTHREADS + tid, ngt = (size_t)G * NTHREADS;
    unsigned char* ws = args.ws;
    const float* x = args.in[0];
    bf16* SKB = (bf16*)(ws + WS_SKB); bf16* WSB = (bf16*)(ws + WS_WSB); float* ROPE = (float*)(ws + WS_ROPE);
    bf16* WIN = (bf16*)(ws + WS_WIN); bf16* WOUT = (bf16*)(ws + WS_WOUT); bf16* WQ = (bf16*)(ws + WS_WQ);
    bf16* UT = (bf16*)(ws + WS_UT); bf16* VT = (bf16*)(ws + WS_VT);
    bf16* PROJ = (bf16*)(ws + WS_PROJ); float* Z = (float*)(ws + WS_Z); int* IDX = (int*)(ws + WS_IDX); float* GATE = (float*)(ws + WS_GATE);
    bf16* H = (bf16*)(ws + WS_H); bf16* XB = (bf16*)(ws + WS_XB); bf16* Y = (bf16*)(ws + WS_Y);
    bf16* ST = (bf16*)(ws + WS_ST); bf16* PREV = (bf16*)(ws + WS_PREV); bf16* QP = (bf16*)(ws + WS_QP);
#define IN(k) (PH_LO <= (k) && (k) < PH_HI)

    if constexpr (IN(0)) {
        LAS float* scr = sm + wave * 4096;
        constexpr int I_IN = (D / 64) * (INW / 32), I_OUT = (D / 64) * (D / 32), I_Q = (D / 64) * (2048 / 32);
        for (int it = gw; it < I_IN + I_OUT + I_Q; it += NGW) {
            int r = it;
            if (r < I_IN) { p0_transpose_item<1>(args.in[1], D, INW, WIN, scr, r, lane); continue; } r -= I_IN;
            if (r < I_OUT) { p0_transpose_item<0>(args.in[9], D, D, WOUT, scr, r, lane); continue; } r -= I_OUT;
            p0_transpose_item<0>(args.in[12], D, 2048, WQ, scr, r, lane);
        }
        p0_convert(args.in[13], SKB, (size_t)8 * 2 * 128 * 128 / 8, gt, ngt);
        p0_convert(args.in[4], WSB, (size_t)4 * 128 * 128 / 8, gt, ngt);
        p0_convert(args.in[14], UT, (size_t)NEXP * D / 8, gt, ngt);
        p0_convert(args.in[15], VT, (size_t)NEXP * D / 8, gt, ngt);
        p0_convert(x, XB, (size_t)M * D / 8, gt, ngt);
        for (size_t i = gt; i < (size_t)4096 * 64; i += ngt) {
            const int pos = (int)(i >> 6), k = (int)(i & 63);
            const float inv = powf(10000.0f, -(float)k / 64.0f);
            const float ang = (float)pos * inv;
            ROPE[i * 2] = cosf(ang); ROPE[i * 2 + 1] = sinf(ang);
        }
    }

    if constexpr (IN(1)) {
        pg8::Gemm g{XB, WIN, M, INW, D}; pg8::StaticOrder S; S.init(M, INW, G, bx);
        pg8::EpiProj E{PROJ, ROPE};
        pg8::gemm_phase<pg8::EpiProj, pg8::StaticOrder, true, true>(lds, g, S, E);
    }

    if constexpr (IN(2)) {
        const float* lnw = args.in[2]; const float* lnb = args.in[3]; const float* wsf = args.in[4]; const float* bs = args.in[5];
        for (int ck = bx; ck < NCHUNK; ck += G) {
            const int t0 = ck * 128, bb = ck >> 5, cc = ck & 31;
            LAS float* stat = sm + 16384;
            for (int r = wave * 16; r < wave * 16 + 16; ++r) {
                const v4u raw = *(const v4u*)(PROJ + (size_t)(t0 + r) * INW + 512 + lane * 8);
                float v[8] = {bflo(raw.x), bfhi(raw.x), bflo(raw.y), bfhi(raw.y), bflo(raw.z), bfhi(raw.z), bflo(raw.w), bfhi(raw.w)};
                float s = 0.f;
#pragma unroll
                for (int j = 0; j < 8; ++j) s += v[j];
                const float mean = wave_sum(s) * (1.0f / 512.0f);
                float q = 0.f;
#pragma unroll
                for (int j = 0; j < 8; ++j) { const float d = v[j] - mean; q += d * d; }
                const float rstd = 1.0f / sqrtf(wave_sum(q) * (1.0f / 512.0f) + LN_EPS);
                if (lane == 0) { stat[r * 2] = mean; stat[r * 2 + 1] = rstd; }
            }
            __syncthreads();
#pragma unroll 1
            for (int h = 0; h < 4; ++h) {
                for (int i = tid; i < 16384; i += NTHREADS) {
                    const int m = i >> 7, d = i & 127, col = h * 128 + d;
                    const float v = bf2f(PROJ[(size_t)(t0 + m) * INW + 512 + col]);
                    sm[i] = (v - stat[m * 2]) * stat[m * 2 + 1] * lnw[col] + lnb[col];
                }
                __syncthreads();
                {
                    const int d = tid & 127, lg = tid >> 7;
#pragma unroll 1
                    for (int ps = 0; ps < 4; ++ps) {
                        const int l0 = lg * 32 + ps * 8;
                        float acc[8];
#pragma unroll
                        for (int li = 0; li < 8; ++li) acc[li] = 0.f;
#pragma unroll 2
                        for (int m = 0; m < 128; ++m) {
                            const float vv = sm[m * 128 + d];
#pragma unroll
                            for (int li = 0; li < 8; ++li) acc[li] += wsf[((size_t)h * 128 + l0 + li) * 128 + m] * vv;
                        }
#pragma unroll
                        for (int li = 0; li < 8; ++li) {
                            const int l = l0 + li;
                            const float mixed = acc[li] + bs[h * 128 + l];
                            const float uu = bf2f(PROJ[(size_t)(t0 + l) * INW + h * 128 + d]);
                            Y[(size_t)(t0 + l) * D + h * 128 + d] = (bf16)f2bf(uu * mixed);
                        }
                    }
                }
                __syncthreads();
            }
#pragma unroll 1
            for (int h = 0; h < 4; ++h) {
                LAS float* Kt = sm; LAS float* Vt = sm + 16384;
                for (int i = tid; i < 16384; i += NTHREADS) {
                    const int l = i >> 7, d = i & 127;
                    Kt[i] = bf2f(PROJ[(size_t)(t0 + l) * INW + 1536 + h * 128 + d]);
                    Vt[i] = bf2f(PROJ[(size_t)(t0 + l) * INW + 2048 + h * 128 + d]);
                }
                {
                    const float lgf = log_sigmoid_f(args.in[6][h]), lgb = log_sigmoid_f(args.in[7][h]);
                    if (tid < 128) { sm[32768 + tid] = expf((float)(127 - tid) * lgf); sm[32768 + 128 + tid] = expf((float)tid * lgb); }
                }
                __syncthreads();
                const int dk = tid & 127, g4 = tid >> 7;
                const size_t u0 = (size_t)((bb * 4 + h) * 32 + cc) * 16384;
#pragma unroll 1
                for (int ps = 0; ps < 4; ++ps) {
                    const int dv0 = g4 * 32 + ps * 8;
                    float af[8], ab[8];
#pragma unroll
                    for (int j = 0; j < 8; ++j) { af[j] = 0.f; ab[j] = 0.f; }
#pragma unroll 2
                    for (int l = 0; l < 128; ++l) {
                        const float kv = Kt[l * 128 + dk];
                        const float kf = kv * sm[32768 + l], kb = kv * sm[32768 + 128 + l];
#pragma unroll
                        for (int j = 0; j < 8; ++j) { const float vv = Vt[l * 128 + dv0 + j]; af[j] += kf * vv; ab[j] += kb * vv; }
                    }
#pragma unroll
                    for (int j = 0; j < 8; ++j) {
                        const int dv = dv0 + j;
                        ST[u0 + dv * 128 + dk] = (bf16)f2bf(af[j]);
                        ST[(size_t)1024 * 16384 + u0 + dv * 128 + dk] = (bf16)f2bf(ab[j]);
                    }
                }
                __syncthreads();
            }
        }
    }

    if constexpr (IN(3)) {
        for (size_t v = gt; v < (size_t)2 * 32 * 2048; v += ngt) {
            const int dir = (int)(v >> 16), bh = (int)((v >> 11) & 31), e8 = (int)(v & 2047), h = bh & 3;
            const float lg = log_sigmoid_f(dir == 0 ? args.in[6][h] : args.in[7][h]);
            const float Gc = expf(128.0f * lg);
            float st[8];
#pragma unroll
            for (int j = 0; j < 8; ++j) st[j] = 0.f;
            for (int ci = 0; ci < 32; ++ci) {
                const int c = (dir == 0) ? ci : 31 - ci;
                const size_t off = ((size_t)dir * 1024 + bh * 32 + c) * 16384 + (size_t)e8 * 8;
                v4u o; o.x = pk2(st[0], st[1]); o.y = pk2(st[2], st[3]); o.z = pk2(st[4], st[5]); o.w = pk2(st[6], st[7]);
                *(v4u*)(PREV + off) = o;
                const v4u s = *(const v4u*)(ST + off);
                st[0] = Gc * st[0] + bflo(s.x); st[1] = Gc * st[1] + bfhi(s.x); st[2] = Gc * st[2] + bflo(s.y); st[3] = Gc * st[3] + bfhi(s.y);
                st[4] = Gc * st[4] + bflo(s.z); st[5] = Gc * st[5] + bfhi(s.z); st[6] = Gc * st[6] + bflo(s.w); st[7] = Gc * st[7] + bfhi(s.w);
            }
        }
    }

    if constexpr (IN(4)) {
        const float* gnw = args.in[8];
        for (int ck = bx; ck < NCHUNK; ck += G) {
            const int t0 = ck * 128, bb = ck >> 5, cc = ck & 31;
#pragma unroll 1
            for (int h = 0; h < 4; ++h) {
                const float lgf = log_sigmoid_f(args.in[6][h]), lgb = log_sigmoid_f(args.in[7][h]);
                LAS float* A0 = sm;
                LAS float* A1 = sm + 16384;
                for (int i = tid; i < 16384; i += NTHREADS) {
                    const int l = i >> 7, d = i & 127;
                    A0[i] = bf2f(PROJ[(size_t)(t0 + l) * INW + 1024 + h * 128 + d]);
                    A1[l * 129 + d] = bf2f(PROJ[(size_t)(t0 + l) * INW + 1536 + h * 128 + d]);
                }
                LAS float* qwt = sm + 32896;
                if (tid < 128) { qwt[tid] = expf((float)(tid + 1) * lgf); qwt[128 + tid] = expf((float)(128 - tid) * lgb); qwt[256 + tid] = expf((float)tid * lgf); qwt[384 + tid] = expf((float)tid * lgb); }
                __syncthreads();
                const int c0 = tid & 127, lg4 = tid >> 7;
                float acc[32];
#pragma unroll
                for (int li = 0; li < 32; ++li) acc[li] = 0.f;
#pragma unroll 2
                for (int d = 0; d < 128; ++d) {
                    const float kv = A1[c0 * 129 + d];
#pragma unroll
                    for (int li = 0; li < 32; ++li) acc[li] += A0[(lg4 * 32 + li) * 128 + d] * kv;
                }
                __syncthreads();
#pragma unroll
                for (int li = 0; li < 32; ++li) {
                    const int l = lg4 * 32 + li, m = c0;
                    const float dec = (m <= l) ? qwt[256 + l - m] : qwt[384 + m - l];
                    A0[l * 128 + m] = acc[li] * dec;
                }
                for (int i = tid; i < 16384; i += NTHREADS) {
                    const int l = i >> 7, d = i & 127;
                    A1[l * 129 + d] = bf2f(PROJ[(size_t)(t0 + l) * INW + 2048 + h * 128 + d]);
                }
                __syncthreads();
                float o[32];
#pragma unroll
                for (int li = 0; li < 32; ++li) o[li] = 0.f;
#pragma unroll 2
                for (int m = 0; m < 128; ++m) {
                    const float vv = A1[m * 129 + c0];
#pragma unroll
                    for (int li = 0; li < 32; ++li) o[li] += A0[(lg4 * 32 + li) * 128 + m] * vv;
                }
                __syncthreads();
#pragma unroll 1
                for (int dir = 0; dir < 2; ++dir) {
                    const size_t u0 = ((size_t)dir * 1024 + (bb * 4 + h) * 32 + cc) * 16384;
                    __syncthreads();
                    for (int i = tid; i < 16384; i += NTHREADS) {
                        const int l = i >> 7, d = i & 127;
                        A0[i] = qwt[dir * 128 + l] * bf2f(PROJ[(size_t)(t0 + l) * INW + 1024 + h * 128 + d]);
                        A1[l * 129 + d] = bf2f(PREV[u0 + i]);
                    }
                    __syncthreads();
#pragma unroll 2
                    for (int dk = 0; dk < 128; ++dk) {
                        const float pv = A1[c0 * 129 + dk];
#pragma unroll
                        for (int li = 0; li < 32; ++li) o[li] += A0[(lg4 * 32 + li) * 128 + dk] * pv;
                    }
                }
                __syncthreads();
#pragma unroll
                for (int li = 0; li < 32; ++li) A0[(lg4 * 32 + li) * 128 + c0] = o[li];
                __syncthreads();
                for (int r = wave * 16; r < wave * 16 + 16; ++r) {
                    const float a = A0[r * 128 + lane], b = A0[r * 128 + 64 + lane];
                    const float mean = wave_sum(a + b) * (1.0f / 128.0f);
                    const float da = a - mean, db = b - mean;
                    const float rstd = 1.0f / sqrtf(wave_sum(da * da + db * db) * (1.0f / 128.0f) + GN_EPS);
                    const size_t prow = (size_t)(t0 + r) * INW + 2560 + h * 128;
                    const float ga = bf2f(PROJ[prow + lane]), gb = bf2f(PROJ[prow + 64 + lane]);
                    Y[(size_t)(t0 + r) * D + 512 + h * 128 + lane] = (bf16)f2bf(da * rstd * gnw[h * 128 + lane] * ga);
                    Y[(size_t)(t0 + r) * D + 512 + h * 128 + 64 + lane] = (bf16)f2bf(db * rstd * gnw[h * 128 + 64 + lane] * gb);
                }
                __syncthreads();
            }
        }
    }

    if constexpr (IN(5)) {
        pg8::Gemm g{Y, WOUT, M, D, D}; pg8::StaticOrder S; S.init(M, D, G, bx);
        pg8::EpiResF32 E{x, Z, D, ALPHA};
        pg8::gemm_phase<pg8::EpiResF32, pg8::StaticOrder, true, true>(lds, g, S, E);
    }

    if constexpr (IN(6)) {
        const float* w = args.in[10]; const float* b = args.in[11];
        for (int t = gw; t < M; t += NGW) {
            const f32x4* zr = (const f32x4*)(Z + (size_t)t * D) + lane;
            f32x4 v[4]; float s = 0.f;
#pragma unroll
            for (int j = 0; j < 4; ++j) { v[j] = zr[64 * j]; s += (v[j][0] + v[j][1]) + (v[j][2] + v[j][3]); }
            const float mean = wave_sum(s) * (1.0f / D); float q = 0.f;
#pragma unroll
            for (int j = 0; j < 4; ++j) { v[j] = v[j] - mean; q += (v[j][0] * v[j][0] + v[j][1] * v[j][1]) + (v[j][2] * v[j][2] + v[j][3] * v[j][3]); }
            const float rstd = 1.0f / sqrtf(wave_sum(q) * (1.0f / D) + LN_EPS);
            unsigned long long* o8 = (unsigned long long*)(H + (size_t)t * D) + lane;
#pragma unroll
            for (int j = 0; j < 4; ++j) {
                const f32x4 wv = *((const f32x4*)w + lane + 64 * j), bv = *((const f32x4*)b + lane + 64 * j);
                const f32x4 y = v[j] * rstd * wv + bv;
                o8[64 * j] = (unsigned long long)pk2(y[0], y[1]) | ((unsigned long long)pk2(y[2], y[3]) << 32);
            }
        }
    }

    if constexpr (IN(7)) {
        pg8::Gemm g{H, WQ, M, 2048, D}; pg8::StaticOrder S; S.init(M, 2048, G, bx);
        pg8::EpiPlainBf16 E{QP, 2048};
        pg8::gemm_phase<pg8::EpiPlainBf16, pg8::StaticOrder, true, true>(lds, g, S, E);
    }

    if constexpr (IN(8)) {
        const float* keys = args.in[13];
        LAS float* qs = sm;
        LAS float* sc = sm + 64 * 257;
        for (int unit = bx; unit < (M / 64) * PEER_H; unit += G) {
            const int tt0 = (unit >> 3) * 64, hd = unit & 7;
            for (int i = tid; i < 64 * 256; i += NTHREADS) { const int r = i >> 8, c = i & 255; qs[r * 257 + c] = bf2f(QP[(size_t)(tt0 + r) * 2048 + hd * 256 + c]); }
            __syncthreads();
            {
                const int tt = tid & 63, g8 = __builtin_amdgcn_readfirstlane(tid >> 6);
                for (int p = 0; p < 2; ++p) {
                    float acc[16];
#pragma unroll
                    for (int j = 0; j < 16; ++j) acc[j] = 0.f;
                    const float* kp = keys + ((size_t)(hd * 2 + p) * 128 + g8 * 16) * 128;
                    for (int d = 0; d < 128; ++d) {
                        const float qv = qs[tt * 257 + p * 128 + d];
#pragma unroll
                        for (int j = 0; j < 16; ++j) acc[j] += qv * kp[j * 128 + d];
                    }
#pragma unroll
                    for (int j = 0; j < 16; ++j) sc[tt * 257 + p * 128 + g8 * 16 + j] = acc[j];
                }
            }
            __syncthreads();
            LAS float* tops = qs;
            LAS int* topi = (LAS int*)(qs + 2048);
            LAS float* bsc = qs + 4096;
            LAS int* bps = (LAS int*)(qs + 5120);
            if (tid < 128) {
                const int tt = tid & 63, p = tid >> 6;
                LAS float* row = sc + tt * 257 + p * 128;
                for (int r = 0; r < 16; ++r) {
                    float best = -INFINITY; int bi = 0;
                    for (int n = 0; n < 128; ++n) { const float v = row[n]; if (v > best) { best = v; bi = n; } }
                    row[bi] = -INFINITY;
                    tops[(tt * 2 + p) * 16 + r] = best; topi[(tt * 2 + p) * 16 + r] = bi;
                }
            }
            __syncthreads();
            if (tid < 64) {
                const int tt = tid;
                LAS float* cand = sc + tt * 257;
                for (int a = 0; a < 16; ++a) for (int b = 0; b < 16; ++b) cand[a * 16 + b] = tops[(tt * 2) * 16 + a] + tops[(tt * 2 + 1) * 16 + b];
                float mx = -INFINITY;
                for (int r = 0; r < 16; ++r) {
                    float best = -INFINITY; int bi = 0;
                    for (int n = 0; n < 256; ++n) { const float v = cand[n]; if (v > best) { best = v; bi = n; } }
                    cand[bi] = -INFINITY;
                    bsc[tt * 16 + r] = best; bps[tt * 16 + r] = bi;
                    if (r == 0) mx = best;
                }
                float den = 0.f;
                for (int r = 0; r < 16; ++r) den += expf(bsc[tt * 16 + r] - mx);
                const float rden = 1.0f / den;
                for (int r = 0; r < 16; ++r) {
                    const int pos = bps[tt * 16 + r], a = pos >> 4, b = pos & 15;
                    const int e = topi[(tt * 2) * 16 + a] * 128 + topi[(tt * 2 + 1) * 16 + b];
                    IDX[(size_t)(tt0 + tt) * NSEL + hd * 16 + r] = e;
                    GATE[(size_t)(tt0 + tt) * NSEL + hd * 16 + r] = expf(bsc[tt * 16 + r] - mx) * rden;
                }
            }
            __syncthreads();
        }
    }

    if constexpr (IN(9)) {
        const float* w2 = args.in[16]; const float* b2 = args.in[17];
        for (int t = gw; t < M; t += NGW) {
            const v4u* hp = (const v4u*)(H + (size_t)t * D);
            const v4u ha = hp[lane], hb = hp[64 + lane];
            float hf[16] = {bflo(ha.x), bfhi(ha.x), bflo(ha.y), bfhi(ha.y), bflo(ha.z), bfhi(ha.z), bflo(ha.w), bfhi(ha.w),
                            bflo(hb.x), bfhi(hb.x), bflo(hb.y), bfhi(hb.y), bflo(hb.z), bfhi(hb.z), bflo(hb.w), bfhi(hb.w)};
            float o[16];
#pragma unroll
            for (int i = 0; i < 16; ++i) o[i] = 0.f;
            const int e_l0 = IDX[(size_t)t * NSEL + lane], e_l1 = IDX[(size_t)t * NSEL + 64 + lane];
            const float g_l0 = GATE[(size_t)t * NSEL + lane], g_l1 = GATE[(size_t)t * NSEL + 64 + lane];
            for (int j0 = 0; j0 < NSEL; j0 += 4) {
                v4u ua[4], ub[4], va[4], vb[4]; float gg[4];
#pragma unroll
                for (int k = 0; k < 4; ++k) {
                    const int j = j0 + k;
                    const int e = (j < 64) ? __shfl(e_l0, j) : __shfl(e_l1, j - 64);
                    gg[k] = (j < 64) ? __shfl(g_l0, j) : __shfl(g_l1, j - 64);
                    const v4u* up = (const v4u*)(UT + (size_t)e * D); const v4u* vp = (const v4u*)(VT + (size_t)e * D);
                    ua[k] = up[lane]; ub[k] = up[64 + lane]; va[k] = vp[lane]; vb[k] = vp[64 + lane];
                }
#pragma unroll
                for (int k = 0; k < 4; ++k) {
                    float d = hf[0] * bflo(ua[k].x) + hf[1] * bfhi(ua[k].x) + hf[2] * bflo(ua[k].y) + hf[3] * bfhi(ua[k].y)
                            + hf[4] * bflo(ua[k].z) + hf[5] * bfhi(ua[k].z) + hf[6] * bflo(ua[k].w) + hf[7] * bfhi(ua[k].w)
                            + hf[8] * bflo(ub[k].x) + hf[9] * bfhi(ub[k].x) + hf[10] * bflo(ub[k].y) + hf[11] * bfhi(ub[k].y)
                            + hf[12] * bflo(ub[k].z) + hf[13] * bfhi(ub[k].z) + hf[14] * bflo(ub[k].w) + hf[15] * bfhi(ub[k].w);
                    d = wave_sum(d);
                    const float c = gg[k] * gelu_exact(d);
                    o[0] += c * bflo(va[k].x); o[1] += c * bfhi(va[k].x); o[2] += c * bflo(va[k].y); o[3] += c * bfhi(va[k].y);
                    o[4] += c * bflo(va[k].z); o[5] += c * bfhi(va[k].z); o[6] += c * bflo(va[k].w); o[7] += c * bfhi(va[k].w);
                    o[8] += c * bflo(vb[k].x); o[9] += c * bfhi(vb[k].x); o[10] += c * bflo(vb[k].y); o[11] += c * bfhi(vb[k].y);
                    o[12] += c * bflo(vb[k].z); o[13] += c * bfhi(vb[k].z); o[14] += c * bflo(vb[k].w); o[15] += c * bfhi(vb[k].w);
                }
            }
            float s = 0.f;
#pragma unroll
            for (int i = 0; i < 16; ++i) { o[i] = ALPHA * hf[i] + o[i]; s += o[i]; }
            const float mean = wave_sum(s) * (1.0f / D); float q = 0.f;
#pragma unroll
            for (int i = 0; i < 16; ++i) { o[i] -= mean; q += o[i] * o[i]; }
            const float rstd = 1.0f / sqrtf(wave_sum(q) * (1.0f / D) + LN_EPS);
            float* orow = args.out + (size_t)t * D;
#pragma unroll
            for (int hseg = 0; hseg < 2; ++hseg) {
                const int c0 = hseg * 512 + lane * 8;
                const f32x4 wa = *(const f32x4*)(w2 + c0), wb = *(const f32x4*)(w2 + c0 + 4), ba = *(const f32x4*)(b2 + c0), bb4 = *(const f32x4*)(b2 + c0 + 4);
                f32x4 ya, yb;
#pragma unroll
                for (int i = 0; i < 4; ++i) { ya[i] = o[hseg * 8 + i] * rstd * wa[i] + ba[i]; yb[i] = o[hseg * 8 + 4 + i] * rstd * wb[i] + bb4[i]; }
                *(f32x4*)(orow + c0) = ya; *(f32x4*)(orow + c0 + 4) = yb;
            }
        }
    }
#undef IN
}

extern "C" void kernel_launch(void* const* d_in, const int* in_sizes, int n_in, void* d_out, int out_size, void* d_ws, size_t ws_size, hipStream_t stream) {
    static int grid = 0;
    if (grid == 0) {
        if (n_in != 18 || in_sizes[0] != M * D || out_size != M * D || ws_size < WS_END) {
            fprintf(stderr, "kernel_launch: unexpected shapes: n_in %d in0 %d out %d ws %zu\n", n_in, n_in > 0 ? in_sizes[0] : -1, out_size, ws_size); grid = -1; return; }
        int dev = 0, cus = 0;
        if (hipGetDevice(&dev) != hipSuccess || hipDeviceGetAttribute(&cus, hipDeviceAttributeMultiprocessorCount, dev) != hipSuccess) { grid = -1; return; }
        bool ok = true;
#define SETATTR(k) ok = ok && (hipFuncSetAttribute((const void*)fwd_kernel<k, k + 1>, hipFuncAttributeMaxDynamicSharedMemorySize, LDS_BYTES) == hipSuccess)
        SETATTR(0); SETATTR(1); SETATTR(2); SETATTR(3); SETATTR(4); SETATTR(5); SETATTR(6); SETATTR(7); SETATTR(8); SETATTR(9);
#undef SETATTR
        if (!ok) { fprintf(stderr, "kernel_launch: hipFuncSetAttribute failed\n"); grid = -1; return; }
        grid = cus;
    }
    if (grid < 0) return;
    (void)hipMemsetAsync((char*)d_ws + WS_CTL, 0, CTL_ZERO_BYTES, stream);
    Args a{};
    for (int i = 0; i < 18; ++i) a.in[i] = (const float*)d_in[i];
    a.out = (float*)d_out; a.ws = (unsigned char*)d_ws;
    a.ph_lo = 0; a.ph_hi = 10;
#define LAUNCH(k) hipLaunchKernelGGL((fwd_kernel<k, k + 1>), dim3(grid), dim3(NTHREADS), LDS_BYTES, stream, a)
    LAUNCH(0); LAUNCH(1); LAUNCH(2); LAUNCH(3); LAUNCH(4); LAUNCH(5); LAUNCH(6); LAUNCH(7); LAUNCH(8); LAUNCH(9);
#undef LAUNCH
}
```

```cpp
#include <hip/hip_runtime.h>
#include <cstdio>
#include <cstdint>
#include <cmath>
namespace pg8 {
#define PG8_LAS __attribute__((address_space(3)))
typedef unsigned short bf16_t;
typedef short bf16x8 __attribute__((ext_vector_type(8)));
typedef float f32x4 __attribute__((ext_vector_type(4)));
typedef unsigned u32x4 __attribute__((ext_vector_type(4)));
constexpr int BM = 256, BK = 64, HALF = 128, HTB = HALF * BK * 2  , STAGE_BYTES = 8 * HTB, NXCD = 8, WGM = 8;

__host__ __device__ __forceinline__ int lds_byte(int r, int c) { const int st = (r >> 4) * 2 + (c >> 5), rr = r & 15, cc = c & 31, ob = rr * 64 + cc * 2; return st * 1024 + (ob ^ (((ob >> 9) & 1) << 5)); }
__host__ __device__ __forceinline__ void stage_rc(int b, int& R, int& C) { const int st = b / 1024, sb = b % 1024, swz = sb ^ (((sb >> 9) & 1) << 5); R = (st >> 1) * 16 + swz / 64; C = (st & 1) * 32 + (swz % 64) / 2; }
__host__ __device__ __forceinline__ int perm32(int rho) { const int n = rho >> 4, i = rho & 15; return 8 * (i >> 2) + 4 * n + (i & 3); }

struct Unit { int pm, pn; };
struct Gemm { const bf16_t* A; const bf16_t* Bt; int M, N, K; };

struct StaticOrder {
    int nM, nN, nwg, G, c;
    __host__ __device__ void init(int M, int N, int G_, int c_) { nM = M / BM; nN = N / BM; nwg = nM * nN; G = G_; c = c_; }
    __host__ __device__ bool next(int i, Unit& u) const {
        const long L = (long)i * G + c; if (L >= nwg) return false;
        int wgid = (int)L; { const int q = nwg / NXCD, r = nwg % NXCD, xcd = wgid % NXCD, off = wgid / NXCD; wgid = (xcd < r ? xcd * (q + 1) : r * (q + 1) + (xcd - r) * q) + off; }
        const int nig = WGM * nN, gid = wgid / nig, fm = gid * WGM, gsz = (nM - fm) < WGM ? (nM - fm) : WGM;
        u.pm = fm + ((wgid % nig) % gsz); u.pn = (wgid % nig) / gsz; return true;
    }
    __device__ __forceinline__ void a_ready(const Unit&) const {}
    __device__ __forceinline__ void done(const Unit&) const {}
};

__device__ __forceinline__ unsigned cvt_pk_bf16(float lo, float hi) { unsigned r; asm volatile("v_cvt_pk_bf16_f32 %0, %1, %2" : "=v"(r) : "v"(lo), "v"(hi)); return r; }
typedef float f32x2 __attribute__((ext_vector_type(2)));
__device__ __forceinline__ f32x2 gelu_pk(f32x2 v) {
    const f32x2 av = __builtin_elementwise_abs(v), d = av * 0.2316418882f + 1.0f;
    f32x2 t; t.x = __builtin_amdgcn_rcpf(d.x); t.y = __builtin_amdgcn_rcpf(d.y);
    f32x2 q = t * 0.5307027145f + (-0.7265760135f); q = q * t + 0.7107068705f; q = q * t + (-0.142248368f); q = q * t + 0.127414796f; q = q * t;
    const f32x2 s = (v * v) * (-0.72134752044f);
    f32x2 e; e.x = __builtin_amdgcn_exp2f(s.x); e.y = __builtin_amdgcn_exp2f(s.y);
    const f32x2 m = v * (q * e), r = v - m;
    f32x2 o; o.x = v.x < 0.f ? m.x : r.x; o.y = v.y < 0.f ? m.y : r.y; return o;
}

__device__ __forceinline__ float silu_f(float v) { return v * __builtin_amdgcn_rcpf(1.0f + __expf(-v)); }
struct EpiProj {
    static constexpr bool PERM = true, AFTER_DRAIN = false;
    bf16_t* O; const float* rope;
    __device__ __forceinline__ void operator()(const f32x4 (&acc)[2][2][4][2], const Unit& u, int wr, int wc, int fr, int fq) const {
        const int sec = u.pn >> 1;
        const int row0 = u.pm * BM + wr * 64 + fr, col0 = u.pn * BM + wc * 32 + 8 * fq;
        const int i0 = wc * 16 + 4 * fq;
#pragma unroll
        for (int ai = 0; ai < 2; ++ai)
#pragma unroll
            for (int m = 0; m < 4; ++m) {
                const int row = row0 + ai * HALF + m * 16;
                bf16_t* rowp = O + (size_t)row * 3072 + col0;
                f32x4 r0 = (f32x4){1.f, 0.f, 1.f, 0.f}, r1 = r0;
                if (sec == 2 || sec == 3) { const f32x4* rp = (const f32x4*)(rope + ((size_t)(row & 4095) * 64 + i0) * 2); r0 = rp[0]; r1 = rp[1]; }
#pragma unroll
                for (int bj = 0; bj < 2; ++bj) {
                    f32x4 v0 = acc[ai][bj][m][0], v1 = acc[ai][bj][m][1];
                    if (sec <= 1) {
                        f32x2 a = gelu_pk((f32x2){v0[0], v0[1]}), b = gelu_pk((f32x2){v0[2], v0[3]}), c = gelu_pk((f32x2){v1[0], v1[1]}), d = gelu_pk((f32x2){v1[2], v1[3]});
                        v0 = (f32x4){a.x, a.y, b.x, b.y}; v1 = (f32x4){c.x, c.y, d.x, d.y};
                    } else if (sec <= 3) {
                        const float sc = (sec == 3) ? 0.08838834764831845f : 1.0f;
                        f32x4 w0, w1;
                        w0[0] = (v0[0] * r0[0] - v0[1] * r0[1]) * sc; w0[1] = (v0[0] * r0[1] + v0[1] * r0[0]) * sc;
                        w0[2] = (v0[2] * r0[2] - v0[3] * r0[3]) * sc; w0[3] = (v0[2] * r0[3] + v0[3] * r0[2]) * sc;
                        w1[0] = (v1[0] * r1[0] - v1[1] * r1[1]) * sc; w1[1] = (v1[0] * r1[1] + v1[1] * r1[0]) * sc;
                        w1[2] = (v1[2] * r1[2] - v1[3] * r1[3]) * sc; w1[3] = (v1[2] * r1[3] + v1[3] * r1[2]) * sc;
                        v0 = w0; v1 = w1;
                    } else if (sec == 5) {
#pragma unroll
                        for (int j = 0; j < 4; ++j) { v0[j] = silu_f(v0[j]); v1[j] = silu_f(v1[j]); }
                    }
                    u32x4 w; w.x = cvt_pk_bf16(v0[0], v0[1]); w.y = cvt_pk_bf16(v0[2], v0[3]); w.z = cvt_pk_bf16(v1[0], v1[1]); w.w = cvt_pk_bf16(v1[2], v1[3]);
                    *(u32x4*)(rowp + bj * HALF) = w;
                }
            }
    }
};
struct EpiPlainBf16 {
    static constexpr bool PERM = true, AFTER_DRAIN = false;
    bf16_t* O; int ldc;
    __device__ __forceinline__ void operator()(const f32x4 (&acc)[2][2][4][2], const Unit& u, int wr, int wc, int fr, int fq) const {
        const int row0 = u.pm * BM + wr * 64 + fr, col0 = u.pn * BM + wc * 32 + 8 * fq;
#pragma unroll
        for (int ai = 0; ai < 2; ++ai)
#pragma unroll
            for (int m = 0; m < 4; ++m) { bf16_t* rowp = O + (size_t)(row0 + ai * HALF + m * 16) * ldc + col0;
#pragma unroll
                for (int bj = 0; bj < 2; ++bj) { const f32x4 v0 = acc[ai][bj][m][0], v1 = acc[ai][bj][m][1];
                    u32x4 w; w.x = cvt_pk_bf16(v0[0], v0[1]); w.y = cvt_pk_bf16(v0[2], v0[3]); w.z = cvt_pk_bf16(v1[0], v1[1]); w.w = cvt_pk_bf16(v1[2], v1[3]);
                    *(u32x4*)(rowp + bj * HALF) = w; } }
    }
};
struct EpiResF32 {
    static constexpr bool PERM = false, AFTER_DRAIN = false;
    const float* X; float* Z; int ldc; float alpha;
    __device__ __forceinline__ void operator()(const f32x4 (&acc)[2][2][4][2], const Unit& u, int wr, int wc, int fr, int fq) const {
        const int row0 = u.pm * BM + wr * 64 + fr, col0 = u.pn * BM + wc * 32 + 4 * fq;
#pragma unroll
        for (int ai = 0; ai < 2; ++ai)
#pragma unroll
            for (int m = 0; m < 4; ++m) { const size_t off = (size_t)(row0 + ai * HALF + m * 16) * ldc + col0;
#pragma unroll
                for (int bj = 0; bj < 2; ++bj)
#pragma unroll
                    for (int n = 0; n < 2; ++n) { const f32x4 xv = *(const f32x4*)(X + off + bj * HALF + n * 16); *(f32x4*)(Z + off + bj * HALF + n * 16) = acc[ai][bj][m][n] + xv * alpha; } }
    }
};
template <class Epi, class Sched, bool ALIGN_EPI = false, bool SP2 = false>
__device__ __forceinline__ void gemm_phase(PG8_LAS unsigned char* lds, const Gemm g, const Sched& S, const Epi& E) {
    const int tid = threadIdx.x, wid = __builtin_amdgcn_readfirstlane(tid >> 6), lane = tid & 63, wr = wid >> 2, wc = wid & 3, fr = lane & 15, fq = lane >> 4;
    const int K = g.K, nt = K / BK;
    unsigned voffA[2], voffB[2];
#pragma unroll
    for (int i = 0; i < 2; ++i) { int R, C; stage_rc(tid * 16 + i * 8192, R, C); const int Rb = Epi::PERM ? ((R & ~31) + perm32(R & 31)) : R;
        voffA[i] = (unsigned)(R * K + C) * 2u; voffB[i] = (unsigned)(Rb * K + C) * 2u; }
    const size_t kstep = (size_t)(BK * 2);
    const size_t hstep = (size_t)HALF * K * 2;
    const size_t tstep = 2 * hstep;
    const unsigned ldsw = (unsigned)wid * 1024u;
    const int aoff = lds_byte(wr * 64 + fr, fq * 8), boff = lds_byte(wc * 32 + fr, fq * 8);
#define PG8_SA(b, h) (((b) * 2 + (h)) * HTB)
#define PG8_SB(b, h) ((4 + (b) * 2 + (h)) * HTB)
#define PG8_STAGE(bufoff, gbase, voff) do { _Pragma("unroll") for (int _i = 0; _i < 2; ++_i) \
        __builtin_amdgcn_global_load_lds((const unsigned*)((const char*)(gbase) + (voff)[_i]), (PG8_LAS unsigned*)(lds + (bufoff) + ldsw + _i * 8192), 16, 0, 0); } while (0)
#define PG8_LDA(dst, b, h) do { _Pragma("unroll") for (int m = 0; m < 4; ++m) _Pragma("unroll") for (int k = 0; k < 2; ++k) dst[m][k] = *(const PG8_LAS bf16x8*)(lds + PG8_SA(b, h) + aoff + m * 2048 + k * 1024); } while (0)
#define PG8_LDB(dst, b, h) do { _Pragma("unroll") for (int n = 0; n < 2; ++n) _Pragma("unroll") for (int k = 0; k < 2; ++k) dst[n][k] = *(const PG8_LAS bf16x8*)(lds + PG8_SB(b, h) + boff + n * 2048 + k * 1024); } while (0)
#define PG8_MMA(ai, bj, At, Bt) do { __builtin_amdgcn_s_setprio(1); _Pragma("unroll") for (int m = 0; m < 4; ++m) _Pragma("unroll") for (int n = 0; n < 2; ++n) _Pragma("unroll") for (int k = 0; k < 2; ++k) \
        acc[ai][bj][m][n] = __builtin_amdgcn_mfma_f32_16x16x32_bf16(Bt[n][k], At[m][k], acc[ai][bj][m][n], 0, 0, 0); __builtin_amdgcn_s_setprio(0); } while (0)
#define PG8_WAIT_V(n) asm volatile("s_waitcnt vmcnt(" #n ")" ::: "memory")
#define PG8_WAIT_L(n) asm volatile("s_waitcnt lgkmcnt(" #n ")" ::: "memory")
#define PG8_BAR __builtin_amdgcn_s_barrier()
#define PG8_SCHED __builtin_amdgcn_sched_barrier(0)
    Unit cur, nxt; int ui = 0;
    if (!S.next(0, cur)) return;
    f32x4 acc[2][2][4][2];
#pragma unroll
    for (int a = 0; a < 2; ++a)
#pragma unroll
        for (int b = 0; b < 2; ++b)
#pragma unroll
            for (int m = 0; m < 4; ++m)
#pragma unroll
                for (int n = 0; n < 2; ++n) acc[a][b][m][n] = (f32x4){0.f, 0.f, 0.f, 0.f};
    bf16x8 At[4][2], B0[2][2], B1[2][2];
    const char* cA = (const char*)g.A + (size_t)cur.pm * tstep; const char* cB = (const char*)g.Bt + (size_t)cur.pn * tstep;
    S.a_ready(cur);
    if constexpr (SP2) {
        PG8_STAGE(PG8_SB(0, 0), cB, voffB); PG8_STAGE(PG8_SB(0, 1), cB + hstep, voffB); PG8_STAGE(PG8_SA(0, 0), cA, voffA); PG8_STAGE(PG8_SA(0, 1), cA + hstep, voffA);
        if (wr == 1) PG8_BAR;
        PG8_WAIT_V(2); PG8_BAR;
        PG8_STAGE(PG8_SB(1, 0), cB + kstep, voffB); PG8_STAGE(PG8_SA(1, 0), cA + kstep, voffA); PG8_STAGE(PG8_SB(1, 1), cB + hstep + kstep, voffB);
        PG8_WAIT_V(6); PG8_BAR;
    } else {
        PG8_STAGE(PG8_SB(0, 0), cB, voffB); PG8_STAGE(PG8_SA(0, 0), cA, voffA); PG8_STAGE(PG8_SB(0, 1), cB + hstep, voffB); PG8_STAGE(PG8_SA(0, 1), cA + hstep, voffA);
        if (wr == 1) PG8_BAR;
        PG8_WAIT_V(4); PG8_BAR;
        PG8_STAGE(PG8_SB(1, 0), cB + kstep, voffB); PG8_STAGE(PG8_SA(1, 0), cA + kstep, voffA); PG8_STAGE(PG8_SB(1, 1), cB + hstep + kstep, voffB);
        PG8_WAIT_V(6); PG8_BAR;
    }
    for (;;) {
        const bool has_next = S.next(ui + 1, nxt);
        const char* nA = has_next ? (const char*)g.A + (size_t)nxt.pm * tstep : cA; const char* nB = has_next ? (const char*)g.Bt + (size_t)nxt.pn * tstep : cB;
        for (int t = 0; t < nt; t += 2) {
            const bool last = (t == nt - 2);
            const char* a1 = cA + (size_t)(t + 1) * kstep;
            const char* a2 = last ? nA : cA + (size_t)(t + 2) * kstep; const char* b2 = last ? nB : cB + (size_t)(t + 2) * kstep;
            const char* a3 = a2 + kstep; const char* b3 = b2 + kstep;
            if (last && has_next) S.a_ready(nxt);
            if constexpr (SP2) {
            PG8_LDB(B0, 0, 0); PG8_LDB(B1, 0, 1); PG8_SCHED; PG8_LDA(At, 0, 0); PG8_STAGE(PG8_SA(1, 1), a1 + hstep, voffA);
            PG8_WAIT_V(8); PG8_WAIT_L(0); PG8_BAR; PG8_MMA(0, 0, At, B0); PG8_MMA(0, 1, At, B1); PG8_BAR; PG8_SCHED;
            PG8_LDA(At, 0, 1); PG8_STAGE(PG8_SB(0, 0), b2, voffB); PG8_STAGE(PG8_SB(0, 1), b2 + hstep, voffB); PG8_STAGE(PG8_SA(0, 0), a2, voffA);
            PG8_WAIT_V(8); PG8_WAIT_L(0); PG8_BAR; PG8_MMA(1, 0, At, B0); PG8_MMA(1, 1, At, B1); PG8_BAR; PG8_SCHED;
            PG8_LDB(B0, 1, 0); PG8_LDB(B1, 1, 1); PG8_SCHED; PG8_LDA(At, 1, 0); PG8_STAGE(PG8_SA(0, 1), a2 + hstep, voffA);
            PG8_WAIT_V(8); PG8_WAIT_L(0); PG8_BAR; PG8_MMA(0, 0, At, B0); PG8_MMA(0, 1, At, B1); PG8_BAR; PG8_SCHED;
            PG8_LDA(At, 1, 1); PG8_STAGE(PG8_SB(1, 0), b3, voffB); PG8_STAGE(PG8_SB(1, 1), b3 + hstep, voffB); PG8_STAGE(PG8_SA(1, 0), a3, voffA);
            PG8_WAIT_V(8); PG8_WAIT_L(0); PG8_BAR; PG8_MMA(1, 0, At, B0); PG8_MMA(1, 1, At, B1); PG8_BAR; PG8_SCHED;
            } else {
            PG8_LDB(B0, 0, 0); PG8_SCHED; PG8_LDA(At, 0, 0); PG8_STAGE(PG8_SA(1, 1), a1 + hstep, voffA);
            PG8_WAIT_L(8); PG8_BAR; PG8_WAIT_L(0); PG8_MMA(0, 0, At, B0); PG8_BAR; PG8_SCHED;
            PG8_LDB(B1, 0, 1); PG8_STAGE(PG8_SB(0, 0), b2, voffB);
            PG8_BAR; PG8_WAIT_L(0); PG8_MMA(0, 1, At, B1); PG8_BAR;
            PG8_LDA(At, 0, 1); PG8_STAGE(PG8_SA(0, 0), a2, voffA);
            PG8_BAR; PG8_WAIT_L(0); PG8_MMA(1, 0, At, B0); PG8_BAR; PG8_SCHED;
            PG8_STAGE(PG8_SB(0, 1), b2 + hstep, voffB);
            PG8_WAIT_V(6); PG8_BAR; PG8_MMA(1, 1, At, B1); PG8_BAR;
            PG8_LDB(B0, 1, 0); PG8_SCHED; PG8_LDA(At, 1, 0); PG8_STAGE(PG8_SA(0, 1), a2 + hstep, voffA);
            PG8_WAIT_L(8); PG8_BAR; PG8_WAIT_L(0); PG8_MMA(0, 0, At, B0); PG8_BAR; PG8_SCHED;
            PG8_LDB(B1, 1, 1); PG8_STAGE(PG8_SB(1, 0), b3, voffB);
            PG8_BAR; PG8_WAIT_L(0); PG8_MMA(0, 1, At, B1); PG8_BAR;
            PG8_LDA(At, 1, 1); PG8_STAGE(PG8_SA(1, 0), a3, voffA);
            PG8_BAR; PG8_WAIT_L(0); PG8_MMA(1, 0, At, B0); PG8_BAR; PG8_SCHED;
            PG8_STAGE(PG8_SB(1, 1), b3 + hstep, voffB);
            PG8_WAIT_V(6); PG8_BAR; PG8_MMA(1, 1, At, B1); PG8_BAR;
            }
        }
        if constexpr (ALIGN_EPI) { if (wr == 0) PG8_BAR; }
        if constexpr (!Epi::AFTER_DRAIN) { E(acc, cur, wr, wc, fr, fq); S.done(cur); }
        if (!has_next) break;
#pragma unroll
        for (int a = 0; a < 2; ++a)
#pragma unroll
            for (int b = 0; b < 2; ++b)
#pragma unroll
                for (int m = 0; m < 4; ++m)
#pragma unroll
                    for (int n = 0; n < 2; ++n) acc[a][b][m][n] = (f32x4){0.f, 0.f, 0.f, 0.f};
        cur = nxt; cA = nA; cB = nB; ++ui;
        if constexpr (ALIGN_EPI) { if (wr == 1) PG8_BAR; }
    }
    PG8_WAIT_V(0);
    if constexpr (!ALIGN_EPI) { if (wr == 0) PG8_BAR; }
    PG8_BAR;
    if constexpr (Epi::AFTER_DRAIN) { E.fused(acc, cur, wr, wc, fr, fq, lds, wid, lane); S.done(cur); }
#undef PG8_SA
#undef PG8_SB
#undef PG8_STAGE
#undef PG8_LDA
#undef PG8_LDB
#undef PG8_MMA
#undef PG8_WAIT_V
#undef PG8_WAIT_L
#undef PG8_BAR
#undef PG8_SCHED
}
}
#ifndef N_LAUNCHES
#define N_LAUNCHES 1
#endif
constexpr int NWAVES = 8, NTHREADS = 512;
constexpr int BATCH = 8, SEQ = 4096, D = 1024, M = BATCH * SEQ;
constexpr int INW = 3072;
constexpr int NCHUNK = M / 128;
constexpr int PEER_H = 8, PEER_K = 16, NSEL = 128, NEXP = 16384;
constexpr float LN_EPS = 1e-5f, GN_EPS = 1e-5f;
constexpr float ALPHA = 1.189207115002721f;

constexpr size_t MiB = 1u << 20;
constexpr size_t WS_CTL = 0, CTL_ZERO_BYTES = 1 * MiB;
constexpr size_t WS_SKB = 1 * MiB;
constexpr size_t WS_WSB = 1 * MiB + 512 * 1024;
constexpr size_t WS_ROPE = 2 * MiB;
constexpr size_t WS_WIN = 4 * MiB;
constexpr size_t WS_WOUT = 10 * MiB;
constexpr size_t WS_WQ = 12 * MiB;
constexpr size_t WS_UT = 16 * MiB;
constexpr size_t WS_VT = 48 * MiB;
constexpr size_t WS_PROJ = 80 * MiB;
constexpr size_t WS_Z = 80 * MiB;
constexpr size_t WS_IDX = 80 * MiB;
constexpr size_t WS_GATE = 96 * MiB;
constexpr size_t WS_H = 208 * MiB;
constexpr size_t WS_XB = 272 * MiB;
constexpr size_t WS_Y = 272 * MiB;
constexpr size_t WS_ST = 336 * MiB;
constexpr size_t WS_PREV = 400 * MiB;
constexpr size_t WS_QP = 336 * MiB;
constexpr size_t WS_END = 464 * MiB;

constexpr int LDS_BYTES = 147456;

#define GAS __attribute__((address_space(1)))
#define LAS __attribute__((address_space(3)))
typedef unsigned short bf16;
typedef unsigned v4u __attribute__((ext_vector_type(4)));
typedef float f32x4 __attribute__((ext_vector_type(4)));

__device__ __forceinline__ unsigned f2bf(float f) { unsigned u = __builtin_bit_cast(unsigned, f); return (u + 0x7fffu + ((u >> 16) & 1u)) >> 16; }
__device__ __forceinline__ unsigned pk2(float lo, float hi) { return f2bf(lo) | (f2bf(hi) << 16); }
__device__ __forceinline__ float bf2f(unsigned short b) { return __builtin_bit_cast(float, (unsigned)b << 16); }
__device__ __forceinline__ float bflo(unsigned w) { return __builtin_bit_cast(float, w << 16); }
__device__ __forceinline__ float bfhi(unsigned w) { return __builtin_bit_cast(float, w & 0xffff0000u); }
__device__ __forceinline__ float wave_sum(float v) {
#pragma unroll
    for (int o = 1; o < 64; o <<= 1) v += __shfl_xor(v, o);
    return v;
}
__device__ __forceinline__ float gelu_exact(float v) { return 0.5f * v * (1.0f + erff(v * 0.70710678118654752f)); }
__device__ __forceinline__ float log_sigmoid_f(float x) { return -log1pf(expf(-x)); }

#define XB_TMO      128
#define XB_XCNT(j)  (256  + 64 * (j))
#define XB_XSUB(j)  (1280 + 64 * (j))
#define XB_XGEN(j)  (2304 + 64 * (j))
#define XB_TOP      3328
#define XB_TOPGEN   3392
#define XCD_BAR_WORDS 3456
#define XB_SPIN_CAP (1u << 18)

__device__ __forceinline__ unsigned xb_ld(unsigned* p)              { return __hip_atomic_load(p, __ATOMIC_RELAXED, __HIP_MEMORY_SCOPE_AGENT); }
__device__ __forceinline__ unsigned xb_add(unsigned* p, unsigned v) { return __hip_atomic_fetch_add(p, v, __ATOMIC_RELAXED, __HIP_MEMORY_SCOPE_AGENT); }
__device__ __forceinline__ unsigned xb_xcc_id() { return (unsigned)__builtin_amdgcn_s_getreg((3 << 11) | 20) & 0xFu; }
#define XB_SPIN(cond, bar) do { unsigned _sp = 0; while (cond) { __builtin_amdgcn_s_sleep(1); \
    if ((++_sp & 255u) == 0u) { if (xb_ld(&(bar)[XB_TMO])) break; if (_sp > XB_SPIN_CAP) { atomicAdd(&(bar)[XB_TMO], 1u); break; } } } } while (0)

struct XcdBarrier {
    unsigned* bar; unsigned x;
    volatile LAS unsigned* st;
};

__device__ __forceinline__ XcdBarrier xcd_barrier_post(unsigned* bar, volatile LAS unsigned* st) {
    XcdBarrier b; b.bar = bar; b.x = xb_xcc_id(); b.st = st;
    if (threadIdx.x == 0) (void)xb_add(&bar[XB_XCNT(b.x)], 1u);
    return b;
}
__device__ __forceinline__ void xcd_barrier_complete(unsigned* bar, unsigned x, unsigned& nloc, unsigned& nx) {
    const unsigned G = gridDim.x * gridDim.y * gridDim.z;
    unsigned sum, cnt, mine, sp = 0u;
    for (;;) {
        sum = 0u; cnt = 0u; mine = 0u;
#pragma unroll
        for (unsigned j = 0; j < 16; ++j) { const unsigned c = xb_ld(&bar[XB_XCNT(j)]); sum += c; cnt += (c > 0u) ? 1u : 0u; mine = (j == x) ? c : mine; }
        if (sum == G) break;
        __builtin_amdgcn_s_sleep(1);
        if ((++sp & 255u) == 0u) { if (xb_ld(&bar[XB_TMO])) break; if (sp > XB_SPIN_CAP) { atomicAdd(&bar[XB_TMO], 1u); break; } }
    }
    nloc = mine > 0u ? mine : 1u; nx = cnt > 0u ? cnt : 1u;
}

__device__ __forceinline__ void xcd_barrier(const XcdBarrier& b) {
    asm volatile("s_waitcnt vmcnt(0)" ::: "memory");
    __syncthreads();
    if (threadIdx.x == 0) {
        unsigned* bar = b.bar;
        __builtin_amdgcn_s_waitcnt(0);
        unsigned nloc = b.st[0], nx = b.st[1];
        if (nloc == 0u) { xcd_barrier_complete(bar, b.x, nloc, nx); b.st[0] = nloc; b.st[1] = nx; }
        const unsigned old = xb_add(&bar[XB_XSUB(b.x)], 1u);
        const unsigned gen = old / nloc;
        if (old + 1u == (gen + 1u) * nloc) {
            __builtin_amdgcn_fence(__ATOMIC_RELEASE, "agent");
            asm volatile("s_waitcnt vmcnt(0)" ::: "memory");
            const unsigned og = xb_add(&bar[XB_TOP], 1u);
            const unsigned tg = og / nx;
            if (og + 1u == (tg + 1u) * nx) xb_add(&bar[XB_TOPGEN], 1u);
            else XB_SPIN(xb_ld(&bar[XB_TOPGEN]) == tg, bar);
            __builtin_amdgcn_fence(__ATOMIC_ACQUIRE, "agent");
            xb_add(&bar[XB_XGEN(b.x)], 1u);
            asm volatile("s_waitcnt vmcnt(0)" ::: "memory");
        } else {
            XB_SPIN(xb_ld(&bar[XB_XGEN(b.x)]) == gen, bar);
            __builtin_amdgcn_fence(__ATOMIC_ACQUIRE, "agent");
            asm volatile("s_waitcnt vmcnt(0)" ::: "memory");
        }
    }
    __syncthreads();
}

constexpr int CW_BAR = 4096;
constexpr int MISC_OFF = LDS_BYTES - 64;

struct Args {
    const float* in[18]; float* out; unsigned char* ws; int ph_lo, ph_hi;
};

template <int MODE>
__device__ __forceinline__ int dst_row(int n) {
    if (MODE == 1 && n >= 1024 && n < 2048) { const int j = n & 127; return (n & ~127) + ((j < 64) ? 2 * j : 2 * (j - 64) + 1); }
    return n;
}
template <int MODE>
__device__ __forceinline__ void p0_transpose_item(const float* W, int K, int N, bf16* WT, LAS float* scr, int item, int lane) {
    const int nblk = N / 32, kb = item / nblk, nb = item % nblk, k0 = 64 * kb, n0 = 32 * nb;
#pragma unroll 8
    for (int i = 0; i < 32; ++i) { const int kk = 2 * i + (lane >> 5); scr[kk * 33 + (lane & 31)] = W[(size_t)(k0 + kk) * N + n0 + (lane & 31)]; }
    asm volatile("s_waitcnt lgkmcnt(0)" ::: "memory");
    const int c = lane & 7;
#pragma unroll
    for (int j = 0; j < 4; ++j) { const int n = (lane >> 3) + 8 * j; const LAS float* s = scr + (8 * c) * 33 + n;
        v4u o; o.x = pk2(s[0 * 33], s[1 * 33]); o.y = pk2(s[2 * 33], s[3 * 33]); o.z = pk2(s[4 * 33], s[5 * 33]); o.w = pk2(s[6 * 33], s[7 * 33]);
        *(GAS v4u*)(WT + (size_t)dst_row<MODE>(n0 + n) * K + k0 + 8 * c) = o; }
    asm volatile("s_waitcnt lgkmcnt(0)" ::: "memory");
}
__device__ __forceinline__ void p0_convert(const float* src, bf16* dst, size_t n8, size_t gt, size_t ngt) {
    for (size_t i = gt; i < n8; i += ngt) {
        const f32x4 a = *(const f32x4*)(src + i * 8), b = *(const f32x4*)(src + i * 8 + 4);
        v4u o; o.x = pk2(a[0], a[1]); o.y = pk2(a[2], a[3]); o.z = pk2(b[0], b[1]); o.w = pk2(b[2], b[3]);
        *(v4u*)(dst + i * 8) = o;
    }
}

template <int PH_LO, int PH_HI>
__global__ void __launch_bounds__(NTHREADS, 2) fwd_kernel(Args args) {
    extern __shared__ __attribute__((aligned(16))) unsigned char lds_raw[];
    LAS unsigned char* lds = (LAS unsigned char*)lds_raw;
    LAS float* sm = (LAS float*)lds_raw;
    const int tid = threadIdx.x, lane = tid & 63, wave = __builtin_amdgcn_readfirstlane(tid >> 6);
    const int G = gridDim.x, bx = blockIdx.x;
    const int gw = bx * NWAVES + wave, NGW = G * NWAVES;
    const size_t gt = (size_t)bx * NTHREADS + tid, ngt = (size_t)G * NTHREADS;
    unsigned char* ws = args.ws;
    const float* x = args.in[0];
    bf16* SKB = (bf16*)(ws + WS_SKB); bf16* WSB = (bf16*)(ws + WS_WSB); float* ROPE = (float*)(ws + WS_ROPE);
    bf16* WIN = (bf16*)(ws + WS_WIN); bf16* WOUT = (bf16*)(ws + WS_WOUT); bf16* WQ = (bf16*)(ws + WS_WQ);
    bf16* UT = (bf16*)(ws + WS_UT); bf16* VT = (bf16*)(ws + WS_VT);
    bf16* PROJ = (bf16*)(ws + WS_PROJ); float* Z = (float*)(ws + WS_Z); int* IDX = (int*)(ws + WS_IDX); float* GATE = (float*)(ws + WS_GATE);
    bf16* H = (bf16*)(ws + WS_H); bf16* XB = (bf16*)(ws + WS_XB); bf16* Y = (bf16*)(ws + WS_Y);
    bf16* ST = (bf16*)(ws + WS_ST); bf16* PREV = (bf16*)(ws + WS_PREV); bf16* QP = (bf16*)(ws + WS_QP);
#define IN(k) (PH_LO <= (k) && (k) < PH_HI)
#define BOTH(k) (IN(k) && IN((k) + 1))
    volatile LAS unsigned* MISC = (volatile LAS unsigned*)(lds + MISC_OFF);
    XcdBarrier bar; bar.bar = (unsigned*)(ws + WS_CTL) + CW_BAR; bar.x = 0; bar.st = nullptr;
    if constexpr (PH_HI - PH_LO > 1) {
        if (tid < 16) MISC[tid] = 0u;
        __syncthreads();
        bar = xcd_barrier_post((unsigned*)(ws + WS_CTL) + CW_BAR, MISC + 8);
    }
#define GRID_BAR(k) do { if constexpr (BOTH(k)) xcd_barrier(bar); } while (0)

    if constexpr (IN(0)) {
        LAS float* scr = sm + wave * 4096;
        constexpr int I_IN = (D / 64) * (INW / 32), I_OUT = (D / 64) * (D / 32), I_Q = (D / 64) * (2048 / 32);
        for (int it = gw; it < I_IN + I_OUT + I_Q; it += NGW) {
            int r = it;
            if (r < I_IN) { p0_transpose_item<1>(args.in[1], D, INW, WIN, scr, r, lane); continue; } r -= I_IN;
            if (r < I_OUT) { p0_transpose_item<0>(args.in[9], D, D, WOUT, scr, r, lane); continue; } r -= I_OUT;
            p0_transpose_item<0>(args.in[12], D, 2048, WQ, scr, r, lane);
        }
        p0_convert(args.in[13], SKB, (size_t)8 * 2 * 128 * 128 / 8, gt, ngt);
        p0_convert(args.in[4], WSB, (size_t)4 * 128 * 128 / 8, gt, ngt);
        p0_convert(args.in[14], UT, (size_t)NEXP * D / 8, gt, ngt);
        p0_convert(args.in[15], VT, (size_t)NEXP * D / 8, gt, ngt);
        p0_convert(x, XB, (size_t)M * D / 8, gt, ngt);
        for (size_t i = gt; i < (size_t)4096 * 64; i += ngt) {
            const int pos = (int)(i >> 6), k = (int)(i & 63);
            const float inv = powf(10000.0f, -(float)k / 64.0f);
            const float ang = (float)pos * inv;
            ROPE[i * 2] = cosf(ang); ROPE[i * 2 + 1] = sinf(ang);
        }
    }

    GRID_BAR(0);

    if constexpr (IN(1)) {
        pg8::Gemm g{XB, WIN, M, INW, D}; pg8::StaticOrder S; S.init(M, INW, G, bx);
        pg8::EpiProj E{PROJ, ROPE};
        pg8::gemm_phase<pg8::EpiProj, pg8::StaticOrder, true, true>(lds, g, S, E);
    }

    GRID_BAR(1);

    if constexpr (IN(2)) {
        const float* lnw = args.in[2]; const float* lnb = args.in[3]; const float* wsf = args.in[4]; const float* bs = args.in[5];
        for (int ck = bx; ck < NCHUNK; ck += G) {
            const int t0 = ck * 128, bb = ck >> 5, cc = ck & 31;
            LAS float* stat = sm + 16384;
            for (int r = wave * 16; r < wave * 16 + 16; ++r) {
                const v4u raw = *(const v4u*)(PROJ + (size_t)(t0 + r) * INW + 512 + lane * 8);
                float v[8] = {bflo(raw.x), bfhi(raw.x), bflo(raw.y), bfhi(raw.y), bflo(raw.z), bfhi(raw.z), bflo(raw.w), bfhi(raw.w)};
                float s = 0.f;
#pragma unroll
                for (int j = 0; j < 8; ++j) s += v[j];
                const float mean = wave_sum(s) * (1.0f / 512.0f);
                float q = 0.f;
#pragma unroll
                for (int j = 0; j < 8; ++j) { const float d = v[j] - mean; q += d * d; }
                const float rstd = 1.0f / sqrtf(wave_sum(q) * (1.0f / 512.0f) + LN_EPS);
                if (lane == 0) { stat[r * 2] = mean; stat[r * 2 + 1] = rstd; }
            }
            __syncthreads();
#pragma unroll 1
            for (int h = 0; h < 4; ++h) {
                for (int i = tid; i < 16384; i += NTHREADS) {
                    const int m = i >> 7, d = i & 127, col = h * 128 + d;
                    const float v = bf2f(PROJ[(size_t)(t0 + m) * INW + 512 + col]);
                    sm[i] = (v - stat[m * 2]) * stat[m * 2 + 1] * lnw[col] + lnb[col];
                }
                __syncthreads();
                {
                    const int d = tid & 127, lg = tid >> 7;
#pragma unroll 1
                    for (int ps = 0; ps < 4; ++ps) {
                        const int l0 = lg * 32 + ps * 8;
                        float acc[8];
#pragma unroll
                        for (int li = 0; li < 8; ++li) acc[li] = 0.f;
#pragma unroll 2
                        for (int m = 0; m < 128; ++m) {
                            const float vv = sm[m * 128 + d];
#pragma unroll
                            for (int li = 0; li < 8; ++li) acc[li] += wsf[((size_t)h * 128 + l0 + li) * 128 + m] * vv;
                        }
#pragma unroll
                        for (int li = 0; li < 8; ++li) {
                            const int l = l0 + li;
                            const float mixed = acc[li] + bs[h * 128 + l];
                            const float uu = bf2f(PROJ[(size_t)(t0 + l) * INW + h * 128 + d]);
                            Y[(size_t)(t0 + l) * D + h * 128 + d] = (bf16)f2bf(uu * mixed);
                        }
                    }
                }
                __syncthreads();
            }
#pragma unroll 1
            for (int h = 0; h < 4; ++h) {
                LAS float* Kt = sm; LAS float* Vt = sm + 16384;
                for (int i = tid; i < 16384; i += NTHREADS) {
                    const int l = i >> 7, d = i & 127;
                    Kt[i] = bf2f(PROJ[(size_t)(t0 + l) * INW + 1536 + h * 128 + d]);
                    Vt[i] = bf2f(PROJ[(size_t)(t0 + l) * INW + 2048 + h * 128 + d]);
                }
                {
                    const float lgf = log_sigmoid_f(args.in[6][h]), lgb = log_sigmoid_f(args.in[7][h]);
                    if (tid < 128) { sm[32768 + tid] = expf((float)(127 - tid) * lgf); sm[32768 + 128 + tid] = expf((float)tid * lgb); }
                }
                __syncthreads();
                const int dk = tid & 127, g4 = tid >> 7;
                const size_t u0 = (size_t)((bb * 4 + h) * 32 + cc) * 16384;
#pragma unroll 1
                for (int ps = 0; ps < 4; ++ps) {
                    const int dv0 = g4 * 32 + ps * 8;
                    float af[8], ab[8];
#pragma unroll
                    for (int j = 0; j < 8; ++j) { af[j] = 0.f; ab[j] = 0.f; }
#pragma unroll 2
                    for (int l = 0; l < 128; ++l) {
                        const float kv = Kt[l * 128 + dk];
                        const float kf = kv * sm[32768 + l], kb = kv * sm[32768 + 128 + l];
#pragma unroll
                        for (int j = 0; j < 8; ++j) { const float vv = Vt[l * 128 + dv0 + j]; af[j] += kf * vv; ab[j] += kb * vv; }
                    }
#pragma unroll
                    for (int j = 0; j < 8; ++j) {
                        const int dv = dv0 + j;
                        ST[u0 + dv * 128 + dk] = (bf16)f2bf(af[j]);
                        ST[(size_t)1024 * 16384 + u0 + dv * 128 + dk] = (bf16)f2bf(ab[j]);
                    }
                }
                __syncthreads();
            }
        }
    }

    GRID_BAR(2);

    if constexpr (IN(3)) {
        for (size_t v = gt; v < (size_t)2 * 32 * 2048; v += ngt) {
            const int dir = (int)(v >> 16), bh = (int)((v >> 11) & 31), e8 = (int)(v & 2047), h = bh & 3;
            const float lg = log_sigmoid_f(dir == 0 ? args.in[6][h] : args.in[7][h]);
            const float Gc = expf(128.0f * lg);
            float st[8];
#pragma unroll
            for (int j = 0; j < 8; ++j) st[j] = 0.f;
            for (int ci = 0; ci < 32; ++ci) {
                const int c = (dir == 0) ? ci : 31 - ci;
                const size_t off = ((size_t)dir * 1024 + bh * 32 + c) * 16384 + (size_t)e8 * 8;
                v4u o; o.x = pk2(st[0], st[1]); o.y = pk2(st[2], st[3]); o.z = pk2(st[4], st[5]); o.w = pk2(st[6], st[7]);
                *(v4u*)(PREV + off) = o;
                const v4u s = *(const v4u*)(ST + off);
                st[0] = Gc * st[0] + bflo(s.x); st[1] = Gc * st[1] + bfhi(s.x); st[2] = Gc * st[2] + bflo(s.y); st[3] = Gc * st[3] + bfhi(s.y);
                st[4] = Gc * st[4] + bflo(s.z); st[5] = Gc * st[5] + bfhi(s.z); st[6] = Gc * st[6] + bflo(s.w); st[7] = Gc * st[7] + bfhi(s.w);
            }
        }
    }

    GRID_BAR(3);

    if constexpr (IN(4)) {
        const float* gnw = args.in[8];
        for (int ck = bx; ck < NCHUNK; ck += G) {
            const int t0 = ck * 128, bb = ck >> 5, cc = ck & 31;
#pragma unroll 1
            for (int h = 0; h < 4; ++h) {
                const float lgf = log_sigmoid_f(args.in[6][h]), lgb = log_sigmoid_f(args.in[7][h]);
                LAS float* A0 = sm;
                LAS float* A1 = sm + 16384;
                for (int i = tid; i < 16384; i += NTHREADS) {
                    const int l = i >> 7, d = i & 127;
                    A0[i] = bf2f(PROJ[(size_t)(t0 + l) * INW + 1024 + h * 128 + d]);
                    A1[l * 129 + d] = bf2f(PROJ[(size_t)(t0 + l) * INW + 1536 + h * 128 + d]);
                }
                LAS float* qwt = sm + 32896;
                if (tid < 128) { qwt[tid] = expf((float)(tid + 1) * lgf); qwt[128 + tid] = expf((float)(128 - tid) * lgb); qwt[256 + tid] = expf((float)tid * lgf); qwt[384 + tid] = expf((float)tid * lgb); }
                __syncthreads();
                const int c0 = tid & 127, lg4 = tid >> 7;
                float acc[32];
#pragma unroll
                for (int li = 0; li < 32; ++li) acc[li] = 0.f;
#pragma unroll 1
                for (int d = 0; d < 128; ++d) {
                    const float kv = A1[c0 * 129 + d];
#pragma unroll
                    for (int li = 0; li < 32; ++li) acc[li] += A0[(lg4 * 32 + li) * 128 + d] * kv;
                }
                __syncthreads();
#pragma unroll
                for (int li = 0; li < 32; ++li) {
                    const int l = lg4 * 32 + li, m = c0;
                    const float dec = (m <= l) ? qwt[256 + l - m] : qwt[384 + m - l];
                    A0[l * 128 + m] = acc[li] * dec;
                }
                for (int i = tid; i < 16384; i += NTHREADS) {
                    const int l = i >> 7, d = i & 127;
                    A1[l * 129 + d] = bf2f(PROJ[(size_t)(t0 + l) * INW + 2048 + h * 128 + d]);
                }
                __syncthreads();
                float o[32];
#pragma unroll
                for (int li = 0; li < 32; ++li) o[li] = 0.f;
#pragma unroll 1
                for (int m = 0; m < 128; ++m) {
                    const float vv = A1[m * 129 + c0];
#pragma unroll
                    for (int li = 0; li < 32; ++li) o[li] += A0[(lg4 * 32 + li) * 128 + m] * vv;
                }
                __syncthreads();
#pragma unroll 1
                for (int dir = 0; dir < 2; ++dir) {
                    const size_t u0 = ((size_t)dir * 1024 + (bb * 4 + h) * 32 + cc) * 16384;
                    __syncthreads();
                    for (int i = tid; i < 16384; i += NTHREADS) {
                        const int l = i >> 7, d = i & 127;
                        A0[i] = qwt[dir * 128 + l] * bf2f(PROJ[(size_t)(t0 + l) * INW + 1024 + h * 128 + d]);
                        A1[l * 129 + d] = bf2f(PREV[u0 + i]);
                    }
                    __syncthreads();
#pragma unroll 1
                    for (int dk = 0; dk < 128; ++dk) {
                        const float pv = A1[c0 * 129 + dk];
#pragma unroll
                        for (int li = 0; li < 32; ++li) o[li] += A0[(lg4 * 32 + li) * 128 + dk] * pv;
                    }
                }
                __syncthreads();
#pragma unroll
                for (int li = 0; li < 32; ++li) A0[(lg4 * 32 + li) * 128 + c0] = o[li];
                __syncthreads();
                for (int r = wave * 16; r < wave * 16 + 16; ++r) {
                    const float a = A0[r * 128 + lane], b = A0[r * 128 + 64 + lane];
                    const float mean = wave_sum(a + b) * (1.0f / 128.0f);
                    const float da = a - mean, db = b - mean;
                    const float rstd = 1.0f / sqrtf(wave_sum(da * da + db * db) * (1.0f / 128.0f) + GN_EPS);
                    const size_t prow = (size_t)(t0 + r) * INW + 2560 + h * 128;
                    const float ga = bf2f(PROJ[prow + lane]), gb = bf2f(PROJ[prow + 64 + lane]);
                    Y[(size_t)(t0 + r) * D + 512 + h * 128 + lane] = (bf16)f2bf(da * rstd * gnw[h * 128 + lane] * ga);
                    Y[(size_t)(t0 + r) * D + 512 + h * 128 + 64 + lane] = (bf16)f2bf(db * rstd * gnw[h * 128 + 64 + lane] * gb);
                }
                __syncthreads();
            }
        }
    }

    GRID_BAR(4);

    if constexpr (IN(5)) {
        pg8::Gemm g{Y, WOUT, M, D, D}; pg8::StaticOrder S; S.init(M, D, G, bx);
        pg8::EpiResF32 E{x, Z, D, ALPHA};
        pg8::gemm_phase<pg8::EpiResF32, pg8::StaticOrder, true, true>(lds, g, S, E);
    }

    GRID_BAR(5);

    if constexpr (IN(6)) {
        const float* w = args.in[10]; const float* b = args.in[11];
        for (int t = gw; t < M; t += NGW) {
            const f32x4* zr = (const f32x4*)(Z + (size_t)t * D) + lane;
            f32x4 v[4]; float s = 0.f;
#pragma unroll
            for (int j = 0; j < 4; ++j) { v[j] = zr[64 * j]; s += (v[j][0] + v[j][1]) + (v[j][2] + v[j][3]); }
            const float mean = wave_sum(s) * (1.0f / D); float q = 0.f;
#pragma unroll
            for (int j = 0; j < 4; ++j) { v[j] = v[j] - mean; q += (v[j][0] * v[j][0] + v[j][1] * v[j][1]) + (v[j][2] * v[j][2] + v[j][3] * v[j][3]); }
            const float rstd = 1.0f / sqrtf(wave_sum(q) * (1.0f / D) + LN_EPS);
            unsigned long long* o8 = (unsigned long long*)(H + (size_t)t * D) + lane;
#pragma unroll
            for (int j = 0; j < 4; ++j) {
                const f32x4 wv = *((const f32x4*)w + lane + 64 * j), bv = *((const f32x4*)b + lane + 64 * j);
                const f32x4 y = v[j] * rstd * wv + bv;
                o8[64 * j] = (unsigned long long)pk2(y[0], y[1]) | ((unsigned long long)pk2(y[2], y[3]) << 32);
            }
        }
    }

    GRID_BAR(6);

    if constexpr (IN(7)) {
        pg8::Gemm g{H, WQ, M, 2048, D}; pg8::StaticOrder S; S.init(M, 2048, G, bx);
        pg8::EpiPlainBf16 E{QP, 2048};
        pg8::gemm_phase<pg8::EpiPlainBf16, pg8::StaticOrder, true, true>(lds, g, S, E);
    }

    GRID_BAR(7);

    if constexpr (IN(8)) {
        const float* keys = args.in[13];
        LAS float* qs = sm;
        LAS float* sc = sm + 64 * 257;
        for (int unit = bx; unit < (M / 64) * PEER_H; unit += G) {
            const int tt0 = (unit >> 3) * 64, hd = unit & 7;
            for (int i = tid; i < 64 * 256; i += NTHREADS) { const int r = i >> 8, c = i & 255; qs[r * 257 + c] = bf2f(QP[(size_t)(tt0 + r) * 2048 + hd * 256 + c]); }
            __syncthreads();
            {
                const int tt = tid & 63, g8 = __builtin_amdgcn_readfirstlane(tid >> 6);
                for (int p = 0; p < 2; ++p) {
                    float acc[16];
#pragma unroll
                    for (int j = 0; j < 16; ++j) acc[j] = 0.f;
                    const float* kp = keys + ((size_t)(hd * 2 + p) * 128 + g8 * 16) * 128;
                    for (int d = 0; d < 128; ++d) {
                        const float qv = qs[tt * 257 + p * 128 + d];
#pragma unroll
                        for (int j = 0; j < 16; ++j) acc[j] += qv * kp[j * 128 + d];
                    }
#pragma unroll
                    for (int j = 0; j < 16; ++j) sc[tt * 257 + p * 128 + g8 * 16 + j] = acc[j];
                }
            }
            __syncthreads();
            LAS float* tops = qs;
            LAS int* topi = (LAS int*)(qs + 2048);
            LAS float* bsc = qs + 4096;
            LAS int* bps = (LAS int*)(qs + 5120);
            if (tid < 128) {
                const int tt = tid & 63, p = tid >> 6;
                LAS float* row = sc + tt * 257 + p * 128;
                for (int r = 0; r < 16; ++r) {
                    float best = -INFINITY; int bi = 0;
                    for (int n = 0; n < 128; ++n) { const float v = row[n]; if (v > best) { best = v; bi = n; } }
                    row[bi] = -INFINITY;
                    tops[(tt * 2 + p) * 16 + r] = best; topi[(tt * 2 + p) * 16 + r] = bi;
                }
            }
            __syncthreads();
            if (tid < 64) {
                const int tt = tid;
                LAS float* cand = sc + tt * 257;
                for (int a = 0; a < 16; ++a) for (int b = 0; b < 16; ++b) cand[a * 16 + b] = tops[(tt * 2) * 16 + a] + tops[(tt * 2 + 1) * 16 + b];
                float mx = -INFINITY;
                for (int r = 0; r < 16; ++r) {
                    float best = -INFINITY; int bi = 0;
                    for (int n = 0; n < 256; ++n) { const float v = cand[n]; if (v > best) { best = v; bi = n; } }
                    cand[bi] = -INFINITY;
                    bsc[tt * 16 + r] = best; bps[tt * 16 + r] = bi;
                    if (r == 0) mx = best;
                }
                float den = 0.f;
                for (int r = 0; r < 16; ++r) den += expf(bsc[tt * 16 + r] - mx);
                const float rden = 1.0f / den;
                for (int r = 0; r < 16; ++r) {
                    const int pos = bps[tt * 16 + r], a = pos >> 4, b = pos & 15;
                    const int e = topi[(tt * 2) * 16 + a] * 128 + topi[(tt * 2 + 1) * 16 + b];
                    IDX[(size_t)(tt0 + tt) * NSEL + hd * 16 + r] = e;
                    GATE[(size_t)(tt0 + tt) * NSEL + hd * 16 + r] = expf(bsc[tt * 16 + r] - mx) * rden;
                }
            }
            __syncthreads();
        }
    }

    GRID_BAR(8);

    if constexpr (IN(9)) {
        const float* w2 = args.in[16]; const float* b2 = args.in[17];
        for (int t = gw; t < M; t += NGW) {
            const v4u* hp = (const v4u*)(H + (size_t)t * D);
            const v4u ha = hp[lane], hb = hp[64 + lane];
            float hf[16] = {bflo(ha.x), bfhi(ha.x), bflo(ha.y), bfhi(ha.y), bflo(ha.z), bfhi(ha.z), bflo(ha.w), bfhi(ha.w),
                            bflo(hb.x), bfhi(hb.x), bflo(hb.y), bfhi(hb.y), bflo(hb.z), bfhi(hb.z), bflo(hb.w), bfhi(hb.w)};
            float o[16];
#pragma unroll
            for (int i = 0; i < 16; ++i) o[i] = 0.f;
            const int e_l0 = IDX[(size_t)t * NSEL + lane], e_l1 = IDX[(size_t)t * NSEL + 64 + lane];
            const float g_l0 = GATE[(size_t)t * NSEL + lane], g_l1 = GATE[(size_t)t * NSEL + 64 + lane];
            for (int j0 = 0; j0 < NSEL; j0 += 4) {
                v4u ua[4], ub[4], va[4], vb[4]; float gg[4];
#pragma unroll
                for (int k = 0; k < 4; ++k) {
                    const int j = j0 + k;
                    const int e = (j < 64) ? __shfl(e_l0, j) : __shfl(e_l1, j - 64);
                    gg[k] = (j < 64) ? __shfl(g_l0, j) : __shfl(g_l1, j - 64);
                    const v4u* up = (const v4u*)(UT + (size_t)e * D); const v4u* vp = (const v4u*)(VT + (size_t)e * D);
                    ua[k] = up[lane]; ub[k] = up[64 + lane]; va[k] = vp[lane]; vb[k] = vp[64 + lane];
                }
#pragma unroll
                for (int k = 0; k < 4; ++k) {
                    float d = hf[0] * bflo(ua[k].x) + hf[1] * bfhi(ua[k].x) + hf[2] * bflo(ua[k].y) + hf[3] * bfhi(ua[k].y)
                            + hf[4] * bflo(ua[k].z) + hf[5] * bfhi(ua[k].z) + hf[6] * bflo(ua[k].w) + hf[7] * bfhi(ua[k].w)
                            + hf[8] * bflo(ub[k].x) + hf[9] * bfhi(ub[k].x) + hf[10] * bflo(ub[k].y) + hf[11] * bfhi(ub[k].y)
                            + hf[12] * bflo(ub[k].z) + hf[13] * bfhi(ub[k].z) + hf[14] * bflo(ub[k].w) + hf[15] * bfhi(ub[k].w);
                    d = wave_sum(d);
                    const float c = gg[k] * gelu_exact(d);
                    o[0] += c * bflo(va[k].x); o[1] += c * bfhi(va[k].x); o[2] += c * bflo(va[k].y); o[3] += c * bfhi(va[k].y);
                    o[4] += c * bflo(va[k].z); o[5] += c * bfhi(va[k].z); o[6] += c * bflo(va[k].w); o[7] += c * bfhi(va[k].w);
                    o[8] += c * bflo(vb[k].x); o[9] += c * bfhi(vb[k].x); o[10] += c * bflo(vb[k].y); o[11] += c * bfhi(vb[k].y);
                    o[12] += c * bflo(vb[k].z); o[13] += c * bfhi(vb[k].z); o[14] += c * bflo(vb[k].w); o[15] += c * bfhi(vb[k].w);
                }
            }
            float s = 0.f;
#pragma unroll
            for (int i = 0; i < 16; ++i) { o[i] = ALPHA * hf[i] + o[i]; s += o[i]; }
            const float mean = wave_sum(s) * (1.0f / D); float q = 0.f;
#pragma unroll
            for (int i = 0; i < 16; ++i) { o[i] -= mean; q += o[i] * o[i]; }
            const float rstd = 1.0f / sqrtf(wave_sum(q) * (1.0f / D) + LN_EPS);
            float* orow = args.out + (size_t)t * D;
#pragma unroll
            for (int hseg = 0; hseg < 2; ++hseg) {
                const int c0 = hseg * 512 + lane * 8;
                const f32x4 wa = *(const f32x4*)(w2 + c0), wb = *(const f32x4*)(w2 + c0 + 4), ba = *(const f32x4*)(b2 + c0), bb4 = *(const f32x4*)(b2 + c0 + 4);
                f32x4 ya, yb;
#pragma unroll
                for (int i = 0; i < 4; ++i) { ya[i] = o[hseg * 8 + i] * rstd * wa[i] + ba[i]; yb[i] = o[hseg * 8 + 4 + i] * rstd * wb[i] + bb4[i]; }
                *(f32x4*)(orow + c0) = ya; *(f32x4*)(orow + c0 + 4) = yb;
            }
        }
    }
#undef IN
#undef BOTH
#undef GRID_BAR
}

extern "C" void kernel_launch(void* const* d_in, const int* in_sizes, int n_in, void* d_out, int out_size, void* d_ws, size_t ws_size, hipStream_t stream) {
    static int grid = 0;
    if (grid == 0) {
        if (n_in != 18 || in_sizes[0] != M * D || out_size != M * D || ws_size < WS_END) {
            fprintf(stderr, "kernel_launch: unexpected shapes: n_in %d in0 %d out %d ws %zu\n", n_in, n_in > 0 ? in_sizes[0] : -1, out_size, ws_size); grid = -1; return; }
        int dev = 0, cus = 0;
        if (hipGetDevice(&dev) != hipSuccess || hipDeviceGetAttribute(&cus, hipDeviceAttributeMultiprocessorCount, dev) != hipSuccess) { grid = -1; return; }
        bool ok = true;
#if N_LAUNCHES == 1
        ok = (hipFuncSetAttribute((const void*)fwd_kernel<0, 10>, hipFuncAttributeMaxDynamicSharedMemorySize, LDS_BYTES) == hipSuccess);
#else
#define SETATTR(k) ok = ok && (hipFuncSetAttribute((const void*)fwd_kernel<k, k + 1>, hipFuncAttributeMaxDynamicSharedMemorySize, LDS_BYTES) == hipSuccess)
        SETATTR(0); SETATTR(1); SETATTR(2); SETATTR(3); SETATTR(4); SETATTR(5); SETATTR(6); SETATTR(7); SETATTR(8); SETATTR(9);
#undef SETATTR
#endif
        if (!ok) { fprintf(stderr, "kernel_launch: hipFuncSetAttribute failed\n"); grid = -1; return; }
        grid = cus;
    }
    if (grid < 0) return;
    (void)hipMemsetAsync((char*)d_ws + WS_CTL, 0, CTL_ZERO_BYTES, stream);
    Args a{};
    for (int i = 0; i < 18; ++i) a.in[i] = (const float*)d_in[i];
    a.out = (float*)d_out; a.ws = (unsigned char*)d_ws;
    a.ph_lo = 0; a.ph_hi = 10;
#if N_LAUNCHES == 1
    hipLaunchKernelGGL((fwd_kernel<0, 10>), dim3(grid), dim3(NTHREADS), LDS_BYTES, stream, a);
#else
#define LAUNCH(k) hipLaunchKernelGGL((fwd_kernel<k, k + 1>), dim3(grid), dim3(NTHREADS), LDS_BYTES, stream, a)
    LAUNCH(0); LAUNCH(1); LAUNCH(2); LAUNCH(3); LAUNCH(4); LAUNCH(5); LAUNCH(6); LAUNCH(7); LAUNCH(8); LAUNCH(9);
#undef LAUNCH
#endif
}
```

```cpp
#include <hip/hip_runtime.h>
#include <cstdio>
#include <cstdint>
#include <cmath>
namespace pg8 {
#define PG8_LAS __attribute__((address_space(3)))
typedef unsigned short bf16_t;
typedef short bf16x8 __attribute__((ext_vector_type(8)));
typedef float f32x4 __attribute__((ext_vector_type(4)));
typedef unsigned u32x4 __attribute__((ext_vector_type(4)));
constexpr int BM = 256, BK = 64, HALF = 128, HTB = HALF * BK * 2  , STAGE_BYTES = 8 * HTB, NXCD = 8, WGM = 8;

__host__ __device__ __forceinline__ int lds_byte(int r, int c) { const int st = (r >> 4) * 2 + (c >> 5), rr = r & 15, cc = c & 31, ob = rr * 64 + cc * 2; return st * 1024 + (ob ^ (((ob >> 9) & 1) << 5)); }
__host__ __device__ __forceinline__ void stage_rc(int b, int& R, int& C) { const int st = b / 1024, sb = b % 1024, swz = sb ^ (((sb >> 9) & 1) << 5); R = (st >> 1) * 16 + swz / 64; C = (st & 1) * 32 + (swz % 64) / 2; }
__host__ __device__ __forceinline__ int perm32(int rho) { const int n = rho >> 4, i = rho & 15; return 8 * (i >> 2) + 4 * n + (i & 3); }

struct Unit { int pm, pn; };
struct Gemm { const bf16_t* A; const bf16_t* Bt; int M, N, K; };

struct StaticOrder {
    int nM, nN, nwg, G, c;
    __host__ __device__ void init(int M, int N, int G_, int c_) { nM = M / BM; nN = N / BM; nwg = nM * nN; G = G_; c = c_; }
    __host__ __device__ bool next(int i, Unit& u) const {
        const long L = (long)i * G + c; if (L >= nwg) return false;
        int wgid = (int)L; { const int q = nwg / NXCD, r = nwg % NXCD, xcd = wgid % NXCD, off = wgid / NXCD; wgid = (xcd < r ? xcd * (q + 1) : r * (q + 1) + (xcd - r) * q) + off; }
        const int nig = WGM * nN, gid = wgid / nig, fm = gid * WGM, gsz = (nM - fm) < WGM ? (nM - fm) : WGM;
        u.pm = fm + ((wgid % nig) % gsz); u.pn = (wgid % nig) / gsz; return true;
    }
    __device__ __forceinline__ void a_ready(const Unit&) const {}
    __device__ __forceinline__ void done(const Unit&) const {}
};

__device__ __forceinline__ unsigned cvt_pk_bf16(float lo, float hi) { unsigned r; asm volatile("v_cvt_pk_bf16_f32 %0, %1, %2" : "=v"(r) : "v"(lo), "v"(hi)); return r; }
typedef float f32x2 __attribute__((ext_vector_type(2)));
__device__ __forceinline__ f32x2 gelu_pk(f32x2 v) {
    const f32x2 av = __builtin_elementwise_abs(v), d = av * 0.2316418882f + 1.0f;
    f32x2 t; t.x = __builtin_amdgcn_rcpf(d.x); t.y = __builtin_amdgcn_rcpf(d.y);
    f32x2 q = t * 0.5307027145f + (-0.7265760135f); q = q * t + 0.7107068705f; q = q * t + (-0.142248368f); q = q * t + 0.127414796f; q = q * t;
    const f32x2 s = (v * v) * (-0.72134752044f);
    f32x2 e; e.x = __builtin_amdgcn_exp2f(s.x); e.y = __builtin_amdgcn_exp2f(s.y);
    const f32x2 m = v * (q * e), r = v - m;
    f32x2 o; o.x = v.x < 0.f ? m.x : r.x; o.y = v.y < 0.f ? m.y : r.y; return o;
}

__device__ __forceinline__ float silu_f(float v) { return v * __builtin_amdgcn_rcpf(1.0f + __expf(-v)); }
struct EpiProj {
    static constexpr bool PERM = true, AFTER_DRAIN = false;
    bf16_t* O; const float* rope;
    __device__ __forceinline__ void operator()(const f32x4 (&acc)[2][2][4][2], const Unit& u, int wr, int wc, int fr, int fq) const {
        const int sec = u.pn >> 1;
        const int row0 = u.pm * BM + wr * 64 + fr, col0 = u.pn * BM + wc * 32 + 8 * fq;
        const int i0 = wc * 16 + 4 * fq;
#pragma unroll
        for (int ai = 0; ai < 2; ++ai)
#pragma unroll
            for (int m = 0; m < 4; ++m) {
                const int row = row0 + ai * HALF + m * 16;
                bf16_t* rowp = O + (size_t)row * 3072 + col0;
                f32x4 r0 = (f32x4){1.f, 0.f, 1.f, 0.f}, r1 = r0;
                if (sec == 2 || sec == 3) { const f32x4* rp = (const f32x4*)(rope + ((size_t)(row & 4095) * 64 + i0) * 2); r0 = rp[0]; r1 = rp[1]; }
#pragma unroll
                for (int bj = 0; bj < 2; ++bj) {
                    f32x4 v0 = acc[ai][bj][m][0], v1 = acc[ai][bj][m][1];
                    if (sec <= 1) {
                        f32x2 a = gelu_pk((f32x2){v0[0], v0[1]}), b = gelu_pk((f32x2){v0[2], v0[3]}), c = gelu_pk((f32x2){v1[0], v1[1]}), d = gelu_pk((f32x2){v1[2], v1[3]});
                        v0 = (f32x4){a.x, a.y, b.x, b.y}; v1 = (f32x4){c.x, c.y, d.x, d.y};
                    } else if (sec <= 3) {
                        const float sc = (sec == 3) ? 0.08838834764831845f : 1.0f;
                        f32x4 w0, w1;
                        w0[0] = (v0[0] * r0[0] - v0[1] * r0[1]) * sc; w0[1] = (v0[0] * r0[1] + v0[1] * r0[0]) * sc;
                        w0[2] = (v0[2] * r0[2] - v0[3] * r0[3]) * sc; w0[3] = (v0[2] * r0[3] + v0[3] * r0[2]) * sc;
                        w1[0] = (v1[0] * r1[0] - v1[1] * r1[1]) * sc; w1[1] = (v1[0] * r1[1] + v1[1] * r1[0]) * sc;
                        w1[2] = (v1[2] * r1[2] - v1[3] * r1[3]) * sc; w1[3] = (v1[2] * r1[3] + v1[3] * r1[2]) * sc;
                        v0 = w0; v1 = w1;
                    } else if (sec == 5) {
#pragma unroll
                        for (int j = 0; j < 4; ++j) { v0[j] = silu_f(v0[j]); v1[j] = silu_f(v1[j]); }
                    }
                    u32x4 w; w.x = cvt_pk_bf16(v0[0], v0[1]); w.y = cvt_pk_bf16(v0[2], v0[3]); w.z = cvt_pk_bf16(v1[0], v1[1]); w.w = cvt_pk_bf16(v1[2], v1[3]);
                    *(u32x4*)(rowp + bj * HALF) = w;
                }
            }
    }
};
struct EpiPlainBf16 {
    static constexpr bool PERM = true, AFTER_DRAIN = false;
    bf16_t* O; int ldc;
    __device__ __forceinline__ void operator()(const f32x4 (&acc)[2][2][4][2], const Unit& u, int wr, int wc, int fr, int fq) const {
        const int row0 = u.pm * BM + wr * 64 + fr, col0 = u.pn * BM + wc * 32 + 8 * fq;
#pragma unroll
        for (int ai = 0; ai < 2; ++ai)
#pragma unroll
            for (int m = 0; m < 4; ++m) { bf16_t* rowp = O + (size_t)(row0 + ai * HALF + m * 16) * ldc + col0;
#pragma unroll
                for (int bj = 0; bj < 2; ++bj) { const f32x4 v0 = acc[ai][bj][m][0], v1 = acc[ai][bj][m][1];
                    u32x4 w; w.x = cvt_pk_bf16(v0[0], v0[1]); w.y = cvt_pk_bf16(v0[2], v0[3]); w.z = cvt_pk_bf16(v1[0], v1[1]); w.w = cvt_pk_bf16(v1[2], v1[3]);
                    *(u32x4*)(rowp + bj * HALF) = w; } }
    }
};
struct EpiResF32 {
    static constexpr bool PERM = false, AFTER_DRAIN = false;
    const float* X; float* Z; int ldc; float alpha;
    __device__ __forceinline__ void operator()(const f32x4 (&acc)[2][2][4][2], const Unit& u, int wr, int wc, int fr, int fq) const {
        const int row0 = u.pm * BM + wr * 64 + fr, col0 = u.pn * BM + wc * 32 + 4 * fq;
#pragma unroll
        for (int ai = 0; ai < 2; ++ai)
#pragma unroll
            for (int m = 0; m < 4; ++m) { const size_t off = (size_t)(row0 + ai * HALF + m * 16) * ldc + col0;
#pragma unroll
                for (int bj = 0; bj < 2; ++bj)
#pragma unroll
                    for (int n = 0; n < 2; ++n) { const f32x4 xv = *(const f32x4*)(X + off + bj * HALF + n * 16); *(f32x4*)(Z + off + bj * HALF + n * 16) = acc[ai][bj][m][n] + xv * alpha; } }
    }
};
template <class Epi, class Sched, bool ALIGN_EPI = false, bool SP2 = false>
__device__ __forceinline__ void gemm_phase(PG8_LAS unsigned char* lds, const Gemm g, const Sched& S, const Epi& E) {
    const int tid = threadIdx.x, wid = __builtin_amdgcn_readfirstlane(tid >> 6), lane = tid & 63, wr = wid >> 2, wc = wid & 3, fr = lane & 15, fq = lane >> 4;
    const int K = g.K, nt = K / BK;
    unsigned voffA[2], voffB[2];
#pragma unroll
    for (int i = 0; i < 2; ++i) { int R, C; stage_rc(tid * 16 + i * 8192, R, C); const int Rb = Epi::PERM ? ((R & ~31) + perm32(R & 31)) : R;
        voffA[i] = (unsigned)(R * K + C) * 2u; voffB[i] = (unsigned)(Rb * K + C) * 2u; }
    const size_t kstep = (size_t)(BK * 2);
    const size_t hstep = (size_t)HALF * K * 2;
    const size_t tstep = 2 * hstep;
    const unsigned ldsw = (unsigned)wid * 1024u;
    const int aoff = lds_byte(wr * 64 + fr, fq * 8), boff = lds_byte(wc * 32 + fr, fq * 8);
#define PG8_SA(b, h) (((b) * 2 + (h)) * HTB)
#define PG8_SB(b, h) ((4 + (b) * 2 + (h)) * HTB)
#define PG8_STAGE(bufoff, gbase, voff) do { _Pragma("unroll") for (int _i = 0; _i < 2; ++_i) \
        __builtin_amdgcn_global_load_lds((const unsigned*)((const char*)(gbase) + (voff)[_i]), (PG8_LAS unsigned*)(lds + (bufoff) + ldsw + _i * 8192), 16, 0, 0); } while (0)
#define PG8_LDA(dst, b, h) do { _Pragma("unroll") for (int m = 0; m < 4; ++m) _Pragma("unroll") for (int k = 0; k < 2; ++k) dst[m][k] = *(const PG8_LAS bf16x8*)(lds + PG8_SA(b, h) + aoff + m * 2048 + k * 1024); } while (0)
#define PG8_LDB(dst, b, h) do { _Pragma("unroll") for (int n = 0; n < 2; ++n) _Pragma("unroll") for (int k = 0; k < 2; ++k) dst[n][k] = *(const PG8_LAS bf16x8*)(lds + PG8_SB(b, h) + boff + n * 2048 + k * 1024); } while (0)
#define PG8_MMA(ai, bj, At, Bt) do { __builtin_amdgcn_s_setprio(1); _Pragma("unroll") for (int m = 0; m < 4; ++m) _Pragma("unroll") for (int n = 0; n < 2; ++n) _Pragma("unroll") for (int k = 0; k < 2; ++k) \
        acc[ai][bj][m][n] = __builtin_amdgcn_mfma_f32_16x16x32_bf16(Bt[n][k], At[m][k], acc[ai][bj][m][n], 0, 0, 0); __builtin_amdgcn_s_setprio(0); } while (0)
#define PG8_WAIT_V(n) asm volatile("s_waitcnt vmcnt(" #n ")" ::: "memory")
#define PG8_WAIT_L(n) asm volatile("s_waitcnt lgkmcnt(" #n ")" ::: "memory")
#define PG8_BAR __builtin_amdgcn_s_barrier()
#define PG8_SCHED __builtin_amdgcn_sched_barrier(0)
    Unit cur, nxt; int ui = 0;
    if (!S.next(0, cur)) return;
    f32x4 acc[2][2][4][2];
#pragma unroll
    for (int a = 0; a < 2; ++a)
#pragma unroll
        for (int b = 0; b < 2; ++b)
#pragma unroll
            for (int m = 0; m < 4; ++m)
#pragma unroll
                for (int n = 0; n < 2; ++n) acc[a][b][m][n] = (f32x4){0.f, 0.f, 0.f, 0.f};
    bf16x8 At[4][2], B0[2][2], B1[2][2];
    const char* cA = (const char*)g.A + (size_t)cur.pm * tstep; const char* cB = (const char*)g.Bt + (size_t)cur.pn * tstep;
    S.a_ready(cur);
    if constexpr (SP2) {
        PG8_STAGE(PG8_SB(0, 0), cB, voffB); PG8_STAGE(PG8_SB(0, 1), cB + hstep, voffB); PG8_STAGE(PG8_SA(0, 0), cA, voffA); PG8_STAGE(PG8_SA(0, 1), cA + hstep, voffA);
        if (wr == 1) PG8_BAR;
        PG8_WAIT_V(2); PG8_BAR;
        PG8_STAGE(PG8_SB(1, 0), cB + kstep, voffB); PG8_STAGE(PG8_SA(1, 0), cA + kstep, voffA); PG8_STAGE(PG8_SB(1, 1), cB + hstep + kstep, voffB);
        PG8_WAIT_V(6); PG8_BAR;
    } else {
        PG8_STAGE(PG8_SB(0, 0), cB, voffB); PG8_STAGE(PG8_SA(0, 0), cA, voffA); PG8_STAGE(PG8_SB(0, 1), cB + hstep, voffB); PG8_STAGE(PG8_SA(0, 1), cA + hstep, voffA);
        if (wr == 1) PG8_BAR;
        PG8_WAIT_V(4); PG8_BAR;
        PG8_STAGE(PG8_SB(1, 0), cB + kstep, voffB); PG8_STAGE(PG8_SA(1, 0), cA + kstep, voffA); PG8_STAGE(PG8_SB(1, 1), cB + hstep + kstep, voffB);
        PG8_WAIT_V(6); PG8_BAR;
    }
    for (;;) {
        const bool has_next = S.next(ui + 1, nxt);
        const char* nA = has_next ? (const char*)g.A + (size_t)nxt.pm * tstep : cA; const char* nB = has_next ? (const char*)g.Bt + (size_t)nxt.pn * tstep : cB;
        for (int t = 0; t < nt; t += 2) {
            const bool last = (t == nt - 2);
            const char* a1 = cA + (size_t)(t + 1) * kstep;
            const char* a2 = last ? nA : cA + (size_t)(t + 2) * kstep; const char* b2 = last ? nB : cB + (size_t)(t + 2) * kstep;
            const char* a3 = a2 + kstep; const char* b3 = b2 + kstep;
            if (last && has_next) S.a_ready(nxt);
            if constexpr (SP2) {
            PG8_LDB(B0, 0, 0); PG8_LDB(B1, 0, 1); PG8_SCHED; PG8_LDA(At, 0, 0); PG8_STAGE(PG8_SA(1, 1), a1 + hstep, voffA);
            PG8_WAIT_V(8); PG8_WAIT_L(0); PG8_BAR; PG8_MMA(0, 0, At, B0); PG8_MMA(0, 1, At, B1); PG8_BAR; PG8_SCHED;
            PG8_LDA(At, 0, 1); PG8_STAGE(PG8_SB(0, 0), b2, voffB); PG8_STAGE(PG8_SB(0, 1), b2 + hstep, voffB); PG8_STAGE(PG8_SA(0, 0), a2, voffA);
            PG8_WAIT_V(8); PG8_WAIT_L(0); PG8_BAR; PG8_MMA(1, 0, At, B0); PG8_MMA(1, 1, At, B1); PG8_BAR; PG8_SCHED;
            PG8_LDB(B0, 1, 0); PG8_LDB(B1, 1, 1); PG8_SCHED; PG8_LDA(At, 1, 0); PG8_STAGE(PG8_SA(0, 1), a2 + hstep, voffA);
            PG8_WAIT_V(8); PG8_WAIT_L(0); PG8_BAR; PG8_MMA(0, 0, At, B0); PG8_MMA(0, 1, At, B1); PG8_BAR; PG8_SCHED;
            PG8_LDA(At, 1, 1); PG8_STAGE(PG8_SB(1, 0), b3, voffB); PG8_STAGE(PG8_SB(1, 1), b3 + hstep, voffB); PG8_STAGE(PG8_SA(1, 0), a3, voffA);
            PG8_WAIT_V(8); PG8_WAIT_L(0); PG8_BAR; PG8_MMA(1, 0, At, B0); PG8_MMA(1, 1, At, B1); PG8_BAR; PG8_SCHED;
            } else {
            PG8_LDB(B0, 0, 0); PG8_SCHED; PG8_LDA(At, 0, 0); PG8_STAGE(PG8_SA(1, 1), a1 + hstep, voffA);
            PG8_WAIT_L(8); PG8_BAR; PG8_WAIT_L(0); PG8_MMA(0, 0, At, B0); PG8_BAR; PG8_SCHED;
            PG8_LDB(B1, 0, 1); PG8_STAGE(PG8_SB(0, 0), b2, voffB);
            PG8_BAR; PG8_WAIT_L(0); PG8_MMA(0, 1, At, B1); PG8_BAR;
            PG8_LDA(At, 0, 1); PG8_STAGE(PG8_SA(0, 0), a2, voffA);
            PG8_BAR; PG8_WAIT_L(0); PG8_MMA(1, 0, At, B0); PG8_BAR; PG8_SCHED;
            PG8_STAGE(PG8_SB(0, 1), b2 + hstep, voffB);
            PG8_WAIT_V(6); PG8_BAR; PG8_MMA(1, 1, At, B1); PG8_BAR;
            PG8_LDB(B0, 1, 0); PG8_SCHED; PG8_LDA(At, 1, 0); PG8_STAGE(PG8_SA(0, 1), a2 + hstep, voffA);
            PG8_WAIT_L(8); PG8_BAR; PG8_WAIT_L(0); PG8_MMA(0, 0, At, B0); PG8_BAR; PG8_SCHED;
            PG8_LDB(B1, 1, 1); PG8_STAGE(PG8_SB(1, 0), b3, voffB);
            PG8_BAR; PG8_WAIT_L(0); PG8_MMA(0, 1, At, B1); PG8_BAR;
            PG8_LDA(At, 1, 1); PG8_STAGE(PG8_SA(1, 0), a3, voffA);
            PG8_BAR; PG8_WAIT_L(0); PG8_MMA(1, 0, At, B0); PG8_BAR; PG8_SCHED;
            PG8_STAGE(PG8_SB(1, 1), b3 + hstep, voffB);
            PG8_WAIT_V(6); PG8_BAR; PG8_MMA(1, 1, At, B1); PG8_BAR;
            }
        }
        if constexpr (ALIGN_EPI) { if (wr == 0) PG8_BAR; }
        if constexpr (!Epi::AFTER_DRAIN) { E(acc, cur, wr, wc, fr, fq); S.done(cur); }
        if (!has_next) break;
#pragma unroll
        for (int a = 0; a < 2; ++a)
#pragma unroll
            for (int b = 0; b < 2; ++b)
#pragma unroll
                for (int m = 0; m < 4; ++m)
#pragma unroll
                    for (int n = 0; n < 2; ++n) acc[a][b][m][n] = (f32x4){0.f, 0.f, 0.f, 0.f};
        cur = nxt; cA = nA; cB = nB; ++ui;
        if constexpr (ALIGN_EPI) { if (wr == 1) PG8_BAR; }
    }
    PG8_WAIT_V(0);
    if constexpr (!ALIGN_EPI) { if (wr == 0) PG8_BAR; }
    PG8_BAR;
    if constexpr (Epi::AFTER_DRAIN) { E.fused(acc, cur, wr, wc, fr, fq, lds, wid, lane); S.done(cur); }
#undef PG8_SA
#undef PG8_SB
#undef PG8_STAGE
#undef PG8_LDA
#undef PG8_LDB
#undef PG8_MMA
#undef PG8_WAIT_V
#undef PG8_WAIT_L
#undef PG8_BAR
#undef PG8_SCHED
}
}
#ifndef REP0
#define REP0 1
#endif
#ifndef REP1
#define REP1 1
#endif
#ifndef REP2
#define REP2 1
#endif
#ifndef REP3
#define REP3 1
#endif
#ifndef REP4
#define REP4 1
#endif
#ifndef REP5
#define REP5 1
#endif
#ifndef REP6
#define REP6 1
#endif
#ifndef REP7
#define REP7 1
#endif
#ifndef REP8
#define REP8 1
#endif
#ifndef REP9
#define REP9 1
#endif
#ifndef NAIVE_P4
#define NAIVE_P4 0
#endif
#ifndef NAIVE_P2
#define NAIVE_P2 0
#endif
#ifndef NAIVE_P8
#define NAIVE_P8 0
#endif
#ifndef N_LAUNCHES
#define N_LAUNCHES 1
#endif
constexpr int NWAVES = 8, NTHREADS = 512;
constexpr int BATCH = 8, SEQ = 4096, D = 1024, M = BATCH * SEQ;
constexpr int INW = 3072;
constexpr int NCHUNK = M / 128;
constexpr int PEER_H = 8, PEER_K = 16, NSEL = 128, NEXP = 16384;
constexpr float LN_EPS = 1e-5f, GN_EPS = 1e-5f;
constexpr float ALPHA = 1.189207115002721f;

constexpr size_t MiB = 1u << 20;
constexpr size_t WS_CTL = 0, CTL_ZERO_BYTES = 1 * MiB;
constexpr size_t WS_SKB = 1 * MiB;
constexpr size_t WS_WSB = 1 * MiB + 512 * 1024;
constexpr size_t WS_ROPE = 2 * MiB;
constexpr size_t WS_WIN = 4 * MiB;
constexpr size_t WS_WOUT = 10 * MiB;
constexpr size_t WS_WQ = 12 * MiB;
constexpr size_t WS_UT = 16 * MiB;
constexpr size_t WS_VT = 48 * MiB;
constexpr size_t WS_PROJ = 80 * MiB;
constexpr size_t WS_Z = 80 * MiB;
constexpr size_t WS_IDX = 80 * MiB;
constexpr size_t WS_GATE = 96 * MiB;
constexpr size_t WS_H = 208 * MiB;
constexpr size_t WS_XB = 272 * MiB;
constexpr size_t WS_Y = 272 * MiB;
constexpr size_t WS_ST = 336 * MiB;
constexpr size_t WS_PREV = 400 * MiB;
constexpr size_t WS_QP = 336 * MiB;
constexpr size_t WS_END = 464 * MiB;

constexpr int LDS_BYTES = 147456;

#define GAS __attribute__((address_space(1)))
#define LAS __attribute__((address_space(3)))
typedef unsigned short bf16;
typedef unsigned v4u __attribute__((ext_vector_type(4)));
typedef float f32x4 __attribute__((ext_vector_type(4)));

__device__ __forceinline__ unsigned f2bf(float f) { unsigned u = __builtin_bit_cast(unsigned, f); return (u + 0x7fffu + ((u >> 16) & 1u)) >> 16; }
__device__ __forceinline__ unsigned pk2(float lo, float hi) { return f2bf(lo) | (f2bf(hi) << 16); }
__device__ __forceinline__ float bf2f(unsigned short b) { return __builtin_bit_cast(float, (unsigned)b << 16); }
__device__ __forceinline__ float bflo(unsigned w) { return __builtin_bit_cast(float, w << 16); }
__device__ __forceinline__ float bfhi(unsigned w) { return __builtin_bit_cast(float, w & 0xffff0000u); }
__device__ __forceinline__ float wave_sum(float v) {
#pragma unroll
    for (int o = 1; o < 64; o <<= 1) v += __shfl_xor(v, o);
    return v;
}
__device__ __forceinline__ float gelu_exact(float v) { return 0.5f * v * (1.0f + erff(v * 0.70710678118654752f)); }
__device__ __forceinline__ float log_sigmoid_f(float x) { return -log1pf(expf(-x)); }

typedef short bf16x8 __attribute__((ext_vector_type(8)));
typedef short s16x4 __attribute__((ext_vector_type(4)));
typedef unsigned v2u __attribute__((ext_vector_type(2)));
__device__ __forceinline__ unsigned off_b(unsigned row, unsigned ch) { return 256u * row + 16u * (ch ^ (((row & 3u) << 2) | ((row >> 2) & 3u))); }
__device__ __forceinline__ bf16x8 frag_row(const LAS unsigned char* tile, int lane, int rb, int s) {
    return *(const LAS bf16x8*)(tile + off_b((unsigned)((lane & 15) + 16 * rb), (unsigned)(4 * s + (lane >> 4))));
}
__device__ __forceinline__ bf16x8 frag_tr(const LAS unsigned char* tile, int lane, int c, int ks) {
    const unsigned g = (unsigned)lane >> 4, q = ((unsigned)lane & 15u) >> 2, p = (unsigned)lane & 3u;
    const unsigned a0 = off_b(32u * ks + 8u * g + q, 2u * c + (p >> 1)) + 8u * (p & 1u);
    const unsigned a1 = off_b(32u * ks + 8u * g + 4u + q, 2u * c + (p >> 1)) + 8u * (p & 1u);
    typedef short v4i16_t __attribute__((ext_vector_type(4)));
    const s16x4 lo = __builtin_bit_cast(s16x4, __builtin_amdgcn_ds_read_tr16_b64_v4i16((LAS v4i16_t*)(tile + a0)));
    const s16x4 hi = __builtin_bit_cast(s16x4, __builtin_amdgcn_ds_read_tr16_b64_v4i16((LAS v4i16_t*)(tile + a1)));
    return (bf16x8){lo[0], lo[1], lo[2], lo[3], hi[0], hi[1], hi[2], hi[3]};
}
#define MFMA16(a, b, c) __builtin_amdgcn_mfma_f32_16x16x32_bf16((a), (b), (c), 0, 0, 0)
__device__ __forceinline__ void stage_tile(LAS unsigned char* tile, const bf16* src, int ld, int tid) {
    v4u v[4];
#pragma unroll
    for (int i = 0; i < 4; ++i) { const int c = tid + NTHREADS * i, row = c >> 4, ch = c & 15; v[i] = *(const v4u*)(src + (size_t)row * ld + ch * 8); }
#pragma unroll
    for (int i = 0; i < 4; ++i) { const int c = tid + NTHREADS * i, row = c >> 4, ch = c & 15; *(LAS v4u*)(tile + off_b(row, ch)) = v[i]; }
}
__device__ __forceinline__ v4u scale_chunk(v4u v, float s) {
    v4u o; o.x = pk2(bflo(v.x) * s, bfhi(v.x) * s); o.y = pk2(bflo(v.y) * s, bfhi(v.y) * s); o.z = pk2(bflo(v.z) * s, bfhi(v.z) * s); o.w = pk2(bflo(v.w) * s, bfhi(v.w) * s); return o;
}

__device__ __forceinline__ int f2key(float v, int payload) { const int b = __float_as_int(v); const int t = b ^ ((b >> 31) & 0x7fffffff); return (t & ~0xFF) | payload; }
__device__ __forceinline__ float key2f(int k) { const int t = k & ~0xFF; return __int_as_float(t ^ ((t >> 31) & 0x7fffffff)); }
__device__ __forceinline__ void merge16_desc(int (&k)[16]) {
#pragma unroll
    for (int stride = 8; stride > 0; stride >>= 1)
#pragma unroll
        for (int i = 0; i < 16; ++i) { const int l = i ^ stride; if (l > i) { const int a = k[i], b = k[l]; k[i] = max(a, b); k[l] = min(a, b); } }
}
__device__ __forceinline__ void sort16_desc(int (&k)[16]) {
#pragma unroll
    for (int size = 2; size <= 16; size <<= 1)
#pragma unroll
        for (int stride = size >> 1; stride > 0; stride >>= 1)
#pragma unroll
            for (int i = 0; i < 16; ++i) { const int l = i ^ stride; if (l > i) { const int a = k[i], b = k[l]; const bool desc = ((i & size) == 0); k[i] = desc ? max(a, b) : min(a, b); k[l] = desc ? min(a, b) : max(a, b); } }
}

#define XB_TMO      128
#define XB_XCNT(j)  (256  + 64 * (j))
#define XB_XSUB(j)  (1280 + 64 * (j))
#define XB_XGEN(j)  (2304 + 64 * (j))
#define XB_TOP      3328
#define XB_TOPGEN   3392
#define XCD_BAR_WORDS 3456
#define XB_SPIN_CAP (1u << 18)

__device__ __forceinline__ unsigned xb_ld(unsigned* p)              { return __hip_atomic_load(p, __ATOMIC_RELAXED, __HIP_MEMORY_SCOPE_AGENT); }
__device__ __forceinline__ unsigned xb_add(unsigned* p, unsigned v) { return __hip_atomic_fetch_add(p, v, __ATOMIC_RELAXED, __HIP_MEMORY_SCOPE_AGENT); }
__device__ __forceinline__ unsigned xb_xcc_id() { return (unsigned)__builtin_amdgcn_s_getreg((3 << 11) | 20) & 0xFu; }
#define XB_SPIN(cond, bar) do { unsigned _sp = 0; while (cond) { __builtin_amdgcn_s_sleep(1); \
    if ((++_sp & 255u) == 0u) { if (xb_ld(&(bar)[XB_TMO])) break; if (_sp > XB_SPIN_CAP) { atomicAdd(&(bar)[XB_TMO], 1u); break; } } } } while (0)

struct XcdBarrier {
    unsigned* bar; unsigned x;
    volatile LAS unsigned* st;
};

__device__ __forceinline__ XcdBarrier xcd_barrier_post(unsigned* bar, volatile LAS unsigned* st) {
    XcdBarrier b; b.bar = bar; b.x = xb_xcc_id(); b.st = st;
    if (threadIdx.x == 0) (void)xb_add(&bar[XB_XCNT(b.x)], 1u);
    return b;
}
__device__ __forceinline__ void xcd_barrier_complete(unsigned* bar, unsigned x, unsigned& nloc, unsigned& nx) {
    const unsigned G = gridDim.x * gridDim.y * gridDim.z;
    unsigned sum, cnt, mine, sp = 0u;
    for (;;) {
        sum = 0u; cnt = 0u; mine = 0u;
#pragma unroll
        for (unsigned j = 0; j < 16; ++j) { const unsigned c = xb_ld(&bar[XB_XCNT(j)]); sum += c; cnt += (c > 0u) ? 1u : 0u; mine = (j == x) ? c : mine; }
        if (sum == G) break;
        __builtin_amdgcn_s_sleep(1);
        if ((++sp & 255u) == 0u) { if (xb_ld(&bar[XB_TMO])) break; if (sp > XB_SPIN_CAP) { atomicAdd(&bar[XB_TMO], 1u); break; } }
    }
    nloc = mine > 0u ? mine : 1u; nx = cnt > 0u ? cnt : 1u;
}

__device__ __forceinline__ void xcd_barrier(const XcdBarrier& b) {
    asm volatile("s_waitcnt vmcnt(0)" ::: "memory");
    __syncthreads();
    if (threadIdx.x == 0) {
        unsigned* bar = b.bar;
        __builtin_amdgcn_s_waitcnt(0);
        unsigned nloc = b.st[0], nx = b.st[1];
        if (nloc == 0u) { xcd_barrier_complete(bar, b.x, nloc, nx); b.st[0] = nloc; b.st[1] = nx; }
        const unsigned old = xb_add(&bar[XB_XSUB(b.x)], 1u);
        const unsigned gen = old / nloc;
        if (old + 1u == (gen + 1u) * nloc) {
            __builtin_amdgcn_fence(__ATOMIC_RELEASE, "agent");
            asm volatile("s_waitcnt vmcnt(0)" ::: "memory");
            const unsigned og = xb_add(&bar[XB_TOP], 1u);
            const unsigned tg = og / nx;
            if (og + 1u == (tg + 1u) * nx) xb_add(&bar[XB_TOPGEN], 1u);
            else XB_SPIN(xb_ld(&bar[XB_TOPGEN]) == tg, bar);
            __builtin_amdgcn_fence(__ATOMIC_ACQUIRE, "agent");
            xb_add(&bar[XB_XGEN(b.x)], 1u);
            asm volatile("s_waitcnt vmcnt(0)" ::: "memory");
        } else {
            XB_SPIN(xb_ld(&bar[XB_XGEN(b.x)]) == gen, bar);
            __builtin_amdgcn_fence(__ATOMIC_ACQUIRE, "agent");
            asm volatile("s_waitcnt vmcnt(0)" ::: "memory");
        }
    }
    __syncthreads();
}

constexpr int CW_BAR = 4096;
constexpr int MISC_OFF = LDS_BYTES - 64;

struct Args {
    const float* in[18]; float* out; unsigned char* ws; int ph_lo, ph_hi;
};

template <int MODE>
__device__ __forceinline__ int dst_row(int n) {
    if (MODE == 1 && n >= 1024 && n < 2048) { const int j = n & 127; return (n & ~127) + ((j < 64) ? 2 * j : 2 * (j - 64) + 1); }
    return n;
}
template <int MODE>
__device__ __forceinline__ void p0_transpose_item(const float* W, int K, int N, bf16* WT, LAS float* scr, int item, int lane) {
    const int nblk = N / 32, kb = item / nblk, nb = item % nblk, k0 = 64 * kb, n0 = 32 * nb;
#pragma unroll 8
    for (int i = 0; i < 32; ++i) { const int kk = 2 * i + (lane >> 5); scr[kk * 33 + (lane & 31)] = W[(size_t)(k0 + kk) * N + n0 + (lane & 31)]; }
    asm volatile("s_waitcnt lgkmcnt(0)" ::: "memory");
    const int c = lane & 7;
#pragma unroll
    for (int j = 0; j < 4; ++j) { const int n = (lane >> 3) + 8 * j; const LAS float* s = scr + (8 * c) * 33 + n;
        v4u o; o.x = pk2(s[0 * 33], s[1 * 33]); o.y = pk2(s[2 * 33], s[3 * 33]); o.z = pk2(s[4 * 33], s[5 * 33]); o.w = pk2(s[6 * 33], s[7 * 33]);
        *(GAS v4u*)(WT + (size_t)dst_row<MODE>(n0 + n) * K + k0 + 8 * c) = o; }
    asm volatile("s_waitcnt lgkmcnt(0)" ::: "memory");
}
__device__ __forceinline__ void p0_convert(const float* src, bf16* dst, size_t n8, size_t gt, size_t ngt) {
    for (size_t i = gt; i < n8; i += ngt) {
        const f32x4 a = *(const f32x4*)(src + i * 8), b = *(const f32x4*)(src + i * 8 + 4);
        v4u o; o.x = pk2(a[0], a[1]); o.y = pk2(a[2], a[3]); o.z = pk2(b[0], b[1]); o.w = pk2(b[2], b[3]);
        *(v4u*)(dst + i * 8) = o;
    }
}

template <int PH_LO, int PH_HI>
__global__ void __launch_bounds__(NTHREADS, 2) fwd_kernel(Args args) {
    extern __shared__ __attribute__((aligned(16))) unsigned char lds_raw[];
    LAS unsigned char* lds = (LAS unsigned char*)lds_raw;
    LAS float* sm = (LAS float*)lds_raw;
    const int G = gridDim.x, bx = blockIdx.x;
#define PHASE_COORDS \
    int tid = threadIdx.x; asm volatile("" : "+v"(tid)); \
    const int lane = tid & 63, wave = __builtin_amdgcn_readfirstlane(tid >> 6); \
    const int gw = bx * NWAVES + wave, NGW = G * NWAVES; \
    const size_t gt = (size_t)bx * NTHREADS + tid, ngt = (size_t)G * NTHREADS; \
    (void)lane; (void)wave; (void)gw; (void)NGW; (void)gt; (void)ngt;
    unsigned char* ws = args.ws;
    const float* x = args.in[0];
    bf16* SKB = (bf16*)(ws + WS_SKB); bf16* WSB = (bf16*)(ws + WS_WSB); float* ROPE = (float*)(ws + WS_ROPE);
    bf16* WIN = (bf16*)(ws + WS_WIN); bf16* WOUT = (bf16*)(ws + WS_WOUT); bf16* WQ = (bf16*)(ws + WS_WQ);
    bf16* UT = (bf16*)(ws + WS_UT); bf16* VT = (bf16*)(ws + WS_VT);
    bf16* PROJ = (bf16*)(ws + WS_PROJ); float* Z = (float*)(ws + WS_Z); int* IDX = (int*)(ws + WS_IDX); float* GATE = (float*)(ws + WS_GATE);
    bf16* H = (bf16*)(ws + WS_H); bf16* XB = (bf16*)(ws + WS_XB); bf16* Y = (bf16*)(ws + WS_Y);
    bf16* ST = (bf16*)(ws + WS_ST); bf16* PREV = (bf16*)(ws + WS_PREV); bf16* QP = (bf16*)(ws + WS_QP);
#define IN(k) (PH_LO <= (k) && (k) < PH_HI)
#define BOTH(k) (IN(k) && IN((k) + 1))
    volatile LAS unsigned* MISC = (volatile LAS unsigned*)(lds + MISC_OFF);
    XcdBarrier bar; bar.bar = (unsigned*)(ws + WS_CTL) + CW_BAR; bar.x = 0; bar.st = nullptr;
    if constexpr (PH_HI - PH_LO > 1) {
        if (threadIdx.x < 16) MISC[threadIdx.x] = 0u;
        __syncthreads();
        bar = xcd_barrier_post((unsigned*)(ws + WS_CTL) + CW_BAR, MISC + 8);
    }
#define GRID_BAR(k) do { if constexpr (BOTH(k)) xcd_barrier(bar); } while (0)

    if constexpr (IN(0)) for (int rep_ = 0; rep_ < REP0; ++rep_) {
        PHASE_COORDS
        LAS float* scr = sm + wave * 4096;
        constexpr int I_IN = (D / 64) * (INW / 32), I_OUT = (D / 64) * (D / 32), I_Q = (D / 64) * (2048 / 32);
        for (int it = gw; it < I_IN + I_OUT + I_Q; it += NGW) {
            int r = it;
            if (r < I_IN) { p0_transpose_item<1>(args.in[1], D, INW, WIN, scr, r, lane); continue; } r -= I_IN;
            if (r < I_OUT) { p0_transpose_item<0>(args.in[9], D, D, WOUT, scr, r, lane); continue; } r -= I_OUT;
            p0_transpose_item<0>(args.in[12], D, 2048, WQ, scr, r, lane);
        }
        p0_convert(args.in[13], SKB, (size_t)8 * 2 * 128 * 128 / 8, gt, ngt);
        p0_convert(args.in[4], WSB, (size_t)4 * 128 * 128 / 8, gt, ngt);
        p0_convert(args.in[14], UT, (size_t)NEXP * D / 8, gt, ngt);
        p0_convert(args.in[15], VT, (size_t)NEXP * D / 8, gt, ngt);
        p0_convert(x, XB, (size_t)M * D / 8, gt, ngt);
        for (size_t i = gt; i < (size_t)4096 * 64; i += ngt) {
            const int pos = (int)(i >> 6), k = (int)(i & 63);
            const float inv = powf(10000.0f, -(float)k / 64.0f);
            const float ang = (float)pos * inv;
            ROPE[i * 2] = cosf(ang); ROPE[i * 2 + 1] = sinf(ang);
        }
    }

    GRID_BAR(0);

    if constexpr (IN(1)) for (int rep_ = 0; rep_ < REP1; ++rep_) {
        PHASE_COORDS
        pg8::Gemm g{XB, WIN, M, INW, D}; pg8::StaticOrder S; S.init(M, INW, G, bx);
        pg8::EpiProj E{PROJ, ROPE};
        pg8::gemm_phase<pg8::EpiProj, pg8::StaticOrder, true, true>(lds, g, S, E);
    }

    GRID_BAR(1);

#if NAIVE_P2
    if constexpr (IN(2)) for (int rep_ = 0; rep_ < REP2; ++rep_) {
        PHASE_COORDS
        const float* lnw = args.in[2]; const float* lnb = args.in[3]; const float* wsf = args.in[4]; const float* bs = args.in[5];
        for (int ck = bx; ck < NCHUNK; ck += G) {
            const int t0 = ck * 128, bb = ck >> 5, cc = ck & 31;
            LAS float* stat = sm + 16384;
            for (int r = wave * 16; r < wave * 16 + 16; ++r) {
                const v4u raw = *(const v4u*)(PROJ + (size_t)(t0 + r) * INW + 512 + lane * 8);
                float v[8] = {bflo(raw.x), bfhi(raw.x), bflo(raw.y), bfhi(raw.y), bflo(raw.z), bfhi(raw.z), bflo(raw.w), bfhi(raw.w)};
                float s = 0.f;
#pragma unroll
                for (int j = 0; j < 8; ++j) s += v[j];
                const float mean = wave_sum(s) * (1.0f / 512.0f);
                float q = 0.f;
#pragma unroll
                for (int j = 0; j < 8; ++j) { const float d = v[j] - mean; q += d * d; }
                const float rstd = 1.0f / sqrtf(wave_sum(q) * (1.0f / 512.0f) + LN_EPS);
                if (lane == 0) { stat[r * 2] = mean; stat[r * 2 + 1] = rstd; }
            }
            __syncthreads();
#pragma unroll 1
            for (int h = 0; h < 4; ++h) {
                for (int i = tid; i < 16384; i += NTHREADS) {
                    const int m = i >> 7, d = i & 127, col = h * 128 + d;
                    const float v = bf2f(PROJ[(size_t)(t0 + m) * INW + 512 + col]);
                    sm[i] = (v - stat[m * 2]) * stat[m * 2 + 1] * lnw[col] + lnb[col];
                }
                __syncthreads();
                {
                    const int d = tid & 127, lg = tid >> 7;
#pragma unroll 1
                    for (int ps = 0; ps < 4; ++ps) {
                        const int l0 = lg * 32 + ps * 8;
                        float acc[8];
#pragma unroll
                        for (int li = 0; li < 8; ++li) acc[li] = 0.f;
#pragma unroll 2
                        for (int m = 0; m < 128; ++m) {
                            const float vv = sm[m * 128 + d];
#pragma unroll
                            for (int li = 0; li < 8; ++li) acc[li] += wsf[((size_t)h * 128 + l0 + li) * 128 + m] * vv;
                        }
#pragma unroll
                        for (int li = 0; li < 8; ++li) {
                            const int l = l0 + li;
                            const float mixed = acc[li] + bs[h * 128 + l];
                            const float uu = bf2f(PROJ[(size_t)(t0 + l) * INW + h * 128 + d]);
                            Y[(size_t)(t0 + l) * D + h * 128 + d] = (bf16)f2bf(uu * mixed);
                        }
                    }
                }
                __syncthreads();
            }
#pragma unroll 1
            for (int h = 0; h < 4; ++h) {
                LAS float* Kt = sm; LAS float* Vt = sm + 16384;
                for (int i = tid; i < 16384; i += NTHREADS) {
                    const int l = i >> 7, d = i & 127;
                    Kt[i] = bf2f(PROJ[(size_t)(t0 + l) * INW + 1536 + h * 128 + d]);
                    Vt[i] = bf2f(PROJ[(size_t)(t0 + l) * INW + 2048 + h * 128 + d]);
                }
                {
                    const float lgf = log_sigmoid_f(args.in[6][h]), lgb = log_sigmoid_f(args.in[7][h]);
                    if (tid < 128) { sm[32768 + tid] = expf((float)(127 - tid) * lgf); sm[32768 + 128 + tid] = expf((float)tid * lgb); }
                }
                __syncthreads();
                const int dk = tid & 127, g4 = tid >> 7;
                const size_t u0 = (size_t)((bb * 4 + h) * 32 + cc) * 16384;
#pragma unroll 1
                for (int ps = 0; ps < 4; ++ps) {
                    const int dv0 = g4 * 32 + ps * 8;
                    float af[8], ab[8];
#pragma unroll
                    for (int j = 0; j < 8; ++j) { af[j] = 0.f; ab[j] = 0.f; }
#pragma unroll 2
                    for (int l = 0; l < 128; ++l) {
                        const float kv = Kt[l * 128 + dk];
                        const float kf = kv * sm[32768 + l], kb = kv * sm[32768 + 128 + l];
#pragma unroll
                        for (int j = 0; j < 8; ++j) { const float vv = Vt[l * 128 + dv0 + j]; af[j] += kf * vv; ab[j] += kb * vv; }
                    }
#pragma unroll
                    for (int j = 0; j < 8; ++j) {
                        const int dv = dv0 + j;
                        ST[u0 + dv * 128 + dk] = (bf16)f2bf(af[j]);
                        ST[(size_t)1024 * 16384 + u0 + dv * 128 + dk] = (bf16)f2bf(ab[j]);
                    }
                }
                __syncthreads();
            }
        }
    }

#else
    if constexpr (IN(2)) for (int rep_ = 0; rep_ < REP2; ++rep_) {
        PHASE_COORDS
        const float* lnw = args.in[2]; const float* lnb = args.in[3]; const float* bs = args.in[5];
        LAS unsigned char* B0 = lds; LAS unsigned char* B1 = lds + 32768; LAS unsigned char* B2 = lds + 65536; LAS unsigned char* B3 = lds + 98304;
        LAS float* stat = (LAS float*)(lds + 131072);
        const int g = lane >> 4, fr = lane & 15;
        for (int ck = bx; ck < NCHUNK; ck += G) {
            const int t0 = ck * 128, bb = ck >> 5, cc = ck & 31;
            for (int r = wave * 16; r < wave * 16 + 16; ++r) {
                const v4u raw = *(const v4u*)(PROJ + (size_t)(t0 + r) * INW + 512 + lane * 8);
                float v[8] = {bflo(raw.x), bfhi(raw.x), bflo(raw.y), bfhi(raw.y), bflo(raw.z), bfhi(raw.z), bflo(raw.w), bfhi(raw.w)};
                float s = 0.f;
#pragma unroll
                for (int j = 0; j < 8; ++j) s += v[j];
                const float mean = wave_sum(s) * (1.0f / 512.0f);
                float q = 0.f;
#pragma unroll
                for (int j = 0; j < 8; ++j) { const float d = v[j] - mean; q += d * d; }
                const float rstd = 1.0f / sqrtf(wave_sum(q) * (1.0f / 512.0f) + LN_EPS);
                if (lane == 0) { stat[r * 2] = mean; stat[r * 2 + 1] = rstd; }
            }
            __syncthreads();
#pragma unroll 1
            for (int h = 0; h < 4; ++h) {
                const float lf2 = log_sigmoid_f(args.in[6][h]) * 1.4426950408889634f, lb2 = log_sigmoid_f(args.in[7][h]) * 1.4426950408889634f;
                const bf16* prow = PROJ + (size_t)t0 * INW + h * 128;
#pragma unroll
                for (int i = 0; i < 4; ++i) {
                    const int c = tid + NTHREADS * i, row = c >> 4, ch = c & 15;
                    const v4u raw = *(const v4u*)(prow + (size_t)row * INW + 512 + ch * 8);
                    const f32x4 w0 = *(const f32x4*)(lnw + h * 128 + ch * 8), w1 = *(const f32x4*)(lnw + h * 128 + ch * 8 + 4);
                    const f32x4 b0 = *(const f32x4*)(lnb + h * 128 + ch * 8), b1 = *(const f32x4*)(lnb + h * 128 + ch * 8 + 4);
                    const float mean = stat[row * 2], rstd = stat[row * 2 + 1];
                    v4u o;
                    o.x = pk2((bflo(raw.x) - mean) * rstd * w0[0] + b0[0], (bfhi(raw.x) - mean) * rstd * w0[1] + b0[1]);
                    o.y = pk2((bflo(raw.y) - mean) * rstd * w0[2] + b0[2], (bfhi(raw.y) - mean) * rstd * w0[3] + b0[3]);
                    o.z = pk2((bflo(raw.z) - mean) * rstd * w1[0] + b1[0], (bfhi(raw.z) - mean) * rstd * w1[1] + b1[1]);
                    o.w = pk2((bflo(raw.w) - mean) * rstd * w1[2] + b1[2], (bfhi(raw.w) - mean) * rstd * w1[3] + b1[3]);
                    *(LAS v4u*)(B0 + off_b(row, ch)) = o;
                }
                stage_tile(B1, prow + 1536, INW, tid);
#pragma unroll
                for (int i = 0; i < 4; ++i) {
                    const int c = tid + NTHREADS * i, row = c >> 4, ch = c & 15;
                    const v4u raw = *(const v4u*)(prow + (size_t)row * INW + 2048 + ch * 8);
                    *(LAS v4u*)(B2 + off_b(row, ch)) = scale_chunk(raw, exp2f((float)(127 - row) * lf2));
                    *(LAS v4u*)(B3 + off_b(row, ch)) = scale_chunk(raw, exp2f((float)row * lb2));
                }
                __syncthreads();
                {
                    bf16x8 wf[4];
#pragma unroll
                    for (int s = 0; s < 4; ++s) wf[s] = *(const bf16x8*)(WSB + ((size_t)h * 128 + 16 * wave + fr) * 128 + 32 * s + 8 * g);
                    f32x4 acc[8];
#pragma unroll
                    for (int nt = 0; nt < 8; ++nt) acc[nt] = (f32x4){0.f, 0.f, 0.f, 0.f};
#pragma unroll
                    for (int s = 0; s < 4; ++s)
#pragma unroll
                        for (int nt = 0; nt < 8; ++nt) acc[nt] = MFMA16(frag_tr(B0, lane, nt, s), wf[s], acc[nt]);
                    const int l = 16 * wave + fr;
                    const float bias = bs[h * 128 + l];
                    const bf16* urow = PROJ + (size_t)(t0 + l) * INW + h * 128;
                    bf16* yrow = Y + (size_t)(t0 + l) * D + h * 128;
#pragma unroll
                    for (int nt = 0; nt < 8; ++nt) {
                        const int d0 = 16 * nt + 4 * g;
                        const v2u u2 = *(const v2u*)(urow + d0);
                        v2u w; w.x = pk2(bflo(u2.x) * (acc[nt][0] + bias), bfhi(u2.x) * (acc[nt][1] + bias)); w.y = pk2(bflo(u2.y) * (acc[nt][2] + bias), bfhi(u2.y) * (acc[nt][3] + bias));
                        *(v2u*)(yrow + d0) = w;
                    }
                }
                {
                    f32x4 af[8], ab[8];
#pragma unroll
                    for (int nt = 0; nt < 8; ++nt) { af[nt] = (f32x4){0.f, 0.f, 0.f, 0.f}; ab[nt] = (f32x4){0.f, 0.f, 0.f, 0.f}; }
#pragma unroll
                    for (int s = 0; s < 4; ++s) {
                        const bf16x8 vf = frag_tr(B2, lane, wave, s), vb = frag_tr(B3, lane, wave, s);
#pragma unroll
                        for (int nt = 0; nt < 8; ++nt) { const bf16x8 kf = frag_tr(B1, lane, nt, s); af[nt] = MFMA16(kf, vf, af[nt]); ab[nt] = MFMA16(kf, vb, ab[nt]); }
                    }
                    const size_t u0 = (size_t)((bb * 4 + h) * 32 + cc) * 16384 + (size_t)(16 * wave + fr) * 128;
#pragma unroll
                    for (int nt = 0; nt < 8; ++nt) {
                        const int dk0 = 16 * nt + 4 * g;
                        v2u w; w.x = pk2(af[nt][0], af[nt][1]); w.y = pk2(af[nt][2], af[nt][3]);
                        *(v2u*)(ST + u0 + dk0) = w;
                        w.x = pk2(ab[nt][0], ab[nt][1]); w.y = pk2(ab[nt][2], ab[nt][3]);
                        *(v2u*)(ST + (size_t)1024 * 16384 + u0 + dk0) = w;
                    }
                }
                __syncthreads();
            }
        }
    }

#endif
    GRID_BAR(2);

    if constexpr (IN(3)) for (int rep_ = 0; rep_ < REP3; ++rep_) {
        PHASE_COORDS
        for (size_t v = gt; v < (size_t)2 * 32 * 2048; v += ngt) {
            const int dir = (int)(v >> 16), bh = (int)((v >> 11) & 31), e8 = (int)(v & 2047), h = bh & 3;
            const float lg = log_sigmoid_f(dir == 0 ? args.in[6][h] : args.in[7][h]);
            const float Gc = expf(128.0f * lg);
            float st[8];
#pragma unroll
            for (int j = 0; j < 8; ++j) st[j] = 0.f;
            for (int ci = 0; ci < 32; ++ci) {
                const int c = (dir == 0) ? ci : 31 - ci;
                const size_t off = ((size_t)dir * 1024 + bh * 32 + c) * 16384 + (size_t)e8 * 8;
                v4u o; o.x = pk2(st[0], st[1]); o.y = pk2(st[2], st[3]); o.z = pk2(st[4], st[5]); o.w = pk2(st[6], st[7]);
                *(v4u*)(PREV + off) = o;
                const v4u s = *(const v4u*)(ST + off);
                st[0] = Gc * st[0] + bflo(s.x); st[1] = Gc * st[1] + bfhi(s.x); st[2] = Gc * st[2] + bflo(s.y); st[3] = Gc * st[3] + bfhi(s.y);
                st[4] = Gc * st[4] + bflo(s.z); st[5] = Gc * st[5] + bfhi(s.z); st[6] = Gc * st[6] + bflo(s.w); st[7] = Gc * st[7] + bfhi(s.w);
            }
        }
    }

    GRID_BAR(3);

#if NAIVE_P4
    if constexpr (IN(4)) for (int rep_ = 0; rep_ < REP4; ++rep_) {
        PHASE_COORDS
        const float* gnw = args.in[8];
        for (int ck = bx; ck < NCHUNK; ck += G) {
            const int t0 = ck * 128, bb = ck >> 5, cc = ck & 31;
#pragma unroll 1
            for (int h = 0; h < 4; ++h) {
                const float lgf = log_sigmoid_f(args.in[6][h]), lgb = log_sigmoid_f(args.in[7][h]);
                LAS float* A0 = sm;
                LAS float* A1 = sm + 16384;
                for (int i = tid; i < 16384; i += NTHREADS) {
                    const int l = i >> 7, d = i & 127;
                    A0[i] = bf2f(PROJ[(size_t)(t0 + l) * INW + 1024 + h * 128 + d]);
                    A1[l * 129 + d] = bf2f(PROJ[(size_t)(t0 + l) * INW + 1536 + h * 128 + d]);
                }
                LAS float* qwt = sm + 32896;
                if (tid < 128) { qwt[tid] = expf((float)(tid + 1) * lgf); qwt[128 + tid] = expf((float)(128 - tid) * lgb); qwt[256 + tid] = expf((float)tid * lgf); qwt[384 + tid] = expf((float)tid * lgb); }
                __syncthreads();
                const int c0 = tid & 127, lg4 = tid >> 7;
                float acc[32];
#pragma unroll
                for (int li = 0; li < 32; ++li) acc[li] = 0.f;
#pragma unroll 1
                for (int d = 0; d < 128; ++d) {
                    const float kv = A1[c0 * 129 + d];
#pragma unroll
                    for (int li = 0; li < 32; ++li) acc[li] += A0[(lg4 * 32 + li) * 128 + d] * kv;
                }
                __syncthreads();
#pragma unroll
                for (int li = 0; li < 32; ++li) {
                    const int l = lg4 * 32 + li, m = c0;
                    const float dec = (m <= l) ? qwt[256 + l - m] : qwt[384 + m - l];
                    A0[l * 128 + m] = acc[li] * dec;
                }
                for (int i = tid; i < 16384; i += NTHREADS) {
                    const int l = i >> 7, d = i & 127;
                    A1[l * 129 + d] = bf2f(PROJ[(size_t)(t0 + l) * INW + 2048 + h * 128 + d]);
                }
                __syncthreads();
                float o[32];
#pragma unroll
                for (int li = 0; li < 32; ++li) o[li] = 0.f;
#pragma unroll 1
                for (int m = 0; m < 128; ++m) {
                    const float vv = A1[m * 129 + c0];
#pragma unroll
                    for (int li = 0; li < 32; ++li) o[li] += A0[(lg4 * 32 + li) * 128 + m] * vv;
                }
                __syncthreads();
#pragma unroll 1
                for (int dir = 0; dir < 2; ++dir) {
                    const size_t u0 = ((size_t)dir * 1024 + (bb * 4 + h) * 32 + cc) * 16384;
                    __syncthreads();
                    for (int i = tid; i < 16384; i += NTHREADS) {
                        const int l = i >> 7, d = i & 127;
                        A0[i] = qwt[dir * 128 + l] * bf2f(PROJ[(size_t)(t0 + l) * INW + 1024 + h * 128 + d]);
                        A1[l * 129 + d] = bf2f(PREV[u0 + i]);
                    }
                    __syncthreads();
#pragma unroll 1
                    for (int dk = 0; dk < 128; ++dk) {
                        const float pv = A1[c0 * 129 + dk];
#pragma unroll
                        for (int li = 0; li < 32; ++li) o[li] += A0[(lg4 * 32 + li) * 128 + dk] * pv;
                    }
                }
                __syncthreads();
#pragma unroll
                for (int li = 0; li < 32; ++li) A0[(lg4 * 32 + li) * 128 + c0] = o[li];
                __syncthreads();
                for (int r = wave * 16; r < wave * 16 + 16; ++r) {
                    const float a = A0[r * 128 + lane], b = A0[r * 128 + 64 + lane];
                    const float mean = wave_sum(a + b) * (1.0f / 128.0f);
                    const float da = a - mean, db = b - mean;
                    const float rstd = 1.0f / sqrtf(wave_sum(da * da + db * db) * (1.0f / 128.0f) + GN_EPS);
                    const size_t prow = (size_t)(t0 + r) * INW + 2560 + h * 128;
                    const float ga = bf2f(PROJ[prow + lane]), gb = bf2f(PROJ[prow + 64 + lane]);
                    Y[(size_t)(t0 + r) * D + 512 + h * 128 + lane] = (bf16)f2bf(da * rstd * gnw[h * 128 + lane] * ga);
                    Y[(size_t)(t0 + r) * D + 512 + h * 128 + 64 + lane] = (bf16)f2bf(db * rstd * gnw[h * 128 + 64 + lane] * gb);
                }
                __syncthreads();
            }
        }
    }

#else
    if constexpr (IN(4)) for (int rep_ = 0; rep_ < REP4; ++rep_) {
        PHASE_COORDS
        const float* gnw = args.in[8];
        LAS unsigned char* B0 = lds; LAS unsigned char* B1 = lds + 32768; LAS unsigned char* B2 = lds + 65536; LAS unsigned char* B3 = lds + 98304;
        const int g = lane >> 4, fr = lane & 15;
        for (int ck = bx; ck < NCHUNK; ck += G) {
            const int t0 = ck * 128, bb = ck >> 5, cc = ck & 31;
#pragma unroll 1
            for (int h = 0; h < 4; ++h) {
                const float lf2 = log_sigmoid_f(args.in[6][h]) * 1.4426950408889634f, lb2 = log_sigmoid_f(args.in[7][h]) * 1.4426950408889634f;
                const bf16* prow = PROJ + (size_t)t0 * INW + h * 128;
                stage_tile(B0, prow + 1024, INW, tid);
                stage_tile(B1, prow + 1536, INW, tid);
                __syncthreads();
                bf16x8 qf[4];
#pragma unroll
                for (int s = 0; s < 4; ++s) qf[s] = frag_row(B0, lane, wave, s);
                f32x4 sacc[8];
#pragma unroll
                for (int nt = 0; nt < 8; ++nt) sacc[nt] = (f32x4){0.f, 0.f, 0.f, 0.f};
#pragma unroll
                for (int nt = 0; nt < 8; ++nt)
#pragma unroll
                    for (int s = 0; s < 4; ++s) sacc[nt] = MFMA16(frag_row(B1, lane, nt, s), qf[s], sacc[nt]);
                __syncthreads();
                const size_t u0 = (size_t)((bb * 4 + h) * 32 + cc) * 16384;
                stage_tile(B2, prow + 2048, INW, tid);
                stage_tile(B3, PREV + u0, 128, tid);
                stage_tile(B0, PREV + (size_t)1024 * 16384 + u0, 128, tid);
                const int l = 16 * wave + fr;
#pragma unroll
                for (int nt = 0; nt < 8; ++nt) {
                    const int m0 = 16 * nt + 4 * g;
                    float p[4];
#pragma unroll
                    for (int r = 0; r < 4; ++r) { const int m = m0 + r; p[r] = sacc[nt][r] * exp2f((float)(l - m) * ((m <= l) ? lf2 : -lb2)); }
                    v2u w; w.x = pk2(p[0], p[1]); w.y = pk2(p[2], p[3]);
                    *(LAS v2u*)(B1 + off_b((unsigned)l, (unsigned)(2 * nt + (g >> 1))) + 8 * (g & 1)) = w;
                }
                __syncthreads();
                f32x4 o[8], c2[8];
#pragma unroll
                for (int nt = 0; nt < 8; ++nt) o[nt] = (f32x4){0.f, 0.f, 0.f, 0.f};
#pragma unroll
                for (int s = 0; s < 4; ++s) {
                    const bf16x8 pf = frag_row(B1, lane, wave, s);
#pragma unroll
                    for (int nt = 0; nt < 8; ++nt) o[nt] = MFMA16(frag_tr(B2, lane, nt, s), pf, o[nt]);
                }
#pragma unroll
                for (int dir = 0; dir < 2; ++dir) {
                    const LAS unsigned char* PT = dir ? B0 : B3;
#pragma unroll
                    for (int nt = 0; nt < 8; ++nt) c2[nt] = (f32x4){0.f, 0.f, 0.f, 0.f};
#pragma unroll
                    for (int nt = 0; nt < 8; ++nt)
#pragma unroll
                        for (int s = 0; s < 4; ++s) c2[nt] = MFMA16(frag_row(PT, lane, nt, s), qf[s], c2[nt]);
                    const float qw = dir ? exp2f((float)(128 - l) * lb2) : exp2f((float)(l + 1) * lf2);
#pragma unroll
                    for (int nt = 0; nt < 8; ++nt) o[nt] = o[nt] + c2[nt] * qw;
                }
                float sum = 0.f;
#pragma unroll
                for (int nt = 0; nt < 8; ++nt) sum += (o[nt][0] + o[nt][1]) + (o[nt][2] + o[nt][3]);
                sum += __shfl_xor(sum, 16); sum += __shfl_xor(sum, 32);
                const float mean = sum * (1.0f / 128.0f);
                float sq = 0.f;
#pragma unroll
                for (int nt = 0; nt < 8; ++nt) { o[nt] = o[nt] - mean; sq += (o[nt][0] * o[nt][0] + o[nt][1] * o[nt][1]) + (o[nt][2] * o[nt][2] + o[nt][3] * o[nt][3]); }
                sq += __shfl_xor(sq, 16); sq += __shfl_xor(sq, 32);
                const float rstd = 1.0f / sqrtf(sq * (1.0f / 128.0f) + GN_EPS);
                const bf16* grow = PROJ + (size_t)(t0 + l) * INW + 2560 + h * 128;
                bf16* yrow = Y + (size_t)(t0 + l) * D + 512 + h * 128;
#pragma unroll
                for (int nt = 0; nt < 8; ++nt) {
                    const int dv0 = 16 * nt + 4 * g;
                    const v2u gt2 = *(const v2u*)(grow + dv0);
                    const f32x4 gn = *(const f32x4*)(gnw + h * 128 + dv0);
                    v2u w; w.x = pk2(o[nt][0] * rstd * gn[0] * bflo(gt2.x), o[nt][1] * rstd * gn[1] * bfhi(gt2.x));
                    w.y = pk2(o[nt][2] * rstd * gn[2] * bflo(gt2.y), o[nt][3] * rstd * gn[3] * bfhi(gt2.y));
                    *(v2u*)(yrow + dv0) = w;
                }
                __syncthreads();
            }
        }
    }

#endif
    GRID_BAR(4);

    if constexpr (IN(5)) for (int rep_ = 0; rep_ < REP5; ++rep_) {
        PHASE_COORDS
        pg8::Gemm g{Y, WOUT, M, D, D}; pg8::StaticOrder S; S.init(M, D, G, bx);
        pg8::EpiResF32 E{x, Z, D, ALPHA};
        pg8::gemm_phase<pg8::EpiResF32, pg8::StaticOrder, true, true>(lds, g, S, E);
    }

    GRID_BAR(5);

    if constexpr (IN(6)) for (int rep_ = 0; rep_ < REP6; ++rep_) {
        PHASE_COORDS
        const float* w = args.in[10]; const float* b = args.in[11];
        for (int t = gw; t < M; t += NGW) {
            const f32x4* zr = (const f32x4*)(Z + (size_t)t * D) + lane;
            f32x4 v[4]; float s = 0.f;
#pragma unroll
            for (int j = 0; j < 4; ++j) { v[j] = zr[64 * j]; s += (v[j][0] + v[j][1]) + (v[j][2] + v[j][3]); }
            const float mean = wave_sum(s) * (1.0f / D); float q = 0.f;
#pragma unroll
            for (int j = 0; j < 4; ++j) { v[j] = v[j] - mean; q += (v[j][0] * v[j][0] + v[j][1] * v[j][1]) + (v[j][2] * v[j][2] + v[j][3] * v[j][3]); }
            const float rstd = 1.0f / sqrtf(wave_sum(q) * (1.0f / D) + LN_EPS);
            unsigned long long* o8 = (unsigned long long*)(H + (size_t)t * D) + lane;
#pragma unroll
            for (int j = 0; j < 4; ++j) {
                const f32x4 wv = *((const f32x4*)w + lane + 64 * j), bv = *((const f32x4*)b + lane + 64 * j);
                const f32x4 y = v[j] * rstd * wv + bv;
                o8[64 * j] = (unsigned long long)pk2(y[0], y[1]) | ((unsigned long long)pk2(y[2], y[3]) << 32);
            }
        }
    }

    GRID_BAR(6);

    if constexpr (IN(7)) for (int rep_ = 0; rep_ < REP7; ++rep_) {
        PHASE_COORDS
        pg8::Gemm g{H, WQ, M, 2048, D}; pg8::StaticOrder S; S.init(M, 2048, G, bx);
        pg8::EpiPlainBf16 E{QP, 2048};
        pg8::gemm_phase<pg8::EpiPlainBf16, pg8::StaticOrder, true, true>(lds, g, S, E);
    }

    GRID_BAR(7);

#if NAIVE_P8
    if constexpr (IN(8)) for (int rep_ = 0; rep_ < REP8; ++rep_) {
        PHASE_COORDS
        const float* keys = args.in[13];
        LAS float* qs = sm;
        LAS float* sc = sm + 64 * 257;
        for (int unit = bx; unit < (M / 64) * PEER_H; unit += G) {
            const int tt0 = (unit >> 3) * 64, hd = unit & 7;
            for (int i = tid; i < 64 * 256; i += NTHREADS) { const int r = i >> 8, c = i & 255; qs[r * 257 + c] = bf2f(QP[(size_t)(tt0 + r) * 2048 + hd * 256 + c]); }
            __syncthreads();
            {
                const int tt = tid & 63, g8 = __builtin_amdgcn_readfirstlane(tid >> 6);
                for (int p = 0; p < 2; ++p) {
                    float acc[16];
#pragma unroll
                    for (int j = 0; j < 16; ++j) acc[j] = 0.f;
                    const float* kp = keys + ((size_t)(hd * 2 + p) * 128 + g8 * 16) * 128;
                    for (int d = 0; d < 128; ++d) {
                        const float qv = qs[tt * 257 + p * 128 + d];
#pragma unroll
                        for (int j = 0; j < 16; ++j) acc[j] += qv * kp[j * 128 + d];
                    }
#pragma unroll
                    for (int j = 0; j < 16; ++j) sc[tt * 257 + p * 128 + g8 * 16 + j] = acc[j];
                }
            }
            __syncthreads();
            LAS float* tops = qs;
            LAS int* topi = (LAS int*)(qs + 2048);
            LAS float* bsc = qs + 4096;
            LAS int* bps = (LAS int*)(qs + 5120);
            if (tid < 128) {
                const int tt = tid & 63, p = tid >> 6;
                LAS float* row = sc + tt * 257 + p * 128;
                for (int r = 0; r < 16; ++r) {
                    float best = -INFINITY; int bi = 0;
                    for (int n = 0; n < 128; ++n) { const float v = row[n]; if (v > best) { best = v; bi = n; } }
                    row[bi] = -INFINITY;
                    tops[(tt * 2 + p) * 16 + r] = best; topi[(tt * 2 + p) * 16 + r] = bi;
                }
            }
            __syncthreads();
            if (tid < 64) {
                const int tt = tid;
                LAS float* cand = sc + tt * 257;
                for (int a = 0; a < 16; ++a) for (int b = 0; b < 16; ++b) cand[a * 16 + b] = tops[(tt * 2) * 16 + a] + tops[(tt * 2 + 1) * 16 + b];
                float mx = -INFINITY;
                for (int r = 0; r < 16; ++r) {
                    float best = -INFINITY; int bi = 0;
                    for (int n = 0; n < 256; ++n) { const float v = cand[n]; if (v > best) { best = v; bi = n; } }
                    cand[bi] = -INFINITY;
                    bsc[tt * 16 + r] = best; bps[tt * 16 + r] = bi;
                    if (r == 0) mx = best;
                }
                float den = 0.f;
                for (int r = 0; r < 16; ++r) den += expf(bsc[tt * 16 + r] - mx);
                const float rden = 1.0f / den;
                for (int r = 0; r < 16; ++r) {
                    const int pos = bps[tt * 16 + r], a = pos >> 4, b = pos & 15;
                    const int e = topi[(tt * 2) * 16 + a] * 128 + topi[(tt * 2 + 1) * 16 + b];
                    IDX[(size_t)(tt0 + tt) * NSEL + hd * 16 + r] = e;
                    GATE[(size_t)(tt0 + tt) * NSEL + hd * 16 + r] = expf(bsc[tt * 16 + r] - mx) * rden;
                }
            }
            __syncthreads();
        }
    }

#else
    if constexpr (IN(8)) for (int rep_ = 0; rep_ < REP8; ++rep_) {
        PHASE_COORDS
        LAS unsigned char* K0 = lds; LAS unsigned char* K1 = lds + 32768;
        const int g = lane >> 4, fr = lane & 15;
        int cur_hd = -1;
        for (int unit = bx; unit < (M / 128) * PEER_H; unit += G) {
            const int hd = unit & 7, tile = unit >> 3;
            if (hd != cur_hd) {
                __syncthreads();
                stage_tile(K0, SKB + (size_t)(hd * 2 + 0) * 16384, 128, tid);
                stage_tile(K1, SKB + (size_t)(hd * 2 + 1) * 16384, 128, tid);
                __syncthreads();
                cur_hd = hd;
            }
            const int t = tile * 128 + 16 * wave + fr;
            int T[2][16];
#pragma unroll
            for (int p = 0; p < 2; ++p) {
                const LAS unsigned char* KT = p ? K1 : K0;
                bf16x8 qf[4];
#pragma unroll
                for (int s = 0; s < 4; ++s) qf[s] = *(const bf16x8*)(QP + (size_t)t * 2048 + hd * 256 + p * 128 + 32 * s + 8 * g);
                f32x4 acc[8];
#pragma unroll
                for (int nt = 0; nt < 8; ++nt) acc[nt] = (f32x4){0.f, 0.f, 0.f, 0.f};
#pragma unroll
                for (int nt = 0; nt < 8; ++nt)
#pragma unroll
                    for (int s = 0; s < 4; ++s) acc[nt] = MFMA16(frag_row(KT, lane, nt, s), qf[s], acc[nt]);
                int A[16], Bk[16];
#pragma unroll
                for (int nt = 0; nt < 4; ++nt)
#pragma unroll
                    for (int r = 0; r < 4; ++r) { A[nt * 4 + r] = f2key(acc[nt][r], 16 * nt + 4 * g + r); Bk[nt * 4 + r] = f2key(acc[nt + 4][r], 16 * (nt + 4) + 4 * g + r); }
                sort16_desc(A); sort16_desc(Bk);
#pragma unroll
                for (int i = 0; i < 16; ++i) A[i] = max(A[i], Bk[15 - i]);
                merge16_desc(A);
#pragma unroll
                for (int mask = 16; mask <= 32; mask <<= 1) {
                    int P[16];
#pragma unroll
                    for (int i = 0; i < 16; ++i) P[i] = __shfl_xor(A[15 - i], mask);
#pragma unroll
                    for (int i = 0; i < 16; ++i) A[i] = max(A[i], P[i]);
                    merge16_desc(A);
                }
#pragma unroll
                for (int i = 0; i < 16; ++i) T[p][i] = A[i];
            }
            float F0[16], F1[16];
#pragma unroll
            for (int i = 0; i < 16; ++i) { F0[i] = key2f(T[0][i]); F1[i] = key2f(T[1][i]); }
            int C[16];
#pragma unroll
            for (int j = 0; j < 16; ++j) {
                constexpr int a2[16] = {2, 2, 2, 2, 2, 3, 3, 3, 3, 4, 4, 4, 5, 5, 6, 6}, b2[16] = {0, 1, 2, 3, 4, 0, 1, 2, 3, 0, 1, 2, 0, 1, 0, 1};
                const int a1 = (j < 8) ? 1 : j, b1 = (j < 8) ? j : 0;
                const float s0 = F0[0] + F1[j], s1 = F0[a1] + F1[b1], s2 = F0[a2[j]] + F1[b2[j]];
                const int k0 = f2key(s0, j), k1 = f2key(s1, a1 * 16 + b1), k2 = f2key(s2, a2[j] * 16 + b2[j]);
                const int k3 = (j < 2) ? f2key(F0[7] + F1[j], 7 * 16 + j) : (int)0x80000000;
                C[j] = (g == 0) ? k0 : (g == 1) ? k1 : (g == 2) ? k2 : k3;
            }
            sort16_desc(C);
#pragma unroll
            for (int mask = 16; mask <= 32; mask <<= 1) {
                int P[16];
#pragma unroll
                for (int i = 0; i < 16; ++i) P[i] = __shfl_xor(C[15 - i], mask);
#pragma unroll
                for (int i = 0; i < 16; ++i) C[i] = max(C[i], P[i]);
                merge16_desc(C);
            }
            const float mx = key2f(C[0]);
            int kk[4];
#pragma unroll
            for (int k = 0; k < 4; ++k) kk[k] = (g == 0) ? C[k] : (g == 1) ? C[4 + k] : (g == 2) ? C[8 + k] : C[12 + k];
            unsigned pk0[4], pk1[4];
#pragma unroll
            for (int q = 0; q < 4; ++q) {
                pk0[q] = (unsigned)(T[0][4 * q] & 0x7F) | ((unsigned)(T[0][4 * q + 1] & 0x7F) << 8) | ((unsigned)(T[0][4 * q + 2] & 0x7F) << 16) | ((unsigned)(T[0][4 * q + 3] & 0x7F) << 24);
                pk1[q] = (unsigned)(T[1][4 * q] & 0x7F) | ((unsigned)(T[1][4 * q + 1] & 0x7F) << 8) | ((unsigned)(T[1][4 * q + 2] & 0x7F) << 16) | ((unsigned)(T[1][4 * q + 3] & 0x7F) << 24);
            }
            float ev[4]; int ex[4]; float part = 0.f;
#pragma unroll
            for (int k = 0; k < 4; ++k) {
                ev[k] = __expf(key2f(kk[k]) - mx); part += ev[k];
                const int a = (kk[k] >> 4) & 15, b = kk[k] & 15;
                const unsigned w0 = (a >> 2) == 0 ? pk0[0] : (a >> 2) == 1 ? pk0[1] : (a >> 2) == 2 ? pk0[2] : pk0[3];
                const unsigned w1 = (b >> 2) == 0 ? pk1[0] : (b >> 2) == 1 ? pk1[1] : (b >> 2) == 2 ? pk1[2] : pk1[3];
                ex[k] = (int)(((w0 >> (8 * (a & 3))) & 0xFFu) * 128u + ((w1 >> (8 * (b & 3))) & 0xFFu));
            }
            part += __shfl_xor(part, 16); part += __shfl_xor(part, 32);
            const float rden = 1.0f / part;
            *(v4u*)(IDX + (size_t)t * NSEL + hd * 16 + 4 * g) = (v4u){(unsigned)ex[0], (unsigned)ex[1], (unsigned)ex[2], (unsigned)ex[3]};
            *(f32x4*)(GATE + (size_t)t * NSEL + hd * 16 + 4 * g) = (f32x4){ev[0] * rden, ev[1] * rden, ev[2] * rden, ev[3] * rden};
        }
    }

#endif
    GRID_BAR(8);

    if constexpr (IN(9)) for (int rep_ = 0; rep_ < REP9; ++rep_) {
        PHASE_COORDS
        const float* w2 = args.in[16]; const float* b2 = args.in[17];
        for (int t = gw; t < M; t += NGW) {
            const v4u* hp = (const v4u*)(H + (size_t)t * D);
            const v4u ha = hp[lane], hb = hp[64 + lane];
            float hf[16] = {bflo(ha.x), bfhi(ha.x), bflo(ha.y), bfhi(ha.y), bflo(ha.z), bfhi(ha.z), bflo(ha.w), bfhi(ha.w),
                            bflo(hb.x), bfhi(hb.x), bflo(hb.y), bfhi(hb.y), bflo(hb.z), bfhi(hb.z), bflo(hb.w), bfhi(hb.w)};
            float o[16];
#pragma unroll
            for (int i = 0; i < 16; ++i) o[i] = 0.f;
            const int e_l0 = IDX[(size_t)t * NSEL + lane], e_l1 = IDX[(size_t)t * NSEL + 64 + lane];
            const float g_l0 = GATE[(size_t)t * NSEL + lane], g_l1 = GATE[(size_t)t * NSEL + 64 + lane];
            for (int j0 = 0; j0 < NSEL; j0 += 4) {
                v4u ua[4], ub[4], va[4], vb[4]; float gg[4];
#pragma unroll
                for (int k = 0; k < 4; ++k) {
                    const int j = j0 + k;
                    const int e = (j < 64) ? __shfl(e_l0, j) : __shfl(e_l1, j - 64);
                    gg[k] = (j < 64) ? __shfl(g_l0, j) : __shfl(g_l1, j - 64);
                    const v4u* up = (const v4u*)(UT + (size_t)e * D); const v4u* vp = (const v4u*)(VT + (size_t)e * D);
                    ua[k] = up[lane]; ub[k] = up[64 + lane]; va[k] = vp[lane]; vb[k] = vp[64 + lane];
                }
#pragma unroll
                for (int k = 0; k < 4; ++k) {
                    float d = hf[0] * bflo(ua[k].x) + hf[1] * bfhi(ua[k].x) + hf[2] * bflo(ua[k].y) + hf[3] * bfhi(ua[k].y)
                            + hf[4] * bflo(ua[k].z) + hf[5] * bfhi(ua[k].z) + hf[6] * bflo(ua[k].w) + hf[7] * bfhi(ua[k].w)
                            + hf[8] * bflo(ub[k].x) + hf[9] * bfhi(ub[k].x) + hf[10] * bflo(ub[k].y) + hf[11] * bfhi(ub[k].y)
                            + hf[12] * bflo(ub[k].z) + hf[13] * bfhi(ub[k].z) + hf[14] * bflo(ub[k].w) + hf[15] * bfhi(ub[k].w);
                    d = wave_sum(d);
                    const float c = gg[k] * gelu_exact(d);
                    o[0] += c * bflo(va[k].x); o[1] += c * bfhi(va[k].x); o[2] += c * bflo(va[k].y); o[3] += c * bfhi(va[k].y);
                    o[4] += c * bflo(va[k].z); o[5] += c * bfhi(va[k].z); o[6] += c * bflo(va[k].w); o[7] += c * bfhi(va[k].w);
                    o[8] += c * bflo(vb[k].x); o[9] += c * bfhi(vb[k].x); o[10] += c * bflo(vb[k].y); o[11] += c * bfhi(vb[k].y);
                    o[12] += c * bflo(vb[k].z); o[13] += c * bfhi(vb[k].z); o[14] += c * bflo(vb[k].w); o[15] += c * bfhi(vb[k].w);
                }
            }
            float s = 0.f;
#pragma unroll
            for (int i = 0; i < 16; ++i) { o[i] = ALPHA * hf[i] + o[i]; s += o[i]; }
            const float mean = wave_sum(s) * (1.0f / D); float q = 0.f;
#pragma unroll
            for (int i = 0; i < 16; ++i) { o[i] -= mean; q += o[i] * o[i]; }
            const float rstd = 1.0f / sqrtf(wave_sum(q) * (1.0f / D) + LN_EPS);
            float* orow = args.out + (size_t)t * D;
#pragma unroll
            for (int hseg = 0; hseg < 2; ++hseg) {
                const int c0 = hseg * 512 + lane * 8;
                const f32x4 wa = *(const f32x4*)(w2 + c0), wb = *(const f32x4*)(w2 + c0 + 4), ba = *(const f32x4*)(b2 + c0), bb4 = *(const f32x4*)(b2 + c0 + 4);
                f32x4 ya, yb;
#pragma unroll
                for (int i = 0; i < 4; ++i) { ya[i] = o[hseg * 8 + i] * rstd * wa[i] + ba[i]; yb[i] = o[hseg * 8 + 4 + i] * rstd * wb[i] + bb4[i]; }
                *(f32x4*)(orow + c0) = ya; *(f32x4*)(orow + c0 + 4) = yb;
            }
        }
    }
#undef IN
#undef BOTH
#undef GRID_BAR
}

extern "C" void kernel_launch(void* const* d_in, const int* in_sizes, int n_in, void* d_out, int out_size, void* d_ws, size_t ws_size, hipStream_t stream) {
    static int grid = 0;
    if (grid == 0) {
        if (n_in != 18 || in_sizes[0] != M * D || out_size != M * D || ws_size < WS_END) {
            fprintf(stderr, "kernel_launch: unexpected shapes: n_in %d in0 %d out %d ws %zu\n", n_in, n_in > 0 ? in_sizes[0] : -1, out_size, ws_size); grid = -1; return; }
        int dev = 0, cus = 0;
        if (hipGetDevice(&dev) != hipSuccess || hipDeviceGetAttribute(&cus, hipDeviceAttributeMultiprocessorCount, dev) != hipSuccess) { grid = -1; return; }
        bool ok = true;
#if N_LAUNCHES == 1
        ok = (hipFuncSetAttribute((const void*)fwd_kernel<0, 10>, hipFuncAttributeMaxDynamicSharedMemorySize, LDS_BYTES) == hipSuccess);
#else
#define SETATTR(k) ok = ok && (hipFuncSetAttribute((const void*)fwd_kernel<k, k + 1>, hipFuncAttributeMaxDynamicSharedMemorySize, LDS_BYTES) == hipSuccess)
        SETATTR(0); SETATTR(1); SETATTR(2); SETATTR(3); SETATTR(4); SETATTR(5); SETATTR(6); SETATTR(7); SETATTR(8); SETATTR(9);
#undef SETATTR
#endif
        if (!ok) { fprintf(stderr, "kernel_launch: hipFuncSetAttribute failed\n"); grid = -1; return; }
        grid = cus;
    }
    if (grid < 0) return;
    (void)hipMemsetAsync((char*)d_ws + WS_CTL, 0, CTL_ZERO_BYTES, stream);
    Args a{};
    for (int i = 0; i < 18; ++i) a.in[i] = (const float*)d_in[i];
    a.out = (float*)d_out; a.ws = (unsigned char*)d_ws;
    a.ph_lo = 0; a.ph_hi = 10;
#if N_LAUNCHES == 1
    hipLaunchKernelGGL((fwd_kernel<0, 10>), dim3(grid), dim3(NTHREADS), LDS_BYTES, stream, a);
#else
#define LAUNCH(k) hipLaunchKernelGGL((fwd_kernel<k, k + 1>), dim3(grid), dim3(NTHREADS), LDS_BYTES, stream, a)
    LAUNCH(0); LAUNCH(1); LAUNCH(2); LAUNCH(3); LAUNCH(4); LAUNCH(5); LAUNCH(6); LAUNCH(7); LAUNCH(8); LAUNCH(9);
#undef LAUNCH
#endif
}
```

```cpp
#include <hip/hip_runtime.h>
#include <cstdio>
#include <cstdint>
#include <cmath>
namespace pg8 {
#define PG8_LAS __attribute__((address_space(3)))
typedef unsigned short bf16_t;
typedef short bf16x8 __attribute__((ext_vector_type(8)));
typedef float f32x4 __attribute__((ext_vector_type(4)));
typedef unsigned u32x4 __attribute__((ext_vector_type(4)));
constexpr int BM = 256, BK = 64, HALF = 128, HTB = HALF * BK * 2  , STAGE_BYTES = 8 * HTB, NXCD = 8, WGM = 8;

__host__ __device__ __forceinline__ int lds_byte(int r, int c) { const int st = (r >> 4) * 2 + (c >> 5), rr = r & 15, cc = c & 31, ob = rr * 64 + cc * 2; return st * 1024 + (ob ^ (((ob >> 9) & 1) << 5)); }
__host__ __device__ __forceinline__ void stage_rc(int b, int& R, int& C) { const int st = b / 1024, sb = b % 1024, swz = sb ^ (((sb >> 9) & 1) << 5); R = (st >> 1) * 16 + swz / 64; C = (st & 1) * 32 + (swz % 64) / 2; }
__host__ __device__ __forceinline__ int perm32(int rho) { const int n = rho >> 4, i = rho & 15; return 8 * (i >> 2) + 4 * n + (i & 3); }

struct Unit { int pm, pn; };
struct Gemm { const bf16_t* A; const bf16_t* Bt; int M, N, K; };

struct StaticOrder {
    int nM, nN, nwg, G, c;
    __host__ __device__ void init(int M, int N, int G_, int c_) { nM = M / BM; nN = N / BM; nwg = nM * nN; G = G_; c = c_; }
    __host__ __device__ bool next(int i, Unit& u) const {
        const long L = (long)i * G + c; if (L >= nwg) return false;
        int wgid = (int)L; { const int q = nwg / NXCD, r = nwg % NXCD, xcd = wgid % NXCD, off = wgid / NXCD; wgid = (xcd < r ? xcd * (q + 1) : r * (q + 1) + (xcd - r) * q) + off; }
        const int nig = WGM * nN, gid = wgid / nig, fm = gid * WGM, gsz = (nM - fm) < WGM ? (nM - fm) : WGM;
        u.pm = fm + ((wgid % nig) % gsz); u.pn = (wgid % nig) / gsz; return true;
    }
    __device__ __forceinline__ void a_ready(const Unit&) const {}
    __device__ __forceinline__ void done(const Unit&) const {}
};

__device__ __forceinline__ unsigned cvt_pk_bf16(float lo, float hi) { unsigned r; asm volatile("v_cvt_pk_bf16_f32 %0, %1, %2" : "=v"(r) : "v"(lo), "v"(hi)); return r; }
typedef float f32x2 __attribute__((ext_vector_type(2)));
__device__ __forceinline__ f32x2 gelu_pk(f32x2 v) {
    const f32x2 av = __builtin_elementwise_abs(v), d = av * 0.2316418882f + 1.0f;
    f32x2 t; t.x = __builtin_amdgcn_rcpf(d.x); t.y = __builtin_amdgcn_rcpf(d.y);
    f32x2 q = t * 0.5307027145f + (-0.7265760135f); q = q * t + 0.7107068705f; q = q * t + (-0.142248368f); q = q * t + 0.127414796f; q = q * t;
    const f32x2 s = (v * v) * (-0.72134752044f);
    f32x2 e; e.x = __builtin_amdgcn_exp2f(s.x); e.y = __builtin_amdgcn_exp2f(s.y);
    const f32x2 m = v * (q * e), r = v - m;
    f32x2 o; o.x = v.x < 0.f ? m.x : r.x; o.y = v.y < 0.f ? m.y : r.y; return o;
}

__device__ __forceinline__ float silu_f(float v) { return v * __builtin_amdgcn_rcpf(1.0f + __expf(-v)); }
struct EpiProj {
    static constexpr bool PERM = true, AFTER_DRAIN = false;
    bf16_t* O; const float* rope;
    __device__ __forceinline__ void operator()(const f32x4 (&acc)[2][2][4][2], const Unit& u, int wr, int wc, int fr, int fq) const {
        const int sec = u.pn >> 1;
        const int row0 = u.pm * BM + wr * 64 + fr, col0 = u.pn * BM + wc * 32 + 8 * fq;
        const int i0 = wc * 16 + 4 * fq;
#pragma unroll
        for (int ai = 0; ai < 2; ++ai)
#pragma unroll
            for (int m = 0; m < 4; ++m) {
                const int row = row0 + ai * HALF + m * 16;
                bf16_t* rowp = O + (size_t)row * 3072 + col0;
                f32x4 r0 = (f32x4){1.f, 0.f, 1.f, 0.f}, r1 = r0;
                if (sec == 2 || sec == 3) { const f32x4* rp = (const f32x4*)(rope + ((size_t)(row & 4095) * 64 + i0) * 2); r0 = rp[0]; r1 = rp[1]; }
#pragma unroll
                for (int bj = 0; bj < 2; ++bj) {
                    f32x4 v0 = acc[ai][bj][m][0], v1 = acc[ai][bj][m][1];
                    if (sec <= 1) {
                        f32x2 a = gelu_pk((f32x2){v0[0], v0[1]}), b = gelu_pk((f32x2){v0[2], v0[3]}), c = gelu_pk((f32x2){v1[0], v1[1]}), d = gelu_pk((f32x2){v1[2], v1[3]});
                        v0 = (f32x4){a.x, a.y, b.x, b.y}; v1 = (f32x4){c.x, c.y, d.x, d.y};
                    } else if (sec <= 3) {
                        const float sc = (sec == 3) ? 0.08838834764831845f : 1.0f;
                        f32x4 w0, w1;
                        w0[0] = (v0[0] * r0[0] - v0[1] * r0[1]) * sc; w0[1] = (v0[0] * r0[1] + v0[1] * r0[0]) * sc;
                        w0[2] = (v0[2] * r0[2] - v0[3] * r0[3]) * sc; w0[3] = (v0[2] * r0[3] + v0[3] * r0[2]) * sc;
                        w1[0] = (v1[0] * r1[0] - v1[1] * r1[1]) * sc; w1[1] = (v1[0] * r1[1] + v1[1] * r1[0]) * sc;
                        w1[2] = (v1[2] * r1[2] - v1[3] * r1[3]) * sc; w1[3] = (v1[2] * r1[3] + v1[3] * r1[2]) * sc;
                        v0 = w0; v1 = w1;
                    } else if (sec == 5) {
#pragma unroll
                        for (int j = 0; j < 4; ++j) { v0[j] = silu_f(v0[j]); v1[j] = silu_f(v1[j]); }
                    }
                    u32x4 w; w.x = cvt_pk_bf16(v0[0], v0[1]); w.y = cvt_pk_bf16(v0[2], v0[3]); w.z = cvt_pk_bf16(v1[0], v1[1]); w.w = cvt_pk_bf16(v1[2], v1[3]);
                    *(u32x4*)(rowp + bj * HALF) = w;
                }
            }
    }
};
struct EpiPlainBf16 {
    static constexpr bool PERM = true, AFTER_DRAIN = false;
    bf16_t* O; int ldc;
    __device__ __forceinline__ void operator()(const f32x4 (&acc)[2][2][4][2], const Unit& u, int wr, int wc, int fr, int fq) const {
        const int row0 = u.pm * BM + wr * 64 + fr, col0 = u.pn * BM + wc * 32 + 8 * fq;
#pragma unroll
        for (int ai = 0; ai < 2; ++ai)
#pragma unroll
            for (int m = 0; m < 4; ++m) { bf16_t* rowp = O + (size_t)(row0 + ai * HALF + m * 16) * ldc + col0;
#pragma unroll
                for (int bj = 0; bj < 2; ++bj) { const f32x4 v0 = acc[ai][bj][m][0], v1 = acc[ai][bj][m][1];
                    u32x4 w; w.x = cvt_pk_bf16(v0[0], v0[1]); w.y = cvt_pk_bf16(v0[2], v0[3]); w.z = cvt_pk_bf16(v1[0], v1[1]); w.w = cvt_pk_bf16(v1[2], v1[3]);
                    *(u32x4*)(rowp + bj * HALF) = w; } }
    }
};
struct EpiResF32 {
    static constexpr bool PERM = false, AFTER_DRAIN = false;
    const float* X; float* Z; int ldc; float alpha;
    __device__ __forceinline__ void operator()(const f32x4 (&acc)[2][2][4][2], const Unit& u, int wr, int wc, int fr, int fq) const {
        const int row0 = u.pm * BM + wr * 64 + fr, col0 = u.pn * BM + wc * 32 + 4 * fq;
#pragma unroll
        for (int ai = 0; ai < 2; ++ai)
#pragma unroll
            for (int m = 0; m < 4; ++m) { const size_t off = (size_t)(row0 + ai * HALF + m * 16) * ldc + col0;
#pragma unroll
                for (int bj = 0; bj < 2; ++bj)
#pragma unroll
                    for (int n = 0; n < 2; ++n) { const f32x4 xv = *(const f32x4*)(X + off + bj * HALF + n * 16); *(f32x4*)(Z + off + bj * HALF + n * 16) = acc[ai][bj][m][n] + xv * alpha; } }
    }
};
template <class Epi, class Sched, bool ALIGN_EPI = false, bool SP2 = false>
__device__ __forceinline__ void gemm_phase(PG8_LAS unsigned char* lds, const Gemm g, const Sched& S, const Epi& E) {
    const int tid = threadIdx.x, wid = __builtin_amdgcn_readfirstlane(tid >> 6), lane = tid & 63, wr = wid >> 2, wc = wid & 3, fr = lane & 15, fq = lane >> 4;
    const int K = g.K, nt = K / BK;
    unsigned voffA[2], voffB[2];
#pragma unroll
    for (int i = 0; i < 2; ++i) { int R, C; stage_rc(tid * 16 + i * 8192, R, C); const int Rb = Epi::PERM ? ((R & ~31) + perm32(R & 31)) : R;
        voffA[i] = (unsigned)(R * K + C) * 2u; voffB[i] = (unsigned)(Rb * K + C) * 2u; }
    const size_t kstep = (size_t)(BK * 2);
    const size_t hstep = (size_t)HALF * K * 2;
    const size_t tstep = 2 * hstep;
    const unsigned ldsw = (unsigned)wid * 1024u;
    const int aoff = lds_byte(wr * 64 + fr, fq * 8), boff = lds_byte(wc * 32 + fr, fq * 8);
#define PG8_SA(b, h) (((b) * 2 + (h)) * HTB)
#define PG8_SB(b, h) ((4 + (b) * 2 + (h)) * HTB)
#define PG8_STAGE(bufoff, gbase, voff) do { _Pragma("unroll") for (int _i = 0; _i < 2; ++_i) \
        __builtin_amdgcn_global_load_lds((const unsigned*)((const char*)(gbase) + (voff)[_i]), (PG8_LAS unsigned*)(lds + (bufoff) + ldsw + _i * 8192), 16, 0, 0); } while (0)
#define PG8_LDA(dst, b, h) do { _Pragma("unroll") for (int m = 0; m < 4; ++m) _Pragma("unroll") for (int k = 0; k < 2; ++k) dst[m][k] = *(const PG8_LAS bf16x8*)(lds + PG8_SA(b, h) + aoff + m * 2048 + k * 1024); } while (0)
#define PG8_LDB(dst, b, h) do { _Pragma("unroll") for (int n = 0; n < 2; ++n) _Pragma("unroll") for (int k = 0; k < 2; ++k) dst[n][k] = *(const PG8_LAS bf16x8*)(lds + PG8_SB(b, h) + boff + n * 2048 + k * 1024); } while (0)
#define PG8_MMA(ai, bj, At, Bt) do { __builtin_amdgcn_s_setprio(1); _Pragma("unroll") for (int m = 0; m < 4; ++m) _Pragma("unroll") for (int n = 0; n < 2; ++n) _Pragma("unroll") for (int k = 0; k < 2; ++k) \
        acc[ai][bj][m][n] = __builtin_amdgcn_mfma_f32_16x16x32_bf16(Bt[n][k], At[m][k], acc[ai][bj][m][n], 0, 0, 0); __builtin_amdgcn_s_setprio(0); } while (0)
#define PG8_WAIT_V(n) asm volatile("s_waitcnt vmcnt(" #n ")" ::: "memory")
#define PG8_WAIT_L(n) asm volatile("s_waitcnt lgkmcnt(" #n ")" ::: "memory")
#define PG8_BAR __builtin_amdgcn_s_barrier()
#define PG8_SCHED __builtin_amdgcn_sched_barrier(0)
    Unit cur, nxt; int ui = 0;
    if (!S.next(0, cur)) return;
    f32x4 acc[2][2][4][2];
#pragma unroll
    for (int a = 0; a < 2; ++a)
#pragma unroll
        for (int b = 0; b < 2; ++b)
#pragma unroll
            for (int m = 0; m < 4; ++m)
#pragma unroll
                for (int n = 0; n < 2; ++n) acc[a][b][m][n] = (f32x4){0.f, 0.f, 0.f, 0.f};
    bf16x8 At[4][2], B0[2][2], B1[2][2];
    const char* cA = (const char*)g.A + (size_t)cur.pm * tstep; const char* cB = (const char*)g.Bt + (size_t)cur.pn * tstep;
    S.a_ready(cur);
    if constexpr (SP2) {
        PG8_STAGE(PG8_SB(0, 0), cB, voffB); PG8_STAGE(PG8_SB(0, 1), cB + hstep, voffB); PG8_STAGE(PG8_SA(0, 0), cA, voffA); PG8_STAGE(PG8_SA(0, 1), cA + hstep, voffA);
        if (wr == 1) PG8_BAR;
        PG8_WAIT_V(2); PG8_BAR;
        PG8_STAGE(PG8_SB(1, 0), cB + kstep, voffB); PG8_STAGE(PG8_SA(1, 0), cA + kstep, voffA); PG8_STAGE(PG8_SB(1, 1), cB + hstep + kstep, voffB);
        PG8_WAIT_V(6); PG8_BAR;
    } else {
        PG8_STAGE(PG8_SB(0, 0), cB, voffB); PG8_STAGE(PG8_SA(0, 0), cA, voffA); PG8_STAGE(PG8_SB(0, 1), cB + hstep, voffB); PG8_STAGE(PG8_SA(0, 1), cA + hstep, voffA);
        if (wr == 1) PG8_BAR;
        PG8_WAIT_V(4); PG8_BAR;
        PG8_STAGE(PG8_SB(1, 0), cB + kstep, voffB); PG8_STAGE(PG8_SA(1, 0), cA + kstep, voffA); PG8_STAGE(PG8_SB(1, 1), cB + hstep + kstep, voffB);
        PG8_WAIT_V(6); PG8_BAR;
    }
    for (;;) {
        const bool has_next = S.next(ui + 1, nxt);
        const char* nA = has_next ? (const char*)g.A + (size_t)nxt.pm * tstep : cA; const char* nB = has_next ? (const char*)g.Bt + (size_t)nxt.pn * tstep : cB;
        for (int t = 0; t < nt; t += 2) {
            const bool last = (t == nt - 2);
            const char* a1 = cA + (size_t)(t + 1) * kstep;
            const char* a2 = last ? nA : cA + (size_t)(t + 2) * kstep; const char* b2 = last ? nB : cB + (size_t)(t + 2) * kstep;
            const char* a3 = a2 + kstep; const char* b3 = b2 + kstep;
            if (last && has_next) S.a_ready(nxt);
            if constexpr (SP2) {
            PG8_LDB(B0, 0, 0); PG8_LDB(B1, 0, 1); PG8_SCHED; PG8_LDA(At, 0, 0); PG8_STAGE(PG8_SA(1, 1), a1 + hstep, voffA);
            PG8_WAIT_V(8); PG8_WAIT_L(0); PG8_BAR; PG8_MMA(0, 0, At, B0); PG8_MMA(0, 1, At, B1); PG8_BAR; PG8_SCHED;
            PG8_LDA(At, 0, 1); PG8_STAGE(PG8_SB(0, 0), b2, voffB); PG8_STAGE(PG8_SB(0, 1), b2 + hstep, voffB); PG8_STAGE(PG8_SA(0, 0), a2, voffA);
            PG8_WAIT_V(8); PG8_WAIT_L(0); PG8_BAR; PG8_MMA(1, 0, At, B0); PG8_MMA(1, 1, At, B1); PG8_BAR; PG8_SCHED;
            PG8_LDB(B0, 1, 0); PG8_LDB(B1, 1, 1); PG8_SCHED; PG8_LDA(At, 1, 0); PG8_STAGE(PG8_SA(0, 1), a2 + hstep, voffA);
            PG8_WAIT_V(8); PG8_WAIT_L(0); PG8_BAR; PG8_MMA(0, 0, At, B0); PG8_MMA(0, 1, At, B1); PG8_BAR; PG8_SCHED;
            PG8_LDA(At, 1, 1); PG8_STAGE(PG8_SB(1, 0), b3, voffB); PG8_STAGE(PG8_SB(1, 1), b3 + hstep, voffB); PG8_STAGE(PG8_SA(1, 0), a3, voffA);
            PG8_WAIT_V(8); PG8_WAIT_L(0); PG8_BAR; PG8_MMA(1, 0, At, B0); PG8_MMA(1, 1, At, B1); PG8_BAR; PG8_SCHED;
            } else {
            PG8_LDB(B0, 0, 0); PG8_SCHED; PG8_LDA(At, 0, 0); PG8_STAGE(PG8_SA(1, 1), a1 + hstep, voffA);
            PG8_WAIT_L(8); PG8_BAR; PG8_WAIT_L(0); PG8_MMA(0, 0, At, B0); PG8_BAR; PG8_SCHED;
            PG8_LDB(B1, 0, 1); PG8_STAGE(PG8_SB(0, 0), b2, voffB);
            PG8_BAR; PG8_WAIT_L(0); PG8_MMA(0, 1, At, B1); PG8_BAR;
            PG8_LDA(At, 0, 1); PG8_STAGE(PG8_SA(0, 0), a2, voffA);
            PG8_BAR; PG8_WAIT_L(0); PG8_MMA(1, 0, At, B0); PG8_BAR; PG8_SCHED;
            PG8_STAGE(PG8_SB(0, 1), b2 + hstep, voffB);
            PG8_WAIT_V(6); PG8_BAR; PG8_MMA(1, 1, At, B1); PG8_BAR;
            PG8_LDB(B0, 1, 0); PG8_SCHED; PG8_LDA(At, 1, 0); PG8_STAGE(PG8_SA(0, 1), a2 + hstep, voffA);
            PG8_WAIT_L(8); PG8_BAR; PG8_WAIT_L(0); PG8_MMA(0, 0, At, B0); PG8_BAR; PG8_SCHED;
            PG8_LDB(B1, 1, 1); PG8_STAGE(PG8_SB(1, 0), b3, voffB);
            PG8_BAR; PG8_WAIT_L(0); PG8_MMA(0, 1, At, B1); PG8_BAR;
            PG8_LDA(At, 1, 1); PG8_STAGE(PG8_SA(1, 0), a3, voffA);
            PG8_BAR; PG8_WAIT_L(0); PG8_MMA(1, 0, At, B0); PG8_BAR; PG8_SCHED;
            PG8_STAGE(PG8_SB(1, 1), b3 + hstep, voffB);
            PG8_WAIT_V(6); PG8_BAR; PG8_MMA(1, 1, At, B1); PG8_BAR;
            }
        }
        if constexpr (ALIGN_EPI) { if (wr == 0) PG8_BAR; }
        if constexpr (!Epi::AFTER_DRAIN) { E(acc, cur, wr, wc, fr, fq); S.done(cur); }
        if (!has_next) break;
#pragma unroll
        for (int a = 0; a < 2; ++a)
#pragma unroll
            for (int b = 0; b < 2; ++b)
#pragma unroll
                for (int m = 0; m < 4; ++m)
#pragma unroll
                    for (int n = 0; n < 2; ++n) acc[a][b][m][n] = (f32x4){0.f, 0.f, 0.f, 0.f};
        cur = nxt; cA = nA; cB = nB; ++ui;
        if constexpr (ALIGN_EPI) { if (wr == 1) PG8_BAR; }
    }
    PG8_WAIT_V(0);
    if constexpr (!ALIGN_EPI) { if (wr == 0) PG8_BAR; }
    PG8_BAR;
    if constexpr (Epi::AFTER_DRAIN) { E.fused(acc, cur, wr, wc, fr, fq, lds, wid, lane); S.done(cur); }
#undef PG8_SA
#undef PG8_SB
#undef PG8_STAGE
#undef PG8_LDA
#undef PG8_LDB
#undef PG8_MMA
#undef PG8_WAIT_V
#undef PG8_WAIT_L
#undef PG8_BAR
#undef PG8_SCHED
}
}
#ifndef REP0
#define REP0 1
#endif
#ifndef REP1
#define REP1 1
#endif
#ifndef REP2
#define REP2 1
#endif
#ifndef REP3
#define REP3 1
#endif
#ifndef REP4
#define REP4 1
#endif
#ifndef REP5
#define REP5 1
#endif
#ifndef REP6
#define REP6 1
#endif
#ifndef REP7
#define REP7 1
#endif
#ifndef REP8
#define REP8 1
#endif
#ifndef REP9
#define REP9 1
#endif
#ifndef REP10
#define REP10 1
#endif
#ifndef REP11
#define REP11 1
#endif
#ifndef REP12
#define REP12 1
#endif
#ifndef NAIVE_P4
#define NAIVE_P4 0
#endif
#ifndef NAIVE_P2
#define NAIVE_P2 0
#endif
#ifndef NAIVE_P8
#define NAIVE_P8 0
#endif
#ifndef N_LAUNCHES
#define N_LAUNCHES 1
#endif
constexpr int NWAVES = 8, NTHREADS = 512;
constexpr int BATCH = 8, SEQ = 4096, D = 1024, M = BATCH * SEQ;
constexpr int INW = 3072;
constexpr int NCHUNK = M / 128;
constexpr int PEER_H = 8, PEER_K = 16, NSEL = 128, NEXP = 16384;
constexpr float LN_EPS = 1e-5f, GN_EPS = 1e-5f;
constexpr float ALPHA = 1.189207115002721f;

constexpr size_t MiB = 1u << 20;
constexpr size_t WS_CTL = 0, CTL_ZERO_BYTES = 1 * MiB;
constexpr size_t WS_SKB = 1 * MiB;
constexpr size_t WS_WSB = 1 * MiB + 512 * 1024;
constexpr size_t WS_ROPE = 2 * MiB;
constexpr size_t WS_WIN = 4 * MiB;
constexpr size_t WS_WOUT = 10 * MiB;
constexpr size_t WS_WQ = 12 * MiB;
constexpr size_t WS_U8 = 16 * MiB;
constexpr size_t WS_SU = 32 * MiB;
constexpr size_t WS_SV = 32 * MiB + 65536;
constexpr size_t WS_V8 = 48 * MiB;
constexpr size_t WS_CS = 64 * MiB;
constexpr size_t WS_SH = 65 * MiB;
constexpr size_t WS_H8 = 272 * MiB;
constexpr size_t WS_PDOT = 336 * MiB;
constexpr size_t WS_PROJ = 80 * MiB;
constexpr size_t WS_Z = 80 * MiB;
constexpr size_t WS_IDX = 80 * MiB;
constexpr size_t WS_GATE = 96 * MiB;
constexpr size_t WS_H = 208 * MiB;
constexpr size_t WS_XB = 272 * MiB;
constexpr size_t WS_Y = 272 * MiB;
constexpr size_t WS_ST = 336 * MiB;
constexpr size_t WS_PREV = 400 * MiB;
constexpr size_t WS_QP = 336 * MiB;
constexpr size_t WS_END = 464 * MiB;

constexpr int LDS_BYTES = 147456;

#define GAS __attribute__((address_space(1)))
#define LAS __attribute__((address_space(3)))
typedef unsigned short bf16;
typedef unsigned v4u __attribute__((ext_vector_type(4)));
typedef float f32x4 __attribute__((ext_vector_type(4)));

__device__ __forceinline__ unsigned f2bf(float f) { unsigned u = __builtin_bit_cast(unsigned, f); return (u + 0x7fffu + ((u >> 16) & 1u)) >> 16; }
__device__ __forceinline__ unsigned pk2(float lo, float hi) { return f2bf(lo) | (f2bf(hi) << 16); }
__device__ __forceinline__ float bf2f(unsigned short b) { return __builtin_bit_cast(float, (unsigned)b << 16); }
__device__ __forceinline__ float bflo(unsigned w) { return __builtin_bit_cast(float, w << 16); }
__device__ __forceinline__ float bfhi(unsigned w) { return __builtin_bit_cast(float, w & 0xffff0000u); }
__device__ __forceinline__ float wave_sum(float v) {
#pragma unroll
    for (int o = 1; o < 64; o <<= 1) v += __shfl_xor(v, o);
    return v;
}
__device__ __forceinline__ float gelu_exact(float v) { return 0.5f * v * (1.0f + erff(v * 0.70710678118654752f)); }
__device__ __forceinline__ float log_sigmoid_f(float x) { return -log1pf(expf(-x)); }

typedef short bf16x8 __attribute__((ext_vector_type(8)));
typedef short s16x4 __attribute__((ext_vector_type(4)));
typedef unsigned v2u __attribute__((ext_vector_type(2)));
__device__ __forceinline__ unsigned off_b(unsigned row, unsigned ch) { return 256u * row + 16u * (ch ^ (((row & 3u) << 2) | ((row >> 2) & 3u))); }
__device__ __forceinline__ bf16x8 frag_row(const LAS unsigned char* tile, int lane, int rb, int s) {
    return *(const LAS bf16x8*)(tile + off_b((unsigned)((lane & 15) + 16 * rb), (unsigned)(4 * s + (lane >> 4))));
}
__device__ __forceinline__ bf16x8 frag_tr(const LAS unsigned char* tile, int lane, int c, int ks) {
    const unsigned g = (unsigned)lane >> 4, q = ((unsigned)lane & 15u) >> 2, p = (unsigned)lane & 3u;
    const unsigned a0 = off_b(32u * ks + 8u * g + q, 2u * c + (p >> 1)) + 8u * (p & 1u);
    const unsigned a1 = off_b(32u * ks + 8u * g + 4u + q, 2u * c + (p >> 1)) + 8u * (p & 1u);
    typedef short v4i16_t __attribute__((ext_vector_type(4)));
    const s16x4 lo = __builtin_bit_cast(s16x4, __builtin_amdgcn_ds_read_tr16_b64_v4i16((LAS v4i16_t*)(tile + a0)));
    const s16x4 hi = __builtin_bit_cast(s16x4, __builtin_amdgcn_ds_read_tr16_b64_v4i16((LAS v4i16_t*)(tile + a1)));
    return (bf16x8){lo[0], lo[1], lo[2], lo[3], hi[0], hi[1], hi[2], hi[3]};
}
#define MFMA16(a, b, c) __builtin_amdgcn_mfma_f32_16x16x32_bf16((a), (b), (c), 0, 0, 0)
__device__ __forceinline__ void stage_tile(LAS unsigned char* tile, const bf16* src, int ld, int tid) {
    v4u v[4];
#pragma unroll
    for (int i = 0; i < 4; ++i) { const int c = tid + NTHREADS * i, row = c >> 4, ch = c & 15; v[i] = *(const v4u*)(src + (size_t)row * ld + ch * 8); }
#pragma unroll
    for (int i = 0; i < 4; ++i) { const int c = tid + NTHREADS * i, row = c >> 4, ch = c & 15; *(LAS v4u*)(tile + off_b(row, ch)) = v[i]; }
}
__device__ __forceinline__ v4u scale_chunk(v4u v, float s) {
    v4u o; o.x = pk2(bflo(v.x) * s, bfhi(v.x) * s); o.y = pk2(bflo(v.y) * s, bfhi(v.y) * s); o.z = pk2(bflo(v.z) * s, bfhi(v.z) * s); o.w = pk2(bflo(v.w) * s, bfhi(v.w) * s); return o;
}

__device__ __forceinline__ int f2key(float v, int payload) { const int b = __float_as_int(v); const int t = b ^ ((b >> 31) & 0x7fffffff); return (t & ~0xFF) | payload; }
__device__ __forceinline__ float key2f(int k) { const int t = k & ~0xFF; return __int_as_float(t ^ ((t >> 31) & 0x7fffffff)); }
__device__ __forceinline__ void merge16_desc(int (&k)[16]) {
#pragma unroll
    for (int stride = 8; stride > 0; stride >>= 1)
#pragma unroll
        for (int i = 0; i < 16; ++i) { const int l = i ^ stride; if (l > i) { const int a = k[i], b = k[l]; k[i] = max(a, b); k[l] = min(a, b); } }
}
__device__ __forceinline__ void sort16_desc(int (&k)[16]) {
#pragma unroll
    for (int size = 2; size <= 16; size <<= 1)
#pragma unroll
        for (int stride = size >> 1; stride > 0; stride >>= 1)
#pragma unroll
            for (int i = 0; i < 16; ++i) { const int l = i ^ stride; if (l > i) { const int a = k[i], b = k[l]; const bool desc = ((i & size) == 0); k[i] = desc ? max(a, b) : min(a, b); k[l] = desc ? min(a, b) : max(a, b); } }
}

#define XB_TMO      128
#define XB_XCNT(j)  (256  + 64 * (j))
#define XB_XSUB(j)  (1280 + 64 * (j))
#define XB_XGEN(j)  (2304 + 64 * (j))
#define XB_TOP      3328
#define XB_TOPGEN   3392
#define XCD_BAR_WORDS 3456
#define XB_SPIN_CAP (1u << 18)

__device__ __forceinline__ unsigned xb_ld(unsigned* p)              { return __hip_atomic_load(p, __ATOMIC_RELAXED, __HIP_MEMORY_SCOPE_AGENT); }
__device__ __forceinline__ unsigned xb_add(unsigned* p, unsigned v) { return __hip_atomic_fetch_add(p, v, __ATOMIC_RELAXED, __HIP_MEMORY_SCOPE_AGENT); }
__device__ __forceinline__ unsigned xb_xcc_id() { return (unsigned)__builtin_amdgcn_s_getreg((3 << 11) | 20) & 0xFu; }
#define XB_SPIN(cond, bar) do { unsigned _sp = 0; while (cond) { __builtin_amdgcn_s_sleep(1); \
    if ((++_sp & 255u) == 0u) { if (xb_ld(&(bar)[XB_TMO])) break; if (_sp > XB_SPIN_CAP) { atomicAdd(&(bar)[XB_TMO], 1u); break; } } } } while (0)

struct XcdBarrier {
    unsigned* bar; unsigned x;
    volatile LAS unsigned* st;
};

__device__ __forceinline__ XcdBarrier xcd_barrier_post(unsigned* bar, volatile LAS unsigned* st) {
    XcdBarrier b; b.bar = bar; b.x = xb_xcc_id(); b.st = st;
    if (threadIdx.x == 0) (void)xb_add(&bar[XB_XCNT(b.x)], 1u);
    return b;
}
__device__ __forceinline__ void xcd_barrier_complete(unsigned* bar, unsigned x, unsigned& nloc, unsigned& nx) {
    const unsigned G = gridDim.x * gridDim.y * gridDim.z;
    unsigned sum, cnt, mine, sp = 0u;
    for (;;) {
        sum = 0u; cnt = 0u; mine = 0u;
#pragma unroll
        for (unsigned j = 0; j < 16; ++j) { const unsigned c = xb_ld(&bar[XB_XCNT(j)]); sum += c; cnt += (c > 0u) ? 1u : 0u; mine = (j == x) ? c : mine; }
        if (sum == G) break;
        __builtin_amdgcn_s_sleep(1);
        if ((++sp & 255u) == 0u) { if (xb_ld(&bar[XB_TMO])) break; if (sp > XB_SPIN_CAP) { atomicAdd(&bar[XB_TMO], 1u); break; } }
    }
    nloc = mine > 0u ? mine : 1u; nx = cnt > 0u ? cnt : 1u;
}

__device__ __forceinline__ void xcd_barrier(const XcdBarrier& b) {
    asm volatile("s_waitcnt vmcnt(0)" ::: "memory");
    __syncthreads();
    if (threadIdx.x == 0) {
        unsigned* bar = b.bar;
        __builtin_amdgcn_s_waitcnt(0);
        unsigned nloc = b.st[0], nx = b.st[1];
        if (nloc == 0u) { xcd_barrier_complete(bar, b.x, nloc, nx); b.st[0] = nloc; b.st[1] = nx; }
        const unsigned old = xb_add(&bar[XB_XSUB(b.x)], 1u);
        const unsigned gen = old / nloc;
        if (old + 1u == (gen + 1u) * nloc) {
            __builtin_amdgcn_fence(__ATOMIC_RELEASE, "agent");
            asm volatile("s_waitcnt vmcnt(0)" ::: "memory");
            const unsigned og = xb_add(&bar[XB_TOP], 1u);
            const unsigned tg = og / nx;
            if (og + 1u == (tg + 1u) * nx) xb_add(&bar[XB_TOPGEN], 1u);
            else XB_SPIN(xb_ld(&bar[XB_TOPGEN]) == tg, bar);
            __builtin_amdgcn_fence(__ATOMIC_ACQUIRE, "agent");
            xb_add(&bar[XB_XGEN(b.x)], 1u);
            asm volatile("s_waitcnt vmcnt(0)" ::: "memory");
        } else {
            XB_SPIN(xb_ld(&bar[XB_XGEN(b.x)]) == gen, bar);
            __builtin_amdgcn_fence(__ATOMIC_ACQUIRE, "agent");
            asm volatile("s_waitcnt vmcnt(0)" ::: "memory");
        }
    }
    __syncthreads();
}

constexpr int CW_BAR = 4096;
constexpr int MISC_OFF = LDS_BYTES - 64;

struct Args {
    const float* in[18]; float* out; unsigned char* ws; int ph_lo, ph_hi;
};

template <int MODE>
__device__ __forceinline__ int dst_row(int n) {
    if (MODE == 1 && n >= 1024 && n < 2048) { const int j = n & 127; return (n & ~127) + ((j < 64) ? 2 * j : 2 * (j - 64) + 1); }
    return n;
}
template <int MODE>
__device__ __forceinline__ void p0_transpose_item(const float* W, int K, int N, bf16* WT, LAS float* scr, int item, int lane) {
    const int nblk = N / 32, kb = item / nblk, nb = item % nblk, k0 = 64 * kb, n0 = 32 * nb;
#pragma unroll 8
    for (int i = 0; i < 32; ++i) { const int kk = 2 * i + (lane >> 5); scr[kk * 33 + (lane & 31)] = W[(size_t)(k0 + kk) * N + n0 + (lane & 31)]; }
    asm volatile("s_waitcnt lgkmcnt(0)" ::: "memory");
    const int c = lane & 7;
#pragma unroll
    for (int j = 0; j < 4; ++j) { const int n = (lane >> 3) + 8 * j; const LAS float* s = scr + (8 * c) * 33 + n;
        v4u o; o.x = pk2(s[0 * 33], s[1 * 33]); o.y = pk2(s[2 * 33], s[3 * 33]); o.z = pk2(s[4 * 33], s[5 * 33]); o.w = pk2(s[6 * 33], s[7 * 33]);
        *(GAS v4u*)(WT + (size_t)dst_row<MODE>(n0 + n) * K + k0 + 8 * c) = o; }
    asm volatile("s_waitcnt lgkmcnt(0)" ::: "memory");
}
__device__ __forceinline__ void p0_convert(const float* src, bf16* dst, size_t n8, size_t gt, size_t ngt) {
    for (size_t i = gt; i < n8; i += ngt) {
        const f32x4 a = *(const f32x4*)(src + i * 8), b = *(const f32x4*)(src + i * 8 + 4);
        v4u o; o.x = pk2(a[0], a[1]); o.y = pk2(a[2], a[3]); o.z = pk2(b[0], b[1]); o.w = pk2(b[2], b[3]);
        *(v4u*)(dst + i * 8) = o;
    }
}

template <int PH_LO, int PH_HI>
__global__ void __launch_bounds__(NTHREADS, 2) fwd_kernel(Args args) {
    extern __shared__ __attribute__((aligned(16))) unsigned char lds_raw[];
    LAS unsigned char* lds = (LAS unsigned char*)lds_raw;
    LAS float* sm = (LAS float*)lds_raw;
    const int G = gridDim.x, bx = blockIdx.x;
#define PHASE_COORDS \
    int tid = threadIdx.x; asm volatile("" : "+v"(tid)); \
    const int lane = tid & 63, wave = __builtin_amdgcn_readfirstlane(tid >> 6); \
    const int gw = bx * NWAVES + wave, NGW = G * NWAVES; \
    const size_t gt = (size_t)bx * NTHREADS + tid, ngt = (size_t)G * NTHREADS; \
    (void)lane; (void)wave; (void)gw; (void)NGW; (void)gt; (void)ngt;
    unsigned char* ws = args.ws;
    const float* x = args.in[0];
    bf16* SKB = (bf16*)(ws + WS_SKB); bf16* WSB = (bf16*)(ws + WS_WSB); float* ROPE = (float*)(ws + WS_ROPE);
    bf16* WIN = (bf16*)(ws + WS_WIN); bf16* WOUT = (bf16*)(ws + WS_WOUT); bf16* WQ = (bf16*)(ws + WS_WQ);
    unsigned char* U8 = ws + WS_U8; unsigned char* V8 = ws + WS_V8; float* SU = (float*)(ws + WS_SU); float* SV = (float*)(ws + WS_SV);
    float* CS = (float*)(ws + WS_CS); float* SH = (float*)(ws + WS_SH); unsigned char* H8 = ws + WS_H8; int* PDOT = (int*)(ws + WS_PDOT);
    bf16* PROJ = (bf16*)(ws + WS_PROJ); float* Z = (float*)(ws + WS_Z); int* IDX = (int*)(ws + WS_IDX); float* GATE = (float*)(ws + WS_GATE);
    bf16* H = (bf16*)(ws + WS_H); bf16* XB = (bf16*)(ws + WS_XB); bf16* Y = (bf16*)(ws + WS_Y);
    bf16* ST = (bf16*)(ws + WS_ST); bf16* PREV = (bf16*)(ws + WS_PREV); bf16* QP = (bf16*)(ws + WS_QP);
#define IN(k) (PH_LO <= (k) && (k) < PH_HI)
#define BOTH(k) (IN(k) && IN((k) + 1))
    volatile LAS unsigned* MISC = (volatile LAS unsigned*)(lds + MISC_OFF);
    XcdBarrier bar; bar.bar = (unsigned*)(ws + WS_CTL) + CW_BAR; bar.x = 0; bar.st = nullptr;
    if constexpr (PH_HI - PH_LO > 1) {
        if (threadIdx.x < 16) MISC[threadIdx.x] = 0u;
        __syncthreads();
        bar = xcd_barrier_post((unsigned*)(ws + WS_CTL) + CW_BAR, MISC + 8);
    }
#define GRID_BAR(k) do { if constexpr (BOTH(k)) xcd_barrier(bar); } while (0)

    if constexpr (IN(0)) for (int rep_ = 0; rep_ < REP0; ++rep_) {
        PHASE_COORDS
        LAS float* scr = sm + wave * 4096;
        constexpr int I_IN = (D / 64) * (INW / 32), I_OUT = (D / 64) * (D / 32), I_Q = (D / 64) * (2048 / 32);
        for (int it = gw; it < I_IN + I_OUT + I_Q; it += NGW) {
            int r = it;
            if (r < I_IN) { p0_transpose_item<1>(args.in[1], D, INW, WIN, scr, r, lane); continue; } r -= I_IN;
            if (r < I_OUT) { p0_transpose_item<0>(args.in[9], D, D, WOUT, scr, r, lane); continue; } r -= I_OUT;
            p0_transpose_item<0>(args.in[12], D, 2048, WQ, scr, r, lane);
        }
        p0_convert(args.in[13], SKB, (size_t)8 * 2 * 128 * 128 / 8, gt, ngt);
        p0_convert(args.in[4], WSB, (size_t)4 * 128 * 128 / 8, gt, ngt);
        for (int r = gw; r < 2 * NEXP; r += NGW) {
            const bool isv = r >= NEXP; const int e = isv ? r - NEXP : r;
            const float* src = (isv ? args.in[15] : args.in[14]) + (size_t)e * D + lane * 16;
            f32x4 a[4]; float mx = 0.f;
#pragma unroll
            for (int k = 0; k < 4; ++k) { a[k] = *(const f32x4*)(src + 4 * k); mx = fmaxf(mx, fmaxf(fmaxf(fabsf(a[k][0]), fabsf(a[k][1])), fmaxf(fabsf(a[k][2]), fabsf(a[k][3])))); }
#pragma unroll
            for (int o = 1; o < 64; o <<= 1) mx = fmaxf(mx, __shfl_xor(mx, o));
            const float inv = mx > 0.f ? 127.0f / mx : 0.f;
            const int bias = isv ? 128 : 0;
            unsigned wq[4];
#pragma unroll
            for (int k = 0; k < 4; ++k) {
                const int q0 = (int)rintf(a[k][0] * inv) + bias, q1 = (int)rintf(a[k][1] * inv) + bias, q2 = (int)rintf(a[k][2] * inv) + bias, q3 = (int)rintf(a[k][3] * inv) + bias;
                wq[k] = (unsigned)(q0 & 0xff) | ((unsigned)(q1 & 0xff) << 8) | ((unsigned)(q2 & 0xff) << 16) | ((unsigned)(q3 & 0xff) << 24);
            }
            *(v4u*)((isv ? V8 : U8) + ((size_t)(lane >> 3) * NEXP + e) * 128 + (lane & 7) * 16) = (v4u){wq[0], wq[1], wq[2], wq[3]};
            if (lane == 0) (isv ? SV : SU)[e] = mx * (1.0f / 127.0f);
        }
        p0_convert(x, XB, (size_t)M * D / 8, gt, ngt);
        for (size_t i = gt; i < (size_t)4096 * 64; i += ngt) {
            const int pos = (int)(i >> 6), k = (int)(i & 63);
            const float inv = powf(10000.0f, -(float)k / 64.0f);
            const float ang = (float)pos * inv;
            ROPE[i * 2] = cosf(ang); ROPE[i * 2 + 1] = sinf(ang);
        }
    }

    GRID_BAR(0);

    if constexpr (IN(1)) for (int rep_ = 0; rep_ < REP1; ++rep_) {
        PHASE_COORDS
        pg8::Gemm g{XB, WIN, M, INW, D}; pg8::StaticOrder S; S.init(M, INW, G, bx);
        pg8::EpiProj E{PROJ, ROPE};
        pg8::gemm_phase<pg8::EpiProj, pg8::StaticOrder, true, true>(lds, g, S, E);
    }

    GRID_BAR(1);

#if NAIVE_P2
    if constexpr (IN(2)) for (int rep_ = 0; rep_ < REP2; ++rep_) {
        PHASE_COORDS
        const float* lnw = args.in[2]; const float* lnb = args.in[3]; const float* wsf = args.in[4]; const float* bs = args.in[5];
        for (int ck = bx; ck < NCHUNK; ck += G) {
            const int t0 = ck * 128, bb = ck >> 5, cc = ck & 31;
            LAS float* stat = sm + 16384;
            for (int r = wave * 16; r < wave * 16 + 16; ++r) {
                const v4u raw = *(const v4u*)(PROJ + (size_t)(t0 + r) * INW + 512 + lane * 8);
                float v[8] = {bflo(raw.x), bfhi(raw.x), bflo(raw.y), bfhi(raw.y), bflo(raw.z), bfhi(raw.z), bflo(raw.w), bfhi(raw.w)};
                float s = 0.f;
#pragma unroll
                for (int j = 0; j < 8; ++j) s += v[j];
                const float mean = wave_sum(s) * (1.0f / 512.0f);
                float q = 0.f;
#pragma unroll
                for (int j = 0; j < 8; ++j) { const float d = v[j] - mean; q += d * d; }
                const float rstd = 1.0f / sqrtf(wave_sum(q) * (1.0f / 512.0f) + LN_EPS);
                if (lane == 0) { stat[r * 2] = mean; stat[r * 2 + 1] = rstd; }
            }
            __syncthreads();
#pragma unroll 1
            for (int h = 0; h < 4; ++h) {
                for (int i = tid; i < 16384; i += NTHREADS) {
                    const int m = i >> 7, d = i & 127, col = h * 128 + d;
                    const float v = bf2f(PROJ[(size_t)(t0 + m) * INW + 512 + col]);
                    sm[i] = (v - stat[m * 2]) * stat[m * 2 + 1] * lnw[col] + lnb[col];
                }
                __syncthreads();
                {
                    const int d = tid & 127, lg = tid >> 7;
#pragma unroll 1
                    for (int ps = 0; ps < 4; ++ps) {
                        const int l0 = lg * 32 + ps * 8;
                        float acc[8];
#pragma unroll
                        for (int li = 0; li < 8; ++li) acc[li] = 0.f;
#pragma unroll 2
                        for (int m = 0; m < 128; ++m) {
                            const float vv = sm[m * 128 + d];
#pragma unroll
                            for (int li = 0; li < 8; ++li) acc[li] += wsf[((size_t)h * 128 + l0 + li) * 128 + m] * vv;
                        }
#pragma unroll
                        for (int li = 0; li < 8; ++li) {
                            const int l = l0 + li;
                            const float mixed = acc[li] + bs[h * 128 + l];
                            const float uu = bf2f(PROJ[(size_t)(t0 + l) * INW + h * 128 + d]);
                            Y[(size_t)(t0 + l) * D + h * 128 + d] = (bf16)f2bf(uu * mixed);
                        }
                    }
                }
                __syncthreads();
            }
#pragma unroll 1
            for (int h = 0; h < 4; ++h) {
                LAS float* Kt = sm; LAS float* Vt = sm + 16384;
                for (int i = tid; i < 16384; i += NTHREADS) {
                    const int l = i >> 7, d = i & 127;
                    Kt[i] = bf2f(PROJ[(size_t)(t0 + l) * INW + 1536 + h * 128 + d]);
                    Vt[i] = bf2f(PROJ[(size_t)(t0 + l) * INW + 2048 + h * 128 + d]);
                }
                {
                    const float lgf = log_sigmoid_f(args.in[6][h]), lgb = log_sigmoid_f(args.in[7][h]);
                    if (tid < 128) { sm[32768 + tid] = expf((float)(127 - tid) * lgf); sm[32768 + 128 + tid] = expf((float)tid * lgb); }
                }
                __syncthreads();
                const int dk = tid & 127, g4 = tid >> 7;
                const size_t u0 = (size_t)((bb * 4 + h) * 32 + cc) * 16384;
#pragma unroll 1
                for (int ps = 0; ps < 4; ++ps) {
                    const int dv0 = g4 * 32 + ps * 8;
                    float af[8], ab[8];
#pragma unroll
                    for (int j = 0; j < 8; ++j) { af[j] = 0.f; ab[j] = 0.f; }
#pragma unroll 2
                    for (int l = 0; l < 128; ++l) {
                        const float kv = Kt[l * 128 + dk];
                        const float kf = kv * sm[32768 + l], kb = kv * sm[32768 + 128 + l];
#pragma unroll
                        for (int j = 0; j < 8; ++j) { const float vv = Vt[l * 128 + dv0 + j]; af[j] += kf * vv; ab[j] += kb * vv; }
                    }
#pragma unroll
                    for (int j = 0; j < 8; ++j) {
                        const int dv = dv0 + j;
                        ST[u0 + dv * 128 + dk] = (bf16)f2bf(af[j]);
                        ST[(size_t)1024 * 16384 + u0 + dv * 128 + dk] = (bf16)f2bf(ab[j]);
                    }
                }
                __syncthreads();
            }
        }
    }

#else
    if constexpr (IN(2)) for (int rep_ = 0; rep_ < REP2; ++rep_) {
        PHASE_COORDS
        const float* lnw = args.in[2]; const float* lnb = args.in[3]; const float* bs = args.in[5];
        LAS unsigned char* B0 = lds; LAS unsigned char* B1 = lds + 32768; LAS unsigned char* B2 = lds + 65536; LAS unsigned char* B3 = lds + 98304;
        LAS float* stat = (LAS float*)(lds + 131072);
        const int g = lane >> 4, fr = lane & 15;
        for (int ck = bx; ck < NCHUNK; ck += G) {
            const int t0 = ck * 128, bb = ck >> 5, cc = ck & 31;
            for (int r = wave * 16; r < wave * 16 + 16; ++r) {
                const v4u raw = *(const v4u*)(PROJ + (size_t)(t0 + r) * INW + 512 + lane * 8);
                float v[8] = {bflo(raw.x), bfhi(raw.x), bflo(raw.y), bfhi(raw.y), bflo(raw.z), bfhi(raw.z), bflo(raw.w), bfhi(raw.w)};
                float s = 0.f;
#pragma unroll
                for (int j = 0; j < 8; ++j) s += v[j];
                const float mean = wave_sum(s) * (1.0f / 512.0f);
                float q = 0.f;
#pragma unroll
                for (int j = 0; j < 8; ++j) { const float d = v[j] - mean; q += d * d; }
                const float rstd = 1.0f / sqrtf(wave_sum(q) * (1.0f / 512.0f) + LN_EPS);
                if (lane == 0) { stat[r * 2] = mean; stat[r * 2 + 1] = rstd; }
            }
            __syncthreads();
#pragma unroll 1
            for (int h = 0; h < 4; ++h) {
                const float lf2 = log_sigmoid_f(args.in[6][h]) * 1.4426950408889634f, lb2 = log_sigmoid_f(args.in[7][h]) * 1.4426950408889634f;
                const bf16* prow = PROJ + (size_t)t0 * INW + h * 128;
#pragma unroll
                for (int i = 0; i < 4; ++i) {
                    const int c = tid + NTHREADS * i, row = c >> 4, ch = c & 15;
                    const v4u raw = *(const v4u*)(prow + (size_t)row * INW + 512 + ch * 8);
                    const f32x4 w0 = *(const f32x4*)(lnw + h * 128 + ch * 8), w1 = *(const f32x4*)(lnw + h * 128 + ch * 8 + 4);
                    const f32x4 b0 = *(const f32x4*)(lnb + h * 128 + ch * 8), b1 = *(const f32x4*)(lnb + h * 128 + ch * 8 + 4);
                    const float mean = stat[row * 2], rstd = stat[row * 2 + 1];
                    v4u o;
                    o.x = pk2((bflo(raw.x) - mean) * rstd * w0[0] + b0[0], (bfhi(raw.x) - mean) * rstd * w0[1] + b0[1]);
                    o.y = pk2((bflo(raw.y) - mean) * rstd * w0[2] + b0[2], (bfhi(raw.y) - mean) * rstd * w0[3] + b0[3]);
                    o.z = pk2((bflo(raw.z) - mean) * rstd * w1[0] + b1[0], (bfhi(raw.z) - mean) * rstd * w1[1] + b1[1]);
                    o.w = pk2((bflo(raw.w) - mean) * rstd * w1[2] + b1[2], (bfhi(raw.w) - mean) * rstd * w1[3] + b1[3]);
                    *(LAS v4u*)(B0 + off_b(row, ch)) = o;
                }
                stage_tile(B1, prow + 1536, INW, tid);
#pragma unroll
                for (int i = 0; i < 4; ++i) {
                    const int c = tid + NTHREADS * i, row = c >> 4, ch = c & 15;
                    const v4u raw = *(const v4u*)(prow + (size_t)row * INW + 2048 + ch * 8);
                    *(LAS v4u*)(B2 + off_b(row, ch)) = scale_chunk(raw, exp2f((float)(127 - row) * lf2));
                    *(LAS v4u*)(B3 + off_b(row, ch)) = scale_chunk(raw, exp2f((float)row * lb2));
                }
                __syncthreads();
                {
                    bf16x8 wf[4];
#pragma unroll
                    for (int s = 0; s < 4; ++s) wf[s] = *(const bf16x8*)(WSB + ((size_t)h * 128 + 16 * wave + fr) * 128 + 32 * s + 8 * g);
                    f32x4 acc[8];
#pragma unroll
                    for (int nt = 0; nt < 8; ++nt) acc[nt] = (f32x4){0.f, 0.f, 0.f, 0.f};
#pragma unroll
                    for (int s = 0; s < 4; ++s)
#pragma unroll
                        for (int nt = 0; nt < 8; ++nt) acc[nt] = MFMA16(frag_tr(B0, lane, nt, s), wf[s], acc[nt]);
                    const int l = 16 * wave + fr;
                    const float bias = bs[h * 128 + l];
                    const bf16* urow = PROJ + (size_t)(t0 + l) * INW + h * 128;
                    bf16* yrow = Y + (size_t)(t0 + l) * D + h * 128;
#pragma unroll
                    for (int nt = 0; nt < 8; ++nt) {
                        const int d0 = 16 * nt + 4 * g;
                        const v2u u2 = *(const v2u*)(urow + d0);
                        v2u w; w.x = pk2(bflo(u2.x) * (acc[nt][0] + bias), bfhi(u2.x) * (acc[nt][1] + bias)); w.y = pk2(bflo(u2.y) * (acc[nt][2] + bias), bfhi(u2.y) * (acc[nt][3] + bias));
                        *(v2u*)(yrow + d0) = w;
                    }
                }
                {
                    f32x4 af[8], ab[8];
#pragma unroll
                    for (int nt = 0; nt < 8; ++nt) { af[nt] = (f32x4){0.f, 0.f, 0.f, 0.f}; ab[nt] = (f32x4){0.f, 0.f, 0.f, 0.f}; }
#pragma unroll
                    for (int s = 0; s < 4; ++s) {
                        const bf16x8 vf = frag_tr(B2, lane, wave, s), vb = frag_tr(B3, lane, wave, s);
#pragma unroll
                        for (int nt = 0; nt < 8; ++nt) { const bf16x8 kf = frag_tr(B1, lane, nt, s); af[nt] = MFMA16(kf, vf, af[nt]); ab[nt] = MFMA16(kf, vb, ab[nt]); }
                    }
                    const size_t u0 = (size_t)((bb * 4 + h) * 32 + cc) * 16384 + (size_t)(16 * wave + fr) * 128;
#pragma unroll
                    for (int nt = 0; nt < 8; ++nt) {
                        const int dk0 = 16 * nt + 4 * g;
                        v2u w; w.x = pk2(af[nt][0], af[nt][1]); w.y = pk2(af[nt][2], af[nt][3]);
                        *(v2u*)(ST + u0 + dk0) = w;
                        w.x = pk2(ab[nt][0], ab[nt][1]); w.y = pk2(ab[nt][2], ab[nt][3]);
                        *(v2u*)(ST + (size_t)1024 * 16384 + u0 + dk0) = w;
                    }
                }
                __syncthreads();
            }
        }
    }

#endif
    GRID_BAR(2);

    if constexpr (IN(3)) for (int rep_ = 0; rep_ < REP3; ++rep_) {
        PHASE_COORDS
        for (size_t v = gt; v < (size_t)2 * 32 * 2048; v += ngt) {
            const int dir = (int)(v >> 16), bh = (int)((v >> 11) & 31), e8 = (int)(v & 2047), h = bh & 3;
            const float lg = log_sigmoid_f(dir == 0 ? args.in[6][h] : args.in[7][h]);
            const float Gc = expf(128.0f * lg);
            float st[8];
#pragma unroll
            for (int j = 0; j < 8; ++j) st[j] = 0.f;
            for (int ci = 0; ci < 32; ++ci) {
                const int c = (dir == 0) ? ci : 31 - ci;
                const size_t off = ((size_t)dir * 1024 + bh * 32 + c) * 16384 + (size_t)e8 * 8;
                v4u o; o.x = pk2(st[0], st[1]); o.y = pk2(st[2], st[3]); o.z = pk2(st[4], st[5]); o.w = pk2(st[6], st[7]);
                *(v4u*)(PREV + off) = o;
                const v4u s = *(const v4u*)(ST + off);
                st[0] = Gc * st[0] + bflo(s.x); st[1] = Gc * st[1] + bfhi(s.x); st[2] = Gc * st[2] + bflo(s.y); st[3] = Gc * st[3] + bfhi(s.y);
                st[4] = Gc * st[4] + bflo(s.z); st[5] = Gc * st[5] + bfhi(s.z); st[6] = Gc * st[6] + bflo(s.w); st[7] = Gc * st[7] + bfhi(s.w);
            }
        }
    }

    GRID_BAR(3);

#if NAIVE_P4
    if constexpr (IN(4)) for (int rep_ = 0; rep_ < REP4; ++rep_) {
        PHASE_COORDS
        const float* gnw = args.in[8];
        for (int ck = bx; ck < NCHUNK; ck += G) {
            const int t0 = ck * 128, bb = ck >> 5, cc = ck & 31;
#pragma unroll 1
            for (int h = 0; h < 4; ++h) {
                const float lgf = log_sigmoid_f(args.in[6][h]), lgb = log_sigmoid_f(args.in[7][h]);
                LAS float* A0 = sm;
                LAS float* A1 = sm + 16384;
                for (int i = tid; i < 16384; i += NTHREADS) {
                    const int l = i >> 7, d = i & 127;
                    A0[i] = bf2f(PROJ[(size_t)(t0 + l) * INW + 1024 + h * 128 + d]);
                    A1[l * 129 + d] = bf2f(PROJ[(size_t)(t0 + l) * INW + 1536 + h * 128 + d]);
                }
                LAS float* qwt = sm + 32896;
                if (tid < 128) { qwt[tid] = expf((float)(tid + 1) * lgf); qwt[128 + tid] = expf((float)(128 - tid) * lgb); qwt[256 + tid] = expf((float)tid * lgf); qwt[384 + tid] = expf((float)tid * lgb); }
                __syncthreads();
                const int c0 = tid & 127, lg4 = tid >> 7;
                float acc[32];
#pragma unroll
                for (int li = 0; li < 32; ++li) acc[li] = 0.f;
#pragma unroll 1
                for (int d = 0; d < 128; ++d) {
                    const float kv = A1[c0 * 129 + d];
#pragma unroll
                    for (int li = 0; li < 32; ++li) acc[li] += A0[(lg4 * 32 + li) * 128 + d] * kv;
                }
                __syncthreads();
#pragma unroll
                for (int li = 0; li < 32; ++li) {
                    const int l = lg4 * 32 + li, m = c0;
                    const float dec = (m <= l) ? qwt[256 + l - m] : qwt[384 + m - l];
                    A0[l * 128 + m] = acc[li] * dec;
                }
                for (int i = tid; i < 16384; i += NTHREADS) {
                    const int l = i >> 7, d = i & 127;
                    A1[l * 129 + d] = bf2f(PROJ[(size_t)(t0 + l) * INW + 2048 + h * 128 + d]);
                }
                __syncthreads();
                float o[32];
#pragma unroll
                for (int li = 0; li < 32; ++li) o[li] = 0.f;
#pragma unroll 1
                for (int m = 0; m < 128; ++m) {
                    const float vv = A1[m * 129 + c0];
#pragma unroll
                    for (int li = 0; li < 32; ++li) o[li] += A0[(lg4 * 32 + li) * 128 + m] * vv;
                }
                __syncthreads();
#pragma unroll 1
                for (int dir = 0; dir < 2; ++dir) {
                    const size_t u0 = ((size_t)dir * 1024 + (bb * 4 + h) * 32 + cc) * 16384;
                    __syncthreads();
                    for (int i = tid; i < 16384; i += NTHREADS) {
                        const int l = i >> 7, d = i & 127;
                        A0[i] = qwt[dir * 128 + l] * bf2f(PROJ[(size_t)(t0 + l) * INW + 1024 + h * 128 + d]);
                        A1[l * 129 + d] = bf2f(PREV[u0 + i]);
                    }
                    __syncthreads();
#pragma unroll 1
                    for (int dk = 0; dk < 128; ++dk) {
                        const float pv = A1[c0 * 129 + dk];
#pragma unroll
                        for (int li = 0; li < 32; ++li) o[li] += A0[(lg4 * 32 + li) * 128 + dk] * pv;
                    }
                }
                __syncthreads();
#pragma unroll
                for (int li = 0; li < 32; ++li) A0[(lg4 * 32 + li) * 128 + c0] = o[li];
                __syncthreads();
                for (int r = wave * 16; r < wave * 16 + 16; ++r) {
                    const float a = A0[r * 128 + lane], b = A0[r * 128 + 64 + lane];
                    const float mean = wave_sum(a + b) * (1.0f / 128.0f);
                    const float da = a - mean, db = b - mean;
                    const float rstd = 1.0f / sqrtf(wave_sum(da * da + db * db) * (1.0f / 128.0f) + GN_EPS);
                    const size_t prow = (size_t)(t0 + r) * INW + 2560 + h * 128;
                    const float ga = bf2f(PROJ[prow + lane]), gb = bf2f(PROJ[prow + 64 + lane]);
                    Y[(size_t)(t0 + r) * D + 512 + h * 128 + lane] = (bf16)f2bf(da * rstd * gnw[h * 128 + lane] * ga);
                    Y[(size_t)(t0 + r) * D + 512 + h * 128 + 64 + lane] = (bf16)f2bf(db * rstd * gnw[h * 128 + 64 + lane] * gb);
                }
                __syncthreads();
            }
        }
    }

#else
    if constexpr (IN(4)) for (int rep_ = 0; rep_ < REP4; ++rep_) {
        PHASE_COORDS
        const float* gnw = args.in[8];
        LAS unsigned char* B0 = lds; LAS unsigned char* B1 = lds + 32768; LAS unsigned char* B2 = lds + 65536; LAS unsigned char* B3 = lds + 98304;
        const int g = lane >> 4, fr = lane & 15;
        for (int ck = bx; ck < NCHUNK; ck += G) {
            const int t0 = ck * 128, bb = ck >> 5, cc = ck & 31;
#pragma unroll 1
            for (int h = 0; h < 4; ++h) {
                const float lf2 = log_sigmoid_f(args.in[6][h]) * 1.4426950408889634f, lb2 = log_sigmoid_f(args.in[7][h]) * 1.4426950408889634f;
                const bf16* prow = PROJ + (size_t)t0 * INW + h * 128;
                stage_tile(B0, prow + 1024, INW, tid);
                stage_tile(B1, prow + 1536, INW, tid);
                __syncthreads();
                bf16x8 qf[4];
#pragma unroll
                for (int s = 0; s < 4; ++s) qf[s] = frag_row(B0, lane, wave, s);
                f32x4 sacc[8];
#pragma unroll
                for (int nt = 0; nt < 8; ++nt) sacc[nt] = (f32x4){0.f, 0.f, 0.f, 0.f};
#pragma unroll
                for (int nt = 0; nt < 8; ++nt)
#pragma unroll
                    for (int s = 0; s < 4; ++s) sacc[nt] = MFMA16(frag_row(B1, lane, nt, s), qf[s], sacc[nt]);
                __syncthreads();
                const size_t u0 = (size_t)((bb * 4 + h) * 32 + cc) * 16384;
                stage_tile(B2, prow + 2048, INW, tid);
                stage_tile(B3, PREV + u0, 128, tid);
                stage_tile(B0, PREV + (size_t)1024 * 16384 + u0, 128, tid);
                const int l = 16 * wave + fr;
#pragma unroll
                for (int nt = 0; nt < 8; ++nt) {
                    const int m0 = 16 * nt + 4 * g;
                    float p[4];
#pragma unroll
                    for (int r = 0; r < 4; ++r) { const int m = m0 + r; p[r] = sacc[nt][r] * exp2f((float)(l - m) * ((m <= l) ? lf2 : -lb2)); }
                    v2u w; w.x = pk2(p[0], p[1]); w.y = pk2(p[2], p[3]);
                    *(LAS v2u*)(B1 + off_b((unsigned)l, (unsigned)(2 * nt + (g >> 1))) + 8 * (g & 1)) = w;
                }
                __syncthreads();
                f32x4 o[8], c2[8];
#pragma unroll
                for (int nt = 0; nt < 8; ++nt) o[nt] = (f32x4){0.f, 0.f, 0.f, 0.f};
#pragma unroll
                for (int s = 0; s < 4; ++s) {
                    const bf16x8 pf = frag_row(B1, lane, wave, s);
#pragma unroll
                    for (int nt = 0; nt < 8; ++nt) o[nt] = MFMA16(frag_tr(B2, lane, nt, s), pf, o[nt]);
                }
#pragma unroll
                for (int dir = 0; dir < 2; ++dir) {
                    const LAS unsigned char* PT = dir ? B0 : B3;
#pragma unroll
                    for (int nt = 0; nt < 8; ++nt) c2[nt] = (f32x4){0.f, 0.f, 0.f, 0.f};
#pragma unroll
                    for (int nt = 0; nt < 8; ++nt)
#pragma unroll
                        for (int s = 0; s < 4; ++s) c2[nt] = MFMA16(frag_row(PT, lane, nt, s), qf[s], c2[nt]);
                    const float qw = dir ? exp2f((float)(128 - l) * lb2) : exp2f((float)(l + 1) * lf2);
#pragma unroll
                    for (int nt = 0; nt < 8; ++nt) o[nt] = o[nt] + c2[nt] * qw;
                }
                float sum = 0.f;
#pragma unroll
                for (int nt = 0; nt < 8; ++nt) sum += (o[nt][0] + o[nt][1]) + (o[nt][2] + o[nt][3]);
                sum += __shfl_xor(sum, 16); sum += __shfl_xor(sum, 32);
                const float mean = sum * (1.0f / 128.0f);
                float sq = 0.f;
#pragma unroll
                for (int nt = 0; nt < 8; ++nt) { o[nt] = o[nt] - mean; sq += (o[nt][0] * o[nt][0] + o[nt][1] * o[nt][1]) + (o[nt][2] * o[nt][2] + o[nt][3] * o[nt][3]); }
                sq += __shfl_xor(sq, 16); sq += __shfl_xor(sq, 32);
                const float rstd = 1.0f / sqrtf(sq * (1.0f / 128.0f) + GN_EPS);
                const bf16* grow = PROJ + (size_t)(t0 + l) * INW + 2560 + h * 128;
                bf16* yrow = Y + (size_t)(t0 + l) * D + 512 + h * 128;
#pragma unroll
                for (int nt = 0; nt < 8; ++nt) {
                    const int dv0 = 16 * nt + 4 * g;
                    const v2u gt2 = *(const v2u*)(grow + dv0);
                    const f32x4 gn = *(const f32x4*)(gnw + h * 128 + dv0);
                    v2u w; w.x = pk2(o[nt][0] * rstd * gn[0] * bflo(gt2.x), o[nt][1] * rstd * gn[1] * bfhi(gt2.x));
                    w.y = pk2(o[nt][2] * rstd * gn[2] * bflo(gt2.y), o[nt][3] * rstd * gn[3] * bfhi(gt2.y));
                    *(v2u*)(yrow + dv0) = w;
                }
                __syncthreads();
            }
        }
    }

#endif
    GRID_BAR(4);

    if constexpr (IN(5)) for (int rep_ = 0; rep_ < REP5; ++rep_) {
        PHASE_COORDS
        pg8::Gemm g{Y, WOUT, M, D, D}; pg8::StaticOrder S; S.init(M, D, G, bx);
        pg8::EpiResF32 E{x, Z, D, ALPHA};
        pg8::gemm_phase<pg8::EpiResF32, pg8::StaticOrder, true, true>(lds, g, S, E);
    }

    GRID_BAR(5);

    if constexpr (IN(6)) for (int rep_ = 0; rep_ < REP6; ++rep_) {
        PHASE_COORDS
        const float* w = args.in[10]; const float* b = args.in[11];
        for (int t = gw; t < M; t += NGW) {
            const f32x4* zr = (const f32x4*)(Z + (size_t)t * D) + lane;
            f32x4 v[4]; float s = 0.f;
#pragma unroll
            for (int j = 0; j < 4; ++j) { v[j] = zr[64 * j]; s += (v[j][0] + v[j][1]) + (v[j][2] + v[j][3]); }
            const float mean = wave_sum(s) * (1.0f / D); float q = 0.f;
#pragma unroll
            for (int j = 0; j < 4; ++j) { v[j] = v[j] - mean; q += (v[j][0] * v[j][0] + v[j][1] * v[j][1]) + (v[j][2] * v[j][2] + v[j][3] * v[j][3]); }
            const float rstd = 1.0f / sqrtf(wave_sum(q) * (1.0f / D) + LN_EPS);
            unsigned long long* o8 = (unsigned long long*)(H + (size_t)t * D) + lane;
#pragma unroll
            for (int j = 0; j < 4; ++j) {
                const f32x4 wv = *((const f32x4*)w + lane + 64 * j), bv = *((const f32x4*)b + lane + 64 * j);
                const f32x4 y = v[j] * rstd * wv + bv;
                o8[64 * j] = (unsigned long long)pk2(y[0], y[1]) | ((unsigned long long)pk2(y[2], y[3]) << 32);
                v[j] = y;
            }
            float mx = 0.f;
#pragma unroll
            for (int j = 0; j < 4; ++j) mx = fmaxf(mx, fmaxf(fmaxf(fabsf(v[j][0]), fabsf(v[j][1])), fmaxf(fabsf(v[j][2]), fabsf(v[j][3]))));
#pragma unroll
            for (int o = 1; o < 64; o <<= 1) mx = fmaxf(mx, __shfl_xor(mx, o));
            const float inv = mx > 0.f ? 127.0f / mx : 0.f;
#pragma unroll
            for (int j = 0; j < 4; ++j) {
                const int q0 = (int)rintf(v[j][0] * inv), q1 = (int)rintf(v[j][1] * inv), q2 = (int)rintf(v[j][2] * inv), q3 = (int)rintf(v[j][3] * inv);
                *(unsigned*)(H8 + ((size_t)(2 * j + (lane >> 5)) * M + t) * 128 + 4 * (lane & 31)) = (unsigned)(q0 & 0xff) | ((unsigned)(q1 & 0xff) << 8) | ((unsigned)(q2 & 0xff) << 16) | ((unsigned)(q3 & 0xff) << 24);
            }
            if (lane == 0) SH[t] = mx * (1.0f / 127.0f);
        }
    }

    GRID_BAR(6);

    if constexpr (IN(7)) for (int rep_ = 0; rep_ < REP7; ++rep_) {
        PHASE_COORDS
        pg8::Gemm g{H, WQ, M, 2048, D}; pg8::StaticOrder S; S.init(M, 2048, G, bx);
        pg8::EpiPlainBf16 E{QP, 2048};
        pg8::gemm_phase<pg8::EpiPlainBf16, pg8::StaticOrder, true, true>(lds, g, S, E);
    }

    GRID_BAR(7);

#if NAIVE_P8
    if constexpr (IN(8)) for (int rep_ = 0; rep_ < REP8; ++rep_) {
        PHASE_COORDS
        const float* keys = args.in[13];
        LAS float* qs = sm;
        LAS float* sc = sm + 64 * 257;
        for (int unit = bx; unit < (M / 64) * PEER_H; unit += G) {
            const int tt0 = (unit >> 3) * 64, hd = unit & 7;
            for (int i = tid; i < 64 * 256; i += NTHREADS) { const int r = i >> 8, c = i & 255; qs[r * 257 + c] = bf2f(QP[(size_t)(tt0 + r) * 2048 + hd * 256 + c]); }
            __syncthreads();
            {
                const int tt = tid & 63, g8 = __builtin_amdgcn_readfirstlane(tid >> 6);
                for (int p = 0; p < 2; ++p) {
                    float acc[16];
#pragma unroll
                    for (int j = 0; j < 16; ++j) acc[j] = 0.f;
                    const float* kp = keys + ((size_t)(hd * 2 + p) * 128 + g8 * 16) * 128;
                    for (int d = 0; d < 128; ++d) {
                        const float qv = qs[tt * 257 + p * 128 + d];
#pragma unroll
                        for (int j = 0; j < 16; ++j) acc[j] += qv * kp[j * 128 + d];
                    }
#pragma unroll
                    for (int j = 0; j < 16; ++j) sc[tt * 257 + p * 128 + g8 * 16 + j] = acc[j];
                }
            }
            __syncthreads();
            LAS float* tops = qs;
            LAS int* topi = (LAS int*)(qs + 2048);
            LAS float* bsc = qs + 4096;
            LAS int* bps = (LAS int*)(qs + 5120);
            if (tid < 128) {
                const int tt = tid & 63, p = tid >> 6;
                LAS float* row = sc + tt * 257 + p * 128;
                for (int r = 0; r < 16; ++r) {
                    float best = -INFINITY; int bi = 0;
                    for (int n = 0; n < 128; ++n) { const float v = row[n]; if (v > best) { best = v; bi = n; } }
                    row[bi] = -INFINITY;
                    tops[(tt * 2 + p) * 16 + r] = best; topi[(tt * 2 + p) * 16 + r] = bi;
                }
            }
            __syncthreads();
            if (tid < 64) {
                const int tt = tid;
                LAS float* cand = sc + tt * 257;
                for (int a = 0; a < 16; ++a) for (int b = 0; b < 16; ++b) cand[a * 16 + b] = tops[(tt * 2) * 16 + a] + tops[(tt * 2 + 1) * 16 + b];
                float mx = -INFINITY;
                for (int r = 0; r < 16; ++r) {
                    float best = -INFINITY; int bi = 0;
                    for (int n = 0; n < 256; ++n) { const float v = cand[n]; if (v > best) { best = v; bi = n; } }
                    cand[bi] = -INFINITY;
                    bsc[tt * 16 + r] = best; bps[tt * 16 + r] = bi;
                    if (r == 0) mx = best;
                }
                float den = 0.f;
                for (int r = 0; r < 16; ++r) den += expf(bsc[tt * 16 + r] - mx);
                const float rden = 1.0f / den;
                for (int r = 0; r < 16; ++r) {
                    const int pos = bps[tt * 16 + r], a = pos >> 4, b = pos & 15;
                    const int e = topi[(tt * 2) * 16 + a] * 128 + topi[(tt * 2 + 1) * 16 + b];
                    IDX[(size_t)(tt0 + tt) * NSEL + hd * 16 + r] = e;
                    GATE[(size_t)(tt0 + tt) * NSEL + hd * 16 + r] = expf(bsc[tt * 16 + r] - mx) * rden;
                }
            }
            __syncthreads();
        }
    }

#else
    if constexpr (IN(8)) for (int rep_ = 0; rep_ < REP8; ++rep_) {
        PHASE_COORDS
        LAS unsigned char* K0 = lds; LAS unsigned char* K1 = lds + 32768;
        const int g = lane >> 4, fr = lane & 15;
        int cur_hd = -1;
        for (int unit = bx; unit < (M / 128) * PEER_H; unit += G) {
            const int hd = unit & 7, tile = unit >> 3;
            if (hd != cur_hd) {
                __syncthreads();
                stage_tile(K0, SKB + (size_t)(hd * 2 + 0) * 16384, 128, tid);
                stage_tile(K1, SKB + (size_t)(hd * 2 + 1) * 16384, 128, tid);
                __syncthreads();
                cur_hd = hd;
            }
            const int t = tile * 128 + 16 * wave + fr;
            int T[2][16];
#pragma unroll
            for (int p = 0; p < 2; ++p) {
                const LAS unsigned char* KT = p ? K1 : K0;
                bf16x8 qf[4];
#pragma unroll
                for (int s = 0; s < 4; ++s) qf[s] = *(const bf16x8*)(QP + (size_t)t * 2048 + hd * 256 + p * 128 + 32 * s + 8 * g);
                f32x4 acc[8];
#pragma unroll
                for (int nt = 0; nt < 8; ++nt) acc[nt] = (f32x4){0.f, 0.f, 0.f, 0.f};
#pragma unroll
                for (int nt = 0; nt < 8; ++nt)
#pragma unroll
                    for (int s = 0; s < 4; ++s) acc[nt] = MFMA16(frag_row(KT, lane, nt, s), qf[s], acc[nt]);
                int A[16], Bk[16];
#pragma unroll
                for (int nt = 0; nt < 4; ++nt)
#pragma unroll
                    for (int r = 0; r < 4; ++r) { A[nt * 4 + r] = f2key(acc[nt][r], 16 * nt + 4 * g + r); Bk[nt * 4 + r] = f2key(acc[nt + 4][r], 16 * (nt + 4) + 4 * g + r); }
                sort16_desc(A); sort16_desc(Bk);
#pragma unroll
                for (int i = 0; i < 16; ++i) A[i] = max(A[i], Bk[15 - i]);
                merge16_desc(A);
#pragma unroll
                for (int mask = 16; mask <= 32; mask <<= 1) {
                    int P[16];
#pragma unroll
                    for (int i = 0; i < 16; ++i) P[i] = __shfl_xor(A[15 - i], mask);
#pragma unroll
                    for (int i = 0; i < 16; ++i) A[i] = max(A[i], P[i]);
                    merge16_desc(A);
                }
#pragma unroll
                for (int i = 0; i < 16; ++i) T[p][i] = A[i];
            }
            float F0[16], F1[16];
#pragma unroll
            for (int i = 0; i < 16; ++i) { F0[i] = key2f(T[0][i]); F1[i] = key2f(T[1][i]); }
            int C[16];
#pragma unroll
            for (int j = 0; j < 16; ++j) {
                constexpr int a2[16] = {2, 2, 2, 2, 2, 3, 3, 3, 3, 4, 4, 4, 5, 5, 6, 6}, b2[16] = {0, 1, 2, 3, 4, 0, 1, 2, 3, 0, 1, 2, 0, 1, 0, 1};
                const int a1 = (j < 8) ? 1 : j, b1 = (j < 8) ? j : 0;
                const float s0 = F0[0] + F1[j], s1 = F0[a1] + F1[b1], s2 = F0[a2[j]] + F1[b2[j]];
                const int k0 = f2key(s0, j), k1 = f2key(s1, a1 * 16 + b1), k2 = f2key(s2, a2[j] * 16 + b2[j]);
                const int k3 = (j < 2) ? f2key(F0[7] + F1[j], 7 * 16 + j) : (int)0x80000000;
                C[j] = (g == 0) ? k0 : (g == 1) ? k1 : (g == 2) ? k2 : k3;
            }
            sort16_desc(C);
#pragma unroll
            for (int mask = 16; mask <= 32; mask <<= 1) {
                int P[16];
#pragma unroll
                for (int i = 0; i < 16; ++i) P[i] = __shfl_xor(C[15 - i], mask);
#pragma unroll
                for (int i = 0; i < 16; ++i) C[i] = max(C[i], P[i]);
                merge16_desc(C);
            }
            const float mx = key2f(C[0]);
            int kk[4];
#pragma unroll
            for (int k = 0; k < 4; ++k) kk[k] = (g == 0) ? C[k] : (g == 1) ? C[4 + k] : (g == 2) ? C[8 + k] : C[12 + k];
            unsigned pk0[4], pk1[4];
#pragma unroll
            for (int q = 0; q < 4; ++q) {
                pk0[q] = (unsigned)(T[0][4 * q] & 0x7F) | ((unsigned)(T[0][4 * q + 1] & 0x7F) << 8) | ((unsigned)(T[0][4 * q + 2] & 0x7F) << 16) | ((unsigned)(T[0][4 * q + 3] & 0x7F) << 24);
                pk1[q] = (unsigned)(T[1][4 * q] & 0x7F) | ((unsigned)(T[1][4 * q + 1] & 0x7F) << 8) | ((unsigned)(T[1][4 * q + 2] & 0x7F) << 16) | ((unsigned)(T[1][4 * q + 3] & 0x7F) << 24);
            }
            float ev[4]; int ex[4]; float part = 0.f;
#pragma unroll
            for (int k = 0; k < 4; ++k) {
                ev[k] = __expf(key2f(kk[k]) - mx); part += ev[k];
                const int a = (kk[k] >> 4) & 15, b = kk[k] & 15;
                const unsigned w0 = (a >> 2) == 0 ? pk0[0] : (a >> 2) == 1 ? pk0[1] : (a >> 2) == 2 ? pk0[2] : pk0[3];
                const unsigned w1 = (b >> 2) == 0 ? pk1[0] : (b >> 2) == 1 ? pk1[1] : (b >> 2) == 2 ? pk1[2] : pk1[3];
                ex[k] = (int)(((w0 >> (8 * (a & 3))) & 0xFFu) * 128u + ((w1 >> (8 * (b & 3))) & 0xFFu));
            }
            part += __shfl_xor(part, 16); part += __shfl_xor(part, 32);
            const float rden = 1.0f / part;
            *(v4u*)(IDX + (size_t)t * NSEL + hd * 16 + 4 * g) = (v4u){(unsigned)ex[0], (unsigned)ex[1], (unsigned)ex[2], (unsigned)ex[3]};
            *(f32x4*)(GATE + (size_t)t * NSEL + hd * 16 + 4 * g) = (f32x4){ev[0] * rden, ev[1] * rden, ev[2] * rden, ev[3] * rden};
        }
    }

#endif
    GRID_BAR(8);

    if constexpr (IN(9)) for (int rep_ = 0; rep_ < REP9; ++rep_) {
        PHASE_COORDS
        const bool fast = (G & 7) == 0;
        const int nq = fast ? (G >> 3) * NWAVES : NGW, q0 = fast ? (bx >> 3) * NWAVES + wave : gw;
        const long ntask = fast ? (long)M : 8L * M;
        const int c = lane & 7, pg = lane >> 3;
        for (long task = q0; task < ntask; task += nq) {
            const int t = fast ? (int)task : (int)(task >> 3), x = fast ? (bx & 7) : (int)(task & 7);
            const v4u* ip = (const v4u*)(IDX + (size_t)t * NSEL + 16 * pg);
            const v4u e0 = ip[0], e1 = ip[1], e2 = ip[2], e3 = ip[3];
            const unsigned ee[16] = {e0.x, e0.y, e0.z, e0.w, e1.x, e1.y, e1.z, e1.w, e2.x, e2.y, e2.z, e2.w, e3.x, e3.y, e3.z, e3.w};
            const v4u hq = *(const v4u*)(H8 + ((size_t)x * M + t) * 128 + 16 * c);
            const unsigned char* ub = U8 + (size_t)x * NEXP * 128 + 16 * c;
            v4u rows[16];
#pragma unroll
            for (int i = 0; i < 16; ++i) rows[i] = *(const v4u*)(ub + (size_t)ee[i] * 128);
            int acc[16];
#pragma unroll
            for (int i = 0; i < 16; ++i) {
                int a = __builtin_amdgcn_sdot4((int)rows[i].x, (int)hq.x, 0, false);
                a = __builtin_amdgcn_sdot4((int)rows[i].y, (int)hq.y, a, false);
                a = __builtin_amdgcn_sdot4((int)rows[i].z, (int)hq.z, a, false);
                a = __builtin_amdgcn_sdot4((int)rows[i].w, (int)hq.w, a, false);
                a += __shfl_xor(a, 1); a += __shfl_xor(a, 2); a += __shfl_xor(a, 4);
                acc[i] = a;
            }
            if (c == 0) {
                v4u* op = (v4u*)(PDOT + ((size_t)x * M + t) * NSEL + 16 * pg);
                op[0] = (v4u){(unsigned)acc[0], (unsigned)acc[1], (unsigned)acc[2], (unsigned)acc[3]};
                op[1] = (v4u){(unsigned)acc[4], (unsigned)acc[5], (unsigned)acc[6], (unsigned)acc[7]};
                op[2] = (v4u){(unsigned)acc[8], (unsigned)acc[9], (unsigned)acc[10], (unsigned)acc[11]};
                op[3] = (v4u){(unsigned)acc[12], (unsigned)acc[13], (unsigned)acc[14], (unsigned)acc[15]};
            }
        }
    }
    GRID_BAR(9);

    if constexpr (IN(10)) for (int rep_ = 0; rep_ < REP10; ++rep_) {
        PHASE_COORDS
        for (int t = gw; t < M; t += NGW) {
            const float sh = SH[t];
            float cs = 0.f;
#pragma unroll
            for (int k = 0; k < 2; ++k) {
                const int j = lane + 64 * k;
                const int e = IDX[(size_t)t * NSEL + j];
                int s = 0;
#pragma unroll
                for (int x = 0; x < 8; ++x) s += PDOT[((size_t)x * M + t) * NSEL + j];
                const float dot = SU[e] * sh * (float)s;
                const float cp = GATE[(size_t)t * NSEL + j] * gelu_exact(dot) * SV[e];
                GATE[(size_t)t * NSEL + j] = cp;
                cs += cp;
            }
            cs = wave_sum(cs);
            if (lane == 0) CS[t] = cs;
        }
    }
    GRID_BAR(10);

    if constexpr (IN(11)) for (int rep_ = 0; rep_ < REP11; ++rep_) {
        PHASE_COORDS
        const bool fast = (G & 7) == 0;
        const int nq = fast ? (G >> 3) * NWAVES : NGW, q0 = fast ? (bx >> 3) * NWAVES + wave : gw;
        const long ntask = fast ? (long)M : 8L * M;
        const int c = lane & 7, pg = lane >> 3;
        for (long task = q0; task < ntask; task += nq) {
            const int t = fast ? (int)task : (int)(task >> 3), x = fast ? (bx & 7) : (int)(task & 7);
            const v4u* ip = (const v4u*)(IDX + (size_t)t * NSEL + 16 * pg);
            const v4u e0 = ip[0], e1 = ip[1], e2 = ip[2], e3 = ip[3];
            const unsigned ee[16] = {e0.x, e0.y, e0.z, e0.w, e1.x, e1.y, e1.z, e1.w, e2.x, e2.y, e2.z, e2.w, e3.x, e3.y, e3.z, e3.w};
            const f32x4* cp = (const f32x4*)(GATE + (size_t)t * NSEL + 16 * pg);
            const f32x4 c0 = cp[0], c1 = cp[1], c2 = cp[2], c3 = cp[3];
            const float cc[16] = {c0[0], c0[1], c0[2], c0[3], c1[0], c1[1], c1[2], c1[3], c2[0], c2[1], c2[2], c2[3], c3[0], c3[1], c3[2], c3[3]};
            const unsigned char* vb = V8 + (size_t)x * NEXP * 128 + 16 * c;
            v4u rows[16];
#pragma unroll
            for (int i = 0; i < 16; ++i) rows[i] = *(const v4u*)(vb + (size_t)ee[i] * 128);
            float acc[16];
#pragma unroll
            for (int d = 0; d < 16; ++d) acc[d] = 0.f;
#pragma unroll
            for (int i = 0; i < 16; ++i) {
                const unsigned w[4] = {rows[i].x, rows[i].y, rows[i].z, rows[i].w};
#pragma unroll
                for (int k = 0; k < 4; ++k) {
                    acc[4 * k + 0] += cc[i] * (float)(w[k] & 0xffu);
                    acc[4 * k + 1] += cc[i] * (float)((w[k] >> 8) & 0xffu);
                    acc[4 * k + 2] += cc[i] * (float)((w[k] >> 16) & 0xffu);
                    acc[4 * k + 3] += cc[i] * (float)(w[k] >> 24);
                }
            }
            float r8[8], r4[4], r2[2];
            {
                const bool hi = (lane & 32) != 0;
#pragma unroll
                for (int k = 0; k < 8; ++k) { const float keep = hi ? acc[8 + k] : acc[k], send = hi ? acc[k] : acc[8 + k]; r8[k] = keep + __shfl_xor(send, 32); }
            }
            {
                const bool hi = (lane & 16) != 0;
#pragma unroll
                for (int k = 0; k < 4; ++k) { const float keep = hi ? r8[4 + k] : r8[k], send = hi ? r8[k] : r8[4 + k]; r4[k] = keep + __shfl_xor(send, 16); }
            }
            {
                const bool hi = (lane & 8) != 0;
#pragma unroll
                for (int k = 0; k < 2; ++k) { const float keep = hi ? r4[2 + k] : r4[k], send = hi ? r4[k] : r4[2 + k]; r2[k] = keep + __shfl_xor(send, 8); }
            }
            const int d0 = 8 * ((lane >> 5) & 1) + 4 * ((lane >> 4) & 1) + 2 * ((lane >> 3) & 1);
            const int col = 128 * x + 16 * c + d0;
            const float off = 128.0f * CS[t];
            const unsigned hw = *(const unsigned*)(H + (size_t)t * D + col);
            typedef float f32x2 __attribute__((ext_vector_type(2)));
            *(f32x2*)(args.out + (size_t)t * D + col) = (f32x2){ALPHA * bflo(hw) + r2[0] - off, ALPHA * bfhi(hw) + r2[1] - off};
        }
    }
    GRID_BAR(11);

    if constexpr (IN(12)) for (int rep_ = 0; rep_ < REP12; ++rep_) {
        PHASE_COORDS
        const float* w = args.in[16]; const float* b = args.in[17];
        for (int t = gw; t < M; t += NGW) {
            f32x4* zr = (f32x4*)(args.out + (size_t)t * D) + lane;
            f32x4 v[4]; float s = 0.f;
#pragma unroll
            for (int j = 0; j < 4; ++j) { v[j] = zr[64 * j]; s += (v[j][0] + v[j][1]) + (v[j][2] + v[j][3]); }
            const float mean = wave_sum(s) * (1.0f / D); float q = 0.f;
#pragma unroll
            for (int j = 0; j < 4; ++j) { v[j] = v[j] - mean; q += (v[j][0] * v[j][0] + v[j][1] * v[j][1]) + (v[j][2] * v[j][2] + v[j][3] * v[j][3]); }
            const float rstd = 1.0f / sqrtf(wave_sum(q) * (1.0f / D) + LN_EPS);
#pragma unroll
            for (int j = 0; j < 4; ++j) {
                const f32x4 wv = *((const f32x4*)w + lane + 64 * j), bv = *((const f32x4*)b + lane + 64 * j);
                zr[64 * j] = v[j] * rstd * wv + bv;
            }
        }
    }
#undef IN
#undef BOTH
#undef GRID_BAR
}

extern "C" void kernel_launch(void* const* d_in, const int* in_sizes, int n_in, void* d_out, int out_size, void* d_ws, size_t ws_size, hipStream_t stream) {
    static int grid = 0;
    if (grid == 0) {
        if (n_in != 18 || in_sizes[0] != M * D || out_size != M * D || ws_size < WS_END) {
            fprintf(stderr, "kernel_launch: unexpected shapes: n_in %d in0 %d out %d ws %zu\n", n_in, n_in > 0 ? in_sizes[0] : -1, out_size, ws_size); grid = -1; return; }
        int dev = 0, cus = 0;
        if (hipGetDevice(&dev) != hipSuccess || hipDeviceGetAttribute(&cus, hipDeviceAttributeMultiprocessorCount, dev) != hipSuccess) { grid = -1; return; }
        bool ok = true;
#if N_LAUNCHES == 1
        ok = (hipFuncSetAttribute((const void*)fwd_kernel<0, 13>, hipFuncAttributeMaxDynamicSharedMemorySize, LDS_BYTES) == hipSuccess);
#else
#define SETATTR(k) ok = ok && (hipFuncSetAttribute((const void*)fwd_kernel<k, k + 1>, hipFuncAttributeMaxDynamicSharedMemorySize, LDS_BYTES) == hipSuccess)
        SETATTR(0); SETATTR(1); SETATTR(2); SETATTR(3); SETATTR(4); SETATTR(5); SETATTR(6); SETATTR(7); SETATTR(8); SETATTR(9); SETATTR(10); SETATTR(11); SETATTR(12);
#undef SETATTR
#endif
        if (!ok) { fprintf(stderr, "kernel_launch: hipFuncSetAttribute failed\n"); grid = -1; return; }
        grid = cus;
    }
    if (grid < 0) return;
    (void)hipMemsetAsync((char*)d_ws + WS_CTL, 0, CTL_ZERO_BYTES, stream);
    Args a{};
    for (int i = 0; i < 18; ++i) a.in[i] = (const float*)d_in[i];
    a.out = (float*)d_out; a.ws = (unsigned char*)d_ws;
    a.ph_lo = 0; a.ph_hi = 10;
#if N_LAUNCHES == 1
    hipLaunchKernelGGL((fwd_kernel<0, 13>), dim3(grid), dim3(NTHREADS), LDS_BYTES, stream, a);
#else
#define LAUNCH(k) hipLaunchKernelGGL((fwd_kernel<k, k + 1>), dim3(grid), dim3(NTHREADS), LDS_BYTES, stream, a)
    LAUNCH(0); LAUNCH(1); LAUNCH(2); LAUNCH(3); LAUNCH(4); LAUNCH(5); LAUNCH(6); LAUNCH(7); LAUNCH(8); LAUNCH(9); LAUNCH(10); LAUNCH(11); LAUNCH(12);
#undef LAUNCH
#endif
}
```

```cpp
#include <hip/hip_runtime.h>
#include <cstdio>
#include <cstdint>
#include <cmath>
namespace pg8 {
#define PG8_LAS __attribute__((address_space(3)))
typedef unsigned short bf16_t;
typedef short bf16x8 __attribute__((ext_vector_type(8)));
typedef float f32x4 __attribute__((ext_vector_type(4)));
typedef unsigned u32x4 __attribute__((ext_vector_type(4)));
constexpr int BM = 256, BK = 64, HALF = 128, HTB = HALF * BK * 2  , STAGE_BYTES = 8 * HTB, NXCD = 8, WGM = 8;

__host__ __device__ __forceinline__ int lds_byte(int r, int c) { const int st = (r >> 4) * 2 + (c >> 5), rr = r & 15, cc = c & 31, ob = rr * 64 + cc * 2; return st * 1024 + (ob ^ (((ob >> 9) & 1) << 5)); }
__host__ __device__ __forceinline__ void stage_rc(int b, int& R, int& C) { const int st = b / 1024, sb = b % 1024, swz = sb ^ (((sb >> 9) & 1) << 5); R = (st >> 1) * 16 + swz / 64; C = (st & 1) * 32 + (swz % 64) / 2; }
__host__ __device__ __forceinline__ int perm32(int rho) { const int n = rho >> 4, i = rho & 15; return 8 * (i >> 2) + 4 * n + (i & 3); }

struct Unit { int pm, pn; };
struct Gemm { const bf16_t* A; const bf16_t* Bt; int M, N, K; };

struct StaticOrder {
    int nM, nN, nwg, G, c;
    __host__ __device__ void init(int M, int N, int G_, int c_) { nM = M / BM; nN = N / BM; nwg = nM * nN; G = G_; c = c_; }
    __host__ __device__ bool next(int i, Unit& u) const {
        const long L = (long)i * G + c; if (L >= nwg) return false;
        int wgid = (int)L; { const int q = nwg / NXCD, r = nwg % NXCD, xcd = wgid % NXCD, off = wgid / NXCD; wgid = (xcd < r ? xcd * (q + 1) : r * (q + 1) + (xcd - r) * q) + off; }
        const int nig = WGM * nN, gid = wgid / nig, fm = gid * WGM, gsz = (nM - fm) < WGM ? (nM - fm) : WGM;
        u.pm = fm + ((wgid % nig) % gsz); u.pn = (wgid % nig) / gsz; return true;
    }
    __device__ __forceinline__ void a_ready(const Unit&) const {}
    __device__ __forceinline__ void done(const Unit&) const {}
};

__device__ __forceinline__ unsigned cvt_pk_bf16(float lo, float hi) { unsigned r; asm volatile("v_cvt_pk_bf16_f32 %0, %1, %2" : "=v"(r) : "v"(lo), "v"(hi)); return r; }
typedef float f32x2 __attribute__((ext_vector_type(2)));
__device__ __forceinline__ f32x2 gelu_pk(f32x2 v) {
    const f32x2 av = __builtin_elementwise_abs(v), d = av * 0.2316418882f + 1.0f;
    f32x2 t; t.x = __builtin_amdgcn_rcpf(d.x); t.y = __builtin_amdgcn_rcpf(d.y);
    f32x2 q = t * 0.5307027145f + (-0.7265760135f); q = q * t + 0.7107068705f; q = q * t + (-0.142248368f); q = q * t + 0.127414796f; q = q * t;
    const f32x2 s = (v * v) * (-0.72134752044f);
    f32x2 e; e.x = __builtin_amdgcn_exp2f(s.x); e.y = __builtin_amdgcn_exp2f(s.y);
    const f32x2 m = v * (q * e), r = v - m;
    f32x2 o; o.x = v.x < 0.f ? m.x : r.x; o.y = v.y < 0.f ? m.y : r.y; return o;
}

__device__ __forceinline__ float silu_f(float v) { return v * __builtin_amdgcn_rcpf(1.0f + __expf(-v)); }
struct EpiProj {
    static constexpr bool PERM = true, AFTER_DRAIN = false;
    bf16_t* O; const float* rope;
    __device__ __forceinline__ void operator()(const f32x4 (&acc)[2][2][4][2], const Unit& u, int wr, int wc, int fr, int fq) const {
        const int sec = u.pn >> 1;
        const int row0 = u.pm * BM + wr * 64 + fr, col0 = u.pn * BM + wc * 32 + 8 * fq;
        const int i0 = wc * 16 + 4 * fq;
#pragma unroll
        for (int ai = 0; ai < 2; ++ai)
#pragma unroll
            for (int m = 0; m < 4; ++m) {
                const int row = row0 + ai * HALF + m * 16;
                bf16_t* rowp = O + (size_t)row * 3072 + col0;
                f32x4 r0 = (f32x4){1.f, 0.f, 1.f, 0.f}, r1 = r0;
                if (sec == 2 || sec == 3) { const f32x4* rp = (const f32x4*)(rope + ((size_t)(row & 4095) * 64 + i0) * 2); r0 = rp[0]; r1 = rp[1]; }
#pragma unroll
                for (int bj = 0; bj < 2; ++bj) {
                    f32x4 v0 = acc[ai][bj][m][0], v1 = acc[ai][bj][m][1];
                    if (sec <= 1) {
                        f32x2 a = gelu_pk((f32x2){v0[0], v0[1]}), b = gelu_pk((f32x2){v0[2], v0[3]}), c = gelu_pk((f32x2){v1[0], v1[1]}), d = gelu_pk((f32x2){v1[2], v1[3]});
                        v0 = (f32x4){a.x, a.y, b.x, b.y}; v1 = (f32x4){c.x, c.y, d.x, d.y};
                    } else if (sec <= 3) {
                        const float sc = (sec == 3) ? 0.08838834764831845f : 1.0f;
                        f32x4 w0, w1;
                        w0[0] = (v0[0] * r0[0] - v0[1] * r0[1]) * sc; w0[1] = (v0[0] * r0[1] + v0[1] * r0[0]) * sc;
                        w0[2] = (v0[2] * r0[2] - v0[3] * r0[3]) * sc; w0[3] = (v0[2] * r0[3] + v0[3] * r0[2]) * sc;
                        w1[0] = (v1[0] * r1[0] - v1[1] * r1[1]) * sc; w1[1] = (v1[0] * r1[1] + v1[1] * r1[0]) * sc;
                        w1[2] = (v1[2] * r1[2] - v1[3] * r1[3]) * sc; w1[3] = (v1[2] * r1[3] + v1[3] * r1[2]) * sc;
                        v0 = w0; v1 = w1;
                    } else if (sec == 5) {
#pragma unroll
                        for (int j = 0; j < 4; ++j) { v0[j] = silu_f(v0[j]); v1[j] = silu_f(v1[j]); }
                    }
                    u32x4 w; w.x = cvt_pk_bf16(v0[0], v0[1]); w.y = cvt_pk_bf16(v0[2], v0[3]); w.z = cvt_pk_bf16(v1[0], v1[1]); w.w = cvt_pk_bf16(v1[2], v1[3]);
                    *(u32x4*)(rowp + bj * HALF) = w;
                }
            }
    }
};
struct EpiPlainBf16 {
    static constexpr bool PERM = true, AFTER_DRAIN = false;
    bf16_t* O; int ldc;
    __device__ __forceinline__ void operator()(const f32x4 (&acc)[2][2][4][2], const Unit& u, int wr, int wc, int fr, int fq) const {
        const int row0 = u.pm * BM + wr * 64 + fr, col0 = u.pn * BM + wc * 32 + 8 * fq;
#pragma unroll
        for (int ai = 0; ai < 2; ++ai)
#pragma unroll
            for (int m = 0; m < 4; ++m) { bf16_t* rowp = O + (size_t)(row0 + ai * HALF + m * 16) * ldc + col0;
#pragma unroll
                for (int bj = 0; bj < 2; ++bj) { const f32x4 v0 = acc[ai][bj][m][0], v1 = acc[ai][bj][m][1];
                    u32x4 w; w.x = cvt_pk_bf16(v0[0], v0[1]); w.y = cvt_pk_bf16(v0[2], v0[3]); w.z = cvt_pk_bf16(v1[0], v1[1]); w.w = cvt_pk_bf16(v1[2], v1[3]);
                    *(u32x4*)(rowp + bj * HALF) = w; } }
    }
};
struct EpiResF32 {
    static constexpr bool PERM = false, AFTER_DRAIN = false;
    const float* X; float* Z; int ldc; float alpha;
    __device__ __forceinline__ void operator()(const f32x4 (&acc)[2][2][4][2], const Unit& u, int wr, int wc, int fr, int fq) const {
        const int row0 = u.pm * BM + wr * 64 + fr, col0 = u.pn * BM + wc * 32 + 4 * fq;
#pragma unroll
        for (int ai = 0; ai < 2; ++ai)
#pragma unroll
            for (int m = 0; m < 4; ++m) { const size_t off = (size_t)(row0 + ai * HALF + m * 16) * ldc + col0;
#pragma unroll
                for (int bj = 0; bj < 2; ++bj)
#pragma unroll
                    for (int n = 0; n < 2; ++n) { const f32x4 xv = *(const f32x4*)(X + off + bj * HALF + n * 16); *(f32x4*)(Z + off + bj * HALF + n * 16) = acc[ai][bj][m][n] + xv * alpha; } }
    }
};
template <class Epi, class Sched, bool ALIGN_EPI = false, bool SP2 = false>
__device__ __forceinline__ void gemm_phase(PG8_LAS unsigned char* lds, const Gemm g, const Sched& S, const Epi& E) {
    const int tid = threadIdx.x, wid = __builtin_amdgcn_readfirstlane(tid >> 6), lane = tid & 63, wr = wid >> 2, wc = wid & 3, fr = lane & 15, fq = lane >> 4;
    const int K = g.K, nt = K / BK;
    unsigned voffA[2], voffB[2];
#pragma unroll
    for (int i = 0; i < 2; ++i) { int R, C; stage_rc(tid * 16 + i * 8192, R, C); const int Rb = Epi::PERM ? ((R & ~31) + perm32(R & 31)) : R;
        voffA[i] = (unsigned)(R * K + C) * 2u; voffB[i] = (unsigned)(Rb * K + C) * 2u; }
    const size_t kstep = (size_t)(BK * 2);
    const size_t hstep = (size_t)HALF * K * 2;
    const size_t tstep = 2 * hstep;
    const unsigned ldsw = (unsigned)wid * 1024u;
    const int aoff = lds_byte(wr * 64 + fr, fq * 8), boff = lds_byte(wc * 32 + fr, fq * 8);
#define PG8_SA(b, h) (((b) * 2 + (h)) * HTB)
#define PG8_SB(b, h) ((4 + (b) * 2 + (h)) * HTB)
#define PG8_STAGE(bufoff, gbase, voff) do { _Pragma("unroll") for (int _i = 0; _i < 2; ++_i) \
        __builtin_amdgcn_global_load_lds((const unsigned*)((const char*)(gbase) + (voff)[_i]), (PG8_LAS unsigned*)(lds + (bufoff) + ldsw + _i * 8192), 16, 0, 0); } while (0)
#define PG8_LDA(dst, b, h) do { _Pragma("unroll") for (int m = 0; m < 4; ++m) _Pragma("unroll") for (int k = 0; k < 2; ++k) dst[m][k] = *(const PG8_LAS bf16x8*)(lds + PG8_SA(b, h) + aoff + m * 2048 + k * 1024); } while (0)
#define PG8_LDB(dst, b, h) do { _Pragma("unroll") for (int n = 0; n < 2; ++n) _Pragma("unroll") for (int k = 0; k < 2; ++k) dst[n][k] = *(const PG8_LAS bf16x8*)(lds + PG8_SB(b, h) + boff + n * 2048 + k * 1024); } while (0)
#define PG8_MMA(ai, bj, At, Bt) do { __builtin_amdgcn_s_setprio(1); _Pragma("unroll") for (int m = 0; m < 4; ++m) _Pragma("unroll") for (int n = 0; n < 2; ++n) _Pragma("unroll") for (int k = 0; k < 2; ++k) \
        acc[ai][bj][m][n] = __builtin_amdgcn_mfma_f32_16x16x32_bf16(Bt[n][k], At[m][k], acc[ai][bj][m][n], 0, 0, 0); __builtin_amdgcn_s_setprio(0); } while (0)
#define PG8_WAIT_V(n) asm volatile("s_waitcnt vmcnt(" #n ")" ::: "memory")
#define PG8_WAIT_L(n) asm volatile("s_waitcnt lgkmcnt(" #n ")" ::: "memory")
#define PG8_BAR __builtin_amdgcn_s_barrier()
#define PG8_SCHED __builtin_amdgcn_sched_barrier(0)
    Unit cur, nxt; int ui = 0;
    if (!S.next(0, cur)) return;
    f32x4 acc[2][2][4][2];
#pragma unroll
    for (int a = 0; a < 2; ++a)
#pragma unroll
        for (int b = 0; b < 2; ++b)
#pragma unroll
            for (int m = 0; m < 4; ++m)
#pragma unroll
                for (int n = 0; n < 2; ++n) acc[a][b][m][n] = (f32x4){0.f, 0.f, 0.f, 0.f};
    bf16x8 At[4][2], B0[2][2], B1[2][2];
    const char* cA = (const char*)g.A + (size_t)cur.pm * tstep; const char* cB = (const char*)g.Bt + (size_t)cur.pn * tstep;
    S.a_ready(cur);
    if constexpr (SP2) {
        PG8_STAGE(PG8_SB(0, 0), cB, voffB); PG8_STAGE(PG8_SB(0, 1), cB + hstep, voffB); PG8_STAGE(PG8_SA(0, 0), cA, voffA); PG8_STAGE(PG8_SA(0, 1), cA + hstep, voffA);
        if (wr == 1) PG8_BAR;
        PG8_WAIT_V(2); PG8_BAR;
        PG8_STAGE(PG8_SB(1, 0), cB + kstep, voffB); PG8_STAGE(PG8_SA(1, 0), cA + kstep, voffA); PG8_STAGE(PG8_SB(1, 1), cB + hstep + kstep, voffB);
        PG8_WAIT_V(6); PG8_BAR;
    } else {
        PG8_STAGE(PG8_SB(0, 0), cB, voffB); PG8_STAGE(PG8_SA(0, 0), cA, voffA); PG8_STAGE(PG8_SB(0, 1), cB + hstep, voffB); PG8_STAGE(PG8_SA(0, 1), cA + hstep, voffA);
        if (wr == 1) PG8_BAR;
        PG8_WAIT_V(4); PG8_BAR;
        PG8_STAGE(PG8_SB(1, 0), cB + kstep, voffB); PG8_STAGE(PG8_SA(1, 0), cA + kstep, voffA); PG8_STAGE(PG8_SB(1, 1), cB + hstep + kstep, voffB);
        PG8_WAIT_V(6); PG8_BAR;
    }
    for (;;) {
        const bool has_next = S.next(ui + 1, nxt);
        const char* nA = has_next ? (const char*)g.A + (size_t)nxt.pm * tstep : cA; const char* nB = has_next ? (const char*)g.Bt + (size_t)nxt.pn * tstep : cB;
        for (int t = 0; t < nt; t += 2) {
            const bool last = (t == nt - 2);
            const char* a1 = cA + (size_t)(t + 1) * kstep;
            const char* a2 = last ? nA : cA + (size_t)(t + 2) * kstep; const char* b2 = last ? nB : cB + (size_t)(t + 2) * kstep;
            const char* a3 = a2 + kstep; const char* b3 = b2 + kstep;
            if (last && has_next) S.a_ready(nxt);
            if constexpr (SP2) {
            PG8_LDB(B0, 0, 0); PG8_LDB(B1, 0, 1); PG8_SCHED; PG8_LDA(At, 0, 0); PG8_STAGE(PG8_SA(1, 1), a1 + hstep, voffA);
            PG8_WAIT_V(8); PG8_WAIT_L(0); PG8_BAR; PG8_MMA(0, 0, At, B0); PG8_MMA(0, 1, At, B1); PG8_BAR; PG8_SCHED;
            PG8_LDA(At, 0, 1); PG8_STAGE(PG8_SB(0, 0), b2, voffB); PG8_STAGE(PG8_SB(0, 1), b2 + hstep, voffB); PG8_STAGE(PG8_SA(0, 0), a2, voffA);
            PG8_WAIT_V(8); PG8_WAIT_L(0); PG8_BAR; PG8_MMA(1, 0, At, B0); PG8_MMA(1, 1, At, B1); PG8_BAR; PG8_SCHED;
            PG8_LDB(B0, 1, 0); PG8_LDB(B1, 1, 1); PG8_SCHED; PG8_LDA(At, 1, 0); PG8_STAGE(PG8_SA(0, 1), a2 + hstep, voffA);
            PG8_WAIT_V(8); PG8_WAIT_L(0); PG8_BAR; PG8_MMA(0, 0, At, B0); PG8_MMA(0, 1, At, B1); PG8_BAR; PG8_SCHED;
            PG8_LDA(At, 1, 1); PG8_STAGE(PG8_SB(1, 0), b3, voffB); PG8_STAGE(PG8_SB(1, 1), b3 + hstep, voffB); PG8_STAGE(PG8_SA(1, 0), a3, voffA);
            PG8_WAIT_V(8); PG8_WAIT_L(0); PG8_BAR; PG8_MMA(1, 0, At, B0); PG8_MMA(1, 1, At, B1); PG8_BAR; PG8_SCHED;
            } else {
            PG8_LDB(B0, 0, 0); PG8_SCHED; PG8_LDA(At, 0, 0); PG8_STAGE(PG8_SA(1, 1), a1 + hstep, voffA);
            PG8_WAIT_L(8); PG8_BAR; PG8_WAIT_L(0); PG8_MMA(0, 0, At, B0); PG8_BAR; PG8_SCHED;
            PG8_LDB(B1, 0, 1); PG8_STAGE(PG8_SB(0, 0), b2, voffB);
            PG8_BAR; PG8_WAIT_L(0); PG8_MMA(0, 1, At, B1); PG8_BAR;
            PG8_LDA(At, 0, 1); PG8_STAGE(PG8_SA(0, 0), a2, voffA);
            PG8_BAR; PG8_WAIT_L(0); PG8_MMA(1, 0, At, B0); PG8_BAR; PG8_SCHED;
            PG8_STAGE(PG8_SB(0, 1), b2 + hstep, voffB);
            PG8_WAIT_V(6); PG8_BAR; PG8_MMA(1, 1, At, B1); PG8_BAR;
            PG8_LDB(B0, 1, 0); PG8_SCHED; PG8_LDA(At, 1, 0); PG8_STAGE(PG8_SA(0, 1), a2 + hstep, voffA);
            PG8_WAIT_L(8); PG8_BAR; PG8_WAIT_L(0); PG8_MMA(0, 0, At, B0); PG8_BAR; PG8_SCHED;
            PG8_LDB(B1, 1, 1); PG8_STAGE(PG8_SB(1, 0), b3, voffB);
            PG8_BAR; PG8_WAIT_L(0); PG8_MMA(0, 1, At, B1); PG8_BAR;
            PG8_LDA(At, 1, 1); PG8_STAGE(PG8_SA(1, 0), a3, voffA);
            PG8_BAR; PG8_WAIT_L(0); PG8_MMA(1, 0, At, B0); PG8_BAR; PG8_SCHED;
            PG8_STAGE(PG8_SB(1, 1), b3 + hstep, voffB);
            PG8_WAIT_V(6); PG8_BAR; PG8_MMA(1, 1, At, B1); PG8_BAR;
            }
        }
        if constexpr (ALIGN_EPI) { if (wr == 0) PG8_BAR; }
        if constexpr (!Epi::AFTER_DRAIN) { E(acc, cur, wr, wc, fr, fq); S.done(cur); }
        if (!has_next) break;
#pragma unroll
        for (int a = 0; a < 2; ++a)
#pragma unroll
            for (int b = 0; b < 2; ++b)
#pragma unroll
                for (int m = 0; m < 4; ++m)
#pragma unroll
                    for (int n = 0; n < 2; ++n) acc[a][b][m][n] = (f32x4){0.f, 0.f, 0.f, 0.f};
        cur = nxt; cA = nA; cB = nB; ++ui;
        if constexpr (ALIGN_EPI) { if (wr == 1) PG8_BAR; }
    }
    PG8_WAIT_V(0);
    if constexpr (!ALIGN_EPI) { if (wr == 0) PG8_BAR; }
    PG8_BAR;
    if constexpr (Epi::AFTER_DRAIN) { E.fused(acc, cur, wr, wc, fr, fq, lds, wid, lane); S.done(cur); }
#undef PG8_SA
#undef PG8_SB
#undef PG8_STAGE
#undef PG8_LDA
#undef PG8_LDB
#undef PG8_MMA
#undef PG8_WAIT_V
#undef PG8_WAIT_L
#undef PG8_BAR
#undef PG8_SCHED
}
}
#ifndef REP0
#define REP0 1
#endif
#ifndef REP1
#define REP1 1
#endif
#ifndef REP2
#define REP2 1
#endif
#ifndef REP3
#define REP3 1
#endif
#ifndef REP4
#define REP4 1
#endif
#ifndef REP5
#define REP5 1
#endif
#ifndef REP6
#define REP6 1
#endif
#ifndef REP7
#define REP7 1
#endif
#ifndef REP8
#define REP8 1
#endif
#ifndef REP9
#define REP9 1
#endif
#ifndef REP10
#define REP10 1
#endif
#ifndef REP11
#define REP11 1
#endif
#ifndef REP12
#define REP12 1
#endif
#ifndef NAIVE_P4
#define NAIVE_P4 0
#endif
#ifndef NAIVE_P2
#define NAIVE_P2 0
#endif
#ifndef NAIVE_P8
#define NAIVE_P8 0
#endif
#ifndef N_LAUNCHES
#define N_LAUNCHES 1
#endif
constexpr int NWAVES = 8, NTHREADS = 512;
constexpr int BATCH = 8, SEQ = 4096, D = 1024, M = BATCH * SEQ;
constexpr int INW = 3072;
constexpr int NCHUNK = M / 128;
constexpr int PEER_H = 8, PEER_K = 16, NSEL = 128, NEXP = 16384;
constexpr float LN_EPS = 1e-5f, GN_EPS = 1e-5f;
constexpr float ALPHA = 1.189207115002721f;

constexpr size_t MiB = 1u << 20;
constexpr size_t WS_CTL = 0, CTL_ZERO_BYTES = 1 * MiB;
constexpr size_t WS_SKB = 1 * MiB;
constexpr size_t WS_WSB = 1 * MiB + 512 * 1024;
constexpr size_t WS_ROPE = 2 * MiB;
constexpr size_t WS_WIN = 4 * MiB;
constexpr size_t WS_WOUT = 10 * MiB;
constexpr size_t WS_WQ = 12 * MiB;
constexpr size_t WS_U8 = 16 * MiB;
constexpr size_t WS_SU = 32 * MiB;
constexpr size_t WS_SV = 32 * MiB + 65536;
constexpr size_t WS_V8 = 48 * MiB;
constexpr size_t WS_CS = 64 * MiB;
constexpr size_t WS_CQ = 112 * MiB;
constexpr size_t WS_SH = 65 * MiB;
constexpr size_t WS_H8 = 272 * MiB;
constexpr size_t WS_PDOT = 336 * MiB;
constexpr size_t WS_PROJ = 80 * MiB;
constexpr size_t WS_Z = 80 * MiB;
constexpr size_t WS_IDX = 80 * MiB;
constexpr size_t WS_GATE = 96 * MiB;
constexpr size_t WS_H = 208 * MiB;
constexpr size_t WS_XB = 272 * MiB;
constexpr size_t WS_Y = 272 * MiB;
constexpr size_t WS_ST = 336 * MiB;
constexpr size_t WS_PREV = 400 * MiB;
constexpr size_t WS_QP = 336 * MiB;
constexpr size_t WS_END = 464 * MiB;

constexpr int LDS_BYTES = 147456;

#define GAS __attribute__((address_space(1)))
#define LAS __attribute__((address_space(3)))
typedef unsigned short bf16;
typedef unsigned v4u __attribute__((ext_vector_type(4)));
typedef float f32x4 __attribute__((ext_vector_type(4)));

__device__ __forceinline__ unsigned f2bf(float f) { unsigned u = __builtin_bit_cast(unsigned, f); return (u + 0x7fffu + ((u >> 16) & 1u)) >> 16; }
__device__ __forceinline__ unsigned pk2(float lo, float hi) { return f2bf(lo) | (f2bf(hi) << 16); }
__device__ __forceinline__ float bf2f(unsigned short b) { return __builtin_bit_cast(float, (unsigned)b << 16); }
__device__ __forceinline__ float bflo(unsigned w) { return __builtin_bit_cast(float, w << 16); }
__device__ __forceinline__ float bfhi(unsigned w) { return __builtin_bit_cast(float, w & 0xffff0000u); }
__device__ __forceinline__ float wave_sum(float v) {
#pragma unroll
    for (int o = 1; o < 64; o <<= 1) v += __shfl_xor(v, o);
    return v;
}
__device__ __forceinline__ float gelu_exact(float v) { return 0.5f * v * (1.0f + erff(v * 0.70710678118654752f)); }
__device__ __forceinline__ float log_sigmoid_f(float x) { return -log1pf(expf(-x)); }

typedef short bf16x8 __attribute__((ext_vector_type(8)));
typedef short s16x4 __attribute__((ext_vector_type(4)));
typedef unsigned v2u __attribute__((ext_vector_type(2)));
__device__ __forceinline__ unsigned off_b(unsigned row, unsigned ch) { return 256u * row + 16u * (ch ^ (((row & 3u) << 2) | ((row >> 2) & 3u))); }
__device__ __forceinline__ bf16x8 frag_row(const LAS unsigned char* tile, int lane, int rb, int s) {
    return *(const LAS bf16x8*)(tile + off_b((unsigned)((lane & 15) + 16 * rb), (unsigned)(4 * s + (lane >> 4))));
}
__device__ __forceinline__ bf16x8 frag_tr(const LAS unsigned char* tile, int lane, int c, int ks) {
    const unsigned g = (unsigned)lane >> 4, q = ((unsigned)lane & 15u) >> 2, p = (unsigned)lane & 3u;
    const unsigned a0 = off_b(32u * ks + 8u * g + q, 2u * c + (p >> 1)) + 8u * (p & 1u);
    const unsigned a1 = off_b(32u * ks + 8u * g + 4u + q, 2u * c + (p >> 1)) + 8u * (p & 1u);
    typedef short v4i16_t __attribute__((ext_vector_type(4)));
    const s16x4 lo = __builtin_bit_cast(s16x4, __builtin_amdgcn_ds_read_tr16_b64_v4i16((LAS v4i16_t*)(tile + a0)));
    const s16x4 hi = __builtin_bit_cast(s16x4, __builtin_amdgcn_ds_read_tr16_b64_v4i16((LAS v4i16_t*)(tile + a1)));
    return (bf16x8){lo[0], lo[1], lo[2], lo[3], hi[0], hi[1], hi[2], hi[3]};
}
#define MFMA16(a, b, c) __builtin_amdgcn_mfma_f32_16x16x32_bf16((a), (b), (c), 0, 0, 0)
__device__ __forceinline__ void stage_tile(LAS unsigned char* tile, const bf16* src, int ld, int tid) {
    v4u v[4];
#pragma unroll
    for (int i = 0; i < 4; ++i) { const int c = tid + NTHREADS * i, row = c >> 4, ch = c & 15; v[i] = *(const v4u*)(src + (size_t)row * ld + ch * 8); }
#pragma unroll
    for (int i = 0; i < 4; ++i) { const int c = tid + NTHREADS * i, row = c >> 4, ch = c & 15; *(LAS v4u*)(tile + off_b(row, ch)) = v[i]; }
}
__device__ __forceinline__ v4u scale_chunk(v4u v, float s) {
    v4u o; o.x = pk2(bflo(v.x) * s, bfhi(v.x) * s); o.y = pk2(bflo(v.y) * s, bfhi(v.y) * s); o.z = pk2(bflo(v.z) * s, bfhi(v.z) * s); o.w = pk2(bflo(v.w) * s, bfhi(v.w) * s); return o;
}

__device__ __forceinline__ int f2key(float v, int payload) { const int b = __float_as_int(v); const int t = b ^ ((b >> 31) & 0x7fffffff); return (t & ~0xFF) | payload; }
__device__ __forceinline__ float key2f(int k) { const int t = k & ~0xFF; return __int_as_float(t ^ ((t >> 31) & 0x7fffffff)); }
__device__ __forceinline__ void merge16_desc(int (&k)[16]) {
#pragma unroll
    for (int stride = 8; stride > 0; stride >>= 1)
#pragma unroll
        for (int i = 0; i < 16; ++i) { const int l = i ^ stride; if (l > i) { const int a = k[i], b = k[l]; k[i] = max(a, b); k[l] = min(a, b); } }
}
__device__ __forceinline__ void sort16_desc(int (&k)[16]) {
#pragma unroll
    for (int size = 2; size <= 16; size <<= 1)
#pragma unroll
        for (int stride = size >> 1; stride > 0; stride >>= 1)
#pragma unroll
            for (int i = 0; i < 16; ++i) { const int l = i ^ stride; if (l > i) { const int a = k[i], b = k[l]; const bool desc = ((i & size) == 0); k[i] = desc ? max(a, b) : min(a, b); k[l] = desc ? min(a, b) : max(a, b); } }
}

#define XB_TMO      128
#define XB_XCNT(j)  (256  + 64 * (j))
#define XB_XSUB(j)  (1280 + 64 * (j))
#define XB_XGEN(j)  (2304 + 64 * (j))
#define XB_TOP      3328
#define XB_TOPGEN   3392
#define XCD_BAR_WORDS 3456
#define XB_SPIN_CAP (1u << 18)

__device__ __forceinline__ unsigned xb_ld(unsigned* p)              { return __hip_atomic_load(p, __ATOMIC_RELAXED, __HIP_MEMORY_SCOPE_AGENT); }
__device__ __forceinline__ unsigned xb_add(unsigned* p, unsigned v) { return __hip_atomic_fetch_add(p, v, __ATOMIC_RELAXED, __HIP_MEMORY_SCOPE_AGENT); }
__device__ __forceinline__ unsigned xb_xcc_id() { return (unsigned)__builtin_amdgcn_s_getreg((3 << 11) | 20) & 0xFu; }
#define XB_SPIN(cond, bar) do { unsigned _sp = 0; while (cond) { __builtin_amdgcn_s_sleep(1); \
    if ((++_sp & 255u) == 0u) { if (xb_ld(&(bar)[XB_TMO])) break; if (_sp > XB_SPIN_CAP) { atomicAdd(&(bar)[XB_TMO], 1u); break; } } } } while (0)

struct XcdBarrier {
    unsigned* bar; unsigned x;
    volatile LAS unsigned* st;
};

__device__ __forceinline__ XcdBarrier xcd_barrier_post(unsigned* bar, volatile LAS unsigned* st) {
    XcdBarrier b; b.bar = bar; b.x = xb_xcc_id(); b.st = st;
    if (threadIdx.x == 0) (void)xb_add(&bar[XB_XCNT(b.x)], 1u);
    return b;
}
__device__ __forceinline__ void xcd_barrier_complete(unsigned* bar, unsigned x, unsigned& nloc, unsigned& nx) {
    const unsigned G = gridDim.x * gridDim.y * gridDim.z;
    unsigned sum, cnt, mine, sp = 0u;
    for (;;) {
        sum = 0u; cnt = 0u; mine = 0u;
#pragma unroll
        for (unsigned j = 0; j < 16; ++j) { const unsigned c = xb_ld(&bar[XB_XCNT(j)]); sum += c; cnt += (c > 0u) ? 1u : 0u; mine = (j == x) ? c : mine; }
        if (sum == G) break;
        __builtin_amdgcn_s_sleep(1);
        if ((++sp & 255u) == 0u) { if (xb_ld(&bar[XB_TMO])) break; if (sp > XB_SPIN_CAP) { atomicAdd(&bar[XB_TMO], 1u); break; } }
    }
    nloc = mine > 0u ? mine : 1u; nx = cnt > 0u ? cnt : 1u;
}

__device__ __forceinline__ void xcd_barrier(const XcdBarrier& b) {
    asm volatile("s_waitcnt vmcnt(0)" ::: "memory");
    __syncthreads();
    if (threadIdx.x == 0) {
        unsigned* bar = b.bar;
        __builtin_amdgcn_s_waitcnt(0);
        unsigned nloc = b.st[0], nx = b.st[1];
        if (nloc == 0u) { xcd_barrier_complete(bar, b.x, nloc, nx); b.st[0] = nloc; b.st[1] = nx; }
        const unsigned old = xb_add(&bar[XB_XSUB(b.x)], 1u);
        const unsigned gen = old / nloc;
        if (old + 1u == (gen + 1u) * nloc) {
            __builtin_amdgcn_fence(__ATOMIC_RELEASE, "agent");
            asm volatile("s_waitcnt vmcnt(0)" ::: "memory");
            const unsigned og = xb_add(&bar[XB_TOP], 1u);
            const unsigned tg = og / nx;
            if (og + 1u == (tg + 1u) * nx) xb_add(&bar[XB_TOPGEN], 1u);
            else XB_SPIN(xb_ld(&bar[XB_TOPGEN]) == tg, bar);
            __builtin_amdgcn_fence(__ATOMIC_ACQUIRE, "agent");
            xb_add(&bar[XB_XGEN(b.x)], 1u);
            asm volatile("s_waitcnt vmcnt(0)" ::: "memory");
        } else {
            XB_SPIN(xb_ld(&bar[XB_XGEN(b.x)]) == gen, bar);
            __builtin_amdgcn_fence(__ATOMIC_ACQUIRE, "agent");
            asm volatile("s_waitcnt vmcnt(0)" ::: "memory");
        }
    }
    __syncthreads();
}

constexpr int CW_BAR = 4096;
constexpr int MISC_OFF = LDS_BYTES - 64;

struct Args {
    const float* in[18]; float* out; unsigned char* ws; int ph_lo, ph_hi;
};

template <int MODE>
__device__ __forceinline__ int dst_row(int n) {
    if (MODE == 1 && n >= 1024 && n < 2048) { const int j = n & 127; return (n & ~127) + ((j < 64) ? 2 * j : 2 * (j - 64) + 1); }
    return n;
}
template <int MODE>
__device__ __forceinline__ void p0_transpose_item(const float* W, int K, int N, bf16* WT, LAS float* scr, int item, int lane) {
    const int nblk = N / 32, kb = item / nblk, nb = item % nblk, k0 = 64 * kb, n0 = 32 * nb;
#pragma unroll 8
    for (int i = 0; i < 32; ++i) { const int kk = 2 * i + (lane >> 5); scr[kk * 33 + (lane & 31)] = W[(size_t)(k0 + kk) * N + n0 + (lane & 31)]; }
    asm volatile("s_waitcnt lgkmcnt(0)" ::: "memory");
    const int c = lane & 7;
#pragma unroll
    for (int j = 0; j < 4; ++j) { const int n = (lane >> 3) + 8 * j; const LAS float* s = scr + (8 * c) * 33 + n;
        v4u o; o.x = pk2(s[0 * 33], s[1 * 33]); o.y = pk2(s[2 * 33], s[3 * 33]); o.z = pk2(s[4 * 33], s[5 * 33]); o.w = pk2(s[6 * 33], s[7 * 33]);
        *(GAS v4u*)(WT + (size_t)dst_row<MODE>(n0 + n) * K + k0 + 8 * c) = o; }
    asm volatile("s_waitcnt lgkmcnt(0)" ::: "memory");
}
__device__ __forceinline__ void p0_convert(const float* src, bf16* dst, size_t n8, size_t gt, size_t ngt) {
    for (size_t i = gt; i < n8; i += ngt) {
        const f32x4 a = *(const f32x4*)(src + i * 8), b = *(const f32x4*)(src + i * 8 + 4);
        v4u o; o.x = pk2(a[0], a[1]); o.y = pk2(a[2], a[3]); o.z = pk2(b[0], b[1]); o.w = pk2(b[2], b[3]);
        *(v4u*)(dst + i * 8) = o;
    }
}

template <int PH_LO, int PH_HI>
__global__ void __launch_bounds__(NTHREADS, 2) fwd_kernel(Args args) {
    extern __shared__ __attribute__((aligned(16))) unsigned char lds_raw[];
    LAS unsigned char* lds = (LAS unsigned char*)lds_raw;
    LAS float* sm = (LAS float*)lds_raw;
    const int G = gridDim.x, bx = blockIdx.x;
#define PHASE_COORDS \
    int tid = threadIdx.x; asm volatile("" : "+v"(tid)); \
    const int lane = tid & 63, wave = __builtin_amdgcn_readfirstlane(tid >> 6); \
    const int gw = bx * NWAVES + wave, NGW = G * NWAVES; \
    const size_t gt = (size_t)bx * NTHREADS + tid, ngt = (size_t)G * NTHREADS; \
    (void)lane; (void)wave; (void)gw; (void)NGW; (void)gt; (void)ngt;
    unsigned char* ws = args.ws;
    const float* x = args.in[0];
    bf16* SKB = (bf16*)(ws + WS_SKB); bf16* WSB = (bf16*)(ws + WS_WSB); float* ROPE = (float*)(ws + WS_ROPE);
    bf16* WIN = (bf16*)(ws + WS_WIN); bf16* WOUT = (bf16*)(ws + WS_WOUT); bf16* WQ = (bf16*)(ws + WS_WQ);
    unsigned char* U8 = ws + WS_U8; unsigned char* V8 = ws + WS_V8; float* SU = (float*)(ws + WS_SU); float* SV = (float*)(ws + WS_SV);
    float* CS = (float*)(ws + WS_CS); short* CQ = (short*)(ws + WS_CQ); float* SH = (float*)(ws + WS_SH); unsigned char* H8 = ws + WS_H8; int* PDOT = (int*)(ws + WS_PDOT);
    bf16* PROJ = (bf16*)(ws + WS_PROJ); float* Z = (float*)(ws + WS_Z); unsigned short* IDX = (unsigned short*)(ws + WS_IDX); float* GATE = (float*)(ws + WS_GATE);
    bf16* H = (bf16*)(ws + WS_H); bf16* XB = (bf16*)(ws + WS_XB); bf16* Y = (bf16*)(ws + WS_Y);
    bf16* ST = (bf16*)(ws + WS_ST); bf16* PREV = (bf16*)(ws + WS_PREV); bf16* QP = (bf16*)(ws + WS_QP);
#define IN(k) (PH_LO <= (k) && (k) < PH_HI)
#define BOTH(k) (IN(k) && IN((k) + 1))
    volatile LAS unsigned* MISC = (volatile LAS unsigned*)(lds + MISC_OFF);
    XcdBarrier bar; bar.bar = (unsigned*)(ws + WS_CTL) + CW_BAR; bar.x = 0; bar.st = nullptr;
    if constexpr (PH_HI - PH_LO > 1) {
        if (threadIdx.x < 16) MISC[threadIdx.x] = 0u;
        __syncthreads();
        bar = xcd_barrier_post((unsigned*)(ws + WS_CTL) + CW_BAR, MISC + 8);
    }
#define GRID_BAR(k) do { if constexpr (BOTH(k)) xcd_barrier(bar); } while (0)

    if constexpr (IN(0)) for (int rep_ = 0; rep_ < REP0; ++rep_) {
        PHASE_COORDS
        LAS float* scr = sm + wave * 4096;
        constexpr int I_IN = (D / 64) * (INW / 32), I_OUT = (D / 64) * (D / 32), I_Q = (D / 64) * (2048 / 32);
        for (int it = gw; it < I_IN + I_OUT + I_Q; it += NGW) {
            int r = it;
            if (r < I_IN) { p0_transpose_item<1>(args.in[1], D, INW, WIN, scr, r, lane); continue; } r -= I_IN;
            if (r < I_OUT) { p0_transpose_item<0>(args.in[9], D, D, WOUT, scr, r, lane); continue; } r -= I_OUT;
            p0_transpose_item<0>(args.in[12], D, 2048, WQ, scr, r, lane);
        }
        p0_convert(args.in[13], SKB, (size_t)8 * 2 * 128 * 128 / 8, gt, ngt);
        p0_convert(args.in[4], WSB, (size_t)4 * 128 * 128 / 8, gt, ngt);
        for (int r = gw; r < 2 * NEXP; r += NGW) {
            const bool isv = r >= NEXP; const int e = isv ? r - NEXP : r;
            const float* src = (isv ? args.in[15] : args.in[14]) + (size_t)e * D + lane * 16;
            f32x4 a[4]; float mx = 0.f;
#pragma unroll
            for (int k = 0; k < 4; ++k) { a[k] = *(const f32x4*)(src + 4 * k); mx = fmaxf(mx, fmaxf(fmaxf(fabsf(a[k][0]), fabsf(a[k][1])), fmaxf(fabsf(a[k][2]), fabsf(a[k][3])))); }
#pragma unroll
            for (int o = 1; o < 64; o <<= 1) mx = fmaxf(mx, __shfl_xor(mx, o));
            const float inv = mx > 0.f ? 127.0f / mx : 0.f;
            const int bias = isv ? 128 : 0;
            unsigned wq[4];
#pragma unroll
            for (int k = 0; k < 4; ++k) {
                const int q0 = (int)rintf(a[k][0] * inv) + bias, q1 = (int)rintf(a[k][1] * inv) + bias, q2 = (int)rintf(a[k][2] * inv) + bias, q3 = (int)rintf(a[k][3] * inv) + bias;
                wq[k] = (unsigned)(q0 & 0xff) | ((unsigned)(q1 & 0xff) << 8) | ((unsigned)(q2 & 0xff) << 16) | ((unsigned)(q3 & 0xff) << 24);
            }
            *(v4u*)((isv ? V8 : U8) + ((size_t)(lane >> 3) * NEXP + e) * 128 + (lane & 7) * 16) = (v4u){wq[0], wq[1], wq[2], wq[3]};
            if (lane == 0) (isv ? SV : SU)[e] = mx * (1.0f / 127.0f);
        }
        p0_convert(x, XB, (size_t)M * D / 8, gt, ngt);
        for (size_t i = gt; i < (size_t)4096 * 64; i += ngt) {
            const int pos = (int)(i >> 6), k = (int)(i & 63);
            const float inv = powf(10000.0f, -(float)k / 64.0f);
            const float ang = (float)pos * inv;
            ROPE[i * 2] = cosf(ang); ROPE[i * 2 + 1] = sinf(ang);
        }
    }

    GRID_BAR(0);

    if constexpr (IN(1)) for (int rep_ = 0; rep_ < REP1; ++rep_) {
        PHASE_COORDS
        pg8::Gemm g{XB, WIN, M, INW, D}; pg8::StaticOrder S; S.init(M, INW, G, bx);
        pg8::EpiProj E{PROJ, ROPE};
        pg8::gemm_phase<pg8::EpiProj, pg8::StaticOrder, true, true>(lds, g, S, E);
    }

    GRID_BAR(1);

#if NAIVE_P2
    if constexpr (IN(2)) for (int rep_ = 0; rep_ < REP2; ++rep_) {
        PHASE_COORDS
        const float* lnw = args.in[2]; const float* lnb = args.in[3]; const float* wsf = args.in[4]; const float* bs = args.in[5];
        for (int ck = bx; ck < NCHUNK; ck += G) {
            const int t0 = ck * 128, bb = ck >> 5, cc = ck & 31;
            LAS float* stat = sm + 16384;
            for (int r = wave * 16; r < wave * 16 + 16; ++r) {
                const v4u raw = *(const v4u*)(PROJ + (size_t)(t0 + r) * INW + 512 + lane * 8);
                float v[8] = {bflo(raw.x), bfhi(raw.x), bflo(raw.y), bfhi(raw.y), bflo(raw.z), bfhi(raw.z), bflo(raw.w), bfhi(raw.w)};
                float s = 0.f;
#pragma unroll
                for (int j = 0; j < 8; ++j) s += v[j];
                const float mean = wave_sum(s) * (1.0f / 512.0f);
                float q = 0.f;
#pragma unroll
                for (int j = 0; j < 8; ++j) { const float d = v[j] - mean; q += d * d; }
                const float rstd = 1.0f / sqrtf(wave_sum(q) * (1.0f / 512.0f) + LN_EPS);
                if (lane == 0) { stat[r * 2] = mean; stat[r * 2 + 1] = rstd; }
            }
            __syncthreads();
#pragma unroll 1
            for (int h = 0; h < 4; ++h) {
                for (int i = tid; i < 16384; i += NTHREADS) {
                    const int m = i >> 7, d = i & 127, col = h * 128 + d;
                    const float v = bf2f(PROJ[(size_t)(t0 + m) * INW + 512 + col]);
                    sm[i] = (v - stat[m * 2]) * stat[m * 2 + 1] * lnw[col] + lnb[col];
                }
                __syncthreads();
                {
                    const int d = tid & 127, lg = tid >> 7;
#pragma unroll 1
                    for (int ps = 0; ps < 4; ++ps) {
                        const int l0 = lg * 32 + ps * 8;
                        float acc[8];
#pragma unroll
                        for (int li = 0; li < 8; ++li) acc[li] = 0.f;
#pragma unroll 2
                        for (int m = 0; m < 128; ++m) {
                            const float vv = sm[m * 128 + d];
#pragma unroll
                            for (int li = 0; li < 8; ++li) acc[li] += wsf[((size_t)h * 128 + l0 + li) * 128 + m] * vv;
                        }
#pragma unroll
                        for (int li = 0; li < 8; ++li) {
                            const int l = l0 + li;
                            const float mixed = acc[li] + bs[h * 128 + l];
                            const float uu = bf2f(PROJ[(size_t)(t0 + l) * INW + h * 128 + d]);
                            Y[(size_t)(t0 + l) * D + h * 128 + d] = (bf16)f2bf(uu * mixed);
                        }
                    }
                }
                __syncthreads();
            }
#pragma unroll 1
            for (int h = 0; h < 4; ++h) {
                LAS float* Kt = sm; LAS float* Vt = sm + 16384;
                for (int i = tid; i < 16384; i += NTHREADS) {
                    const int l = i >> 7, d = i & 127;
                    Kt[i] = bf2f(PROJ[(size_t)(t0 + l) * INW + 1536 + h * 128 + d]);
                    Vt[i] = bf2f(PROJ[(size_t)(t0 + l) * INW + 2048 + h * 128 + d]);
                }
                {
                    const float lgf = log_sigmoid_f(args.in[6][h]), lgb = log_sigmoid_f(args.in[7][h]);
                    if (tid < 128) { sm[32768 + tid] = expf((float)(127 - tid) * lgf); sm[32768 + 128 + tid] = expf((float)tid * lgb); }
                }
                __syncthreads();
                const int dk = tid & 127, g4 = tid >> 7;
                const size_t u0 = (size_t)((bb * 4 + h) * 32 + cc) * 16384;
#pragma unroll 1
                for (int ps = 0; ps < 4; ++ps) {
                    const int dv0 = g4 * 32 + ps * 8;
                    float af[8], ab[8];
#pragma unroll
                    for (int j = 0; j < 8; ++j) { af[j] = 0.f; ab[j] = 0.f; }
#pragma unroll 2
                    for (int l = 0; l < 128; ++l) {
                        const float kv = Kt[l * 128 + dk];
                        const float kf = kv * sm[32768 + l], kb = kv * sm[32768 + 128 + l];
#pragma unroll
                        for (int j = 0; j < 8; ++j) { const float vv = Vt[l * 128 + dv0 + j]; af[j] += kf * vv; ab[j] += kb * vv; }
                    }
#pragma unroll
                    for (int j = 0; j < 8; ++j) {
                        const int dv = dv0 + j;
                        ST[u0 + dv * 128 + dk] = (bf16)f2bf(af[j]);
                        ST[(size_t)1024 * 16384 + u0 + dv * 128 + dk] = (bf16)f2bf(ab[j]);
                    }
                }
                __syncthreads();
            }
        }
    }

#else
    if constexpr (IN(2)) for (int rep_ = 0; rep_ < REP2; ++rep_) {
        PHASE_COORDS
        const float* lnw = args.in[2]; const float* lnb = args.in[3]; const float* bs = args.in[5];
        LAS unsigned char* B0 = lds; LAS unsigned char* B1 = lds + 32768; LAS unsigned char* B2 = lds + 65536; LAS unsigned char* B3 = lds + 98304;
        LAS float* stat = (LAS float*)(lds + 131072);
        const int g = lane >> 4, fr = lane & 15;
        for (int ck = bx; ck < NCHUNK; ck += G) {
            const int t0 = ck * 128, bb = ck >> 5, cc = ck & 31;
            for (int r = wave * 16; r < wave * 16 + 16; ++r) {
                const v4u raw = *(const v4u*)(PROJ + (size_t)(t0 + r) * INW + 512 + lane * 8);
                float v[8] = {bflo(raw.x), bfhi(raw.x), bflo(raw.y), bfhi(raw.y), bflo(raw.z), bfhi(raw.z), bflo(raw.w), bfhi(raw.w)};
                float s = 0.f;
#pragma unroll
                for (int j = 0; j < 8; ++j) s += v[j];
                const float mean = wave_sum(s) * (1.0f / 512.0f);
                float q = 0.f;
#pragma unroll
                for (int j = 0; j < 8; ++j) { const float d = v[j] - mean; q += d * d; }
                const float rstd = 1.0f / sqrtf(wave_sum(q) * (1.0f / 512.0f) + LN_EPS);
                if (lane == 0) { stat[r * 2] = mean; stat[r * 2 + 1] = rstd; }
            }
            __syncthreads();
#pragma unroll 1
            for (int h = 0; h < 4; ++h) {
                const float lf2 = log_sigmoid_f(args.in[6][h]) * 1.4426950408889634f, lb2 = log_sigmoid_f(args.in[7][h]) * 1.4426950408889634f;
                const bf16* prow = PROJ + (size_t)t0 * INW + h * 128;
#pragma unroll
                for (int i = 0; i < 4; ++i) {
                    const int c = tid + NTHREADS * i, row = c >> 4, ch = c & 15;
                    const v4u raw = *(const v4u*)(prow + (size_t)row * INW + 512 + ch * 8);
                    const f32x4 w0 = *(const f32x4*)(lnw + h * 128 + ch * 8), w1 = *(const f32x4*)(lnw + h * 128 + ch * 8 + 4);
                    const f32x4 b0 = *(const f32x4*)(lnb + h * 128 + ch * 8), b1 = *(const f32x4*)(lnb + h * 128 + ch * 8 + 4);
                    const float mean = stat[row * 2], rstd = stat[row * 2 + 1];
                    v4u o;
                    o.x = pk2((bflo(raw.x) - mean) * rstd * w0[0] + b0[0], (bfhi(raw.x) - mean) * rstd * w0[1] + b0[1]);
                    o.y = pk2((bflo(raw.y) - mean) * rstd * w0[2] + b0[2], (bfhi(raw.y) - mean) * rstd * w0[3] + b0[3]);
                    o.z = pk2((bflo(raw.z) - mean) * rstd * w1[0] + b1[0], (bfhi(raw.z) - mean) * rstd * w1[1] + b1[1]);
                    o.w = pk2((bflo(raw.w) - mean) * rstd * w1[2] + b1[2], (bfhi(raw.w) - mean) * rstd * w1[3] + b1[3]);
                    *(LAS v4u*)(B0 + off_b(row, ch)) = o;
                }
                stage_tile(B1, prow + 1536, INW, tid);
#pragma unroll
                for (int i = 0; i < 4; ++i) {
                    const int c = tid + NTHREADS * i, row = c >> 4, ch = c & 15;
                    const v4u raw = *(const v4u*)(prow + (size_t)row * INW + 2048 + ch * 8);
                    *(LAS v4u*)(B2 + off_b(row, ch)) = scale_chunk(raw, exp2f((float)(127 - row) * lf2));
                    *(LAS v4u*)(B3 + off_b(row, ch)) = scale_chunk(raw, exp2f((float)row * lb2));
                }
                __syncthreads();
                {
                    bf16x8 wf[4];
#pragma unroll
                    for (int s = 0; s < 4; ++s) wf[s] = *(const bf16x8*)(WSB + ((size_t)h * 128 + 16 * wave + fr) * 128 + 32 * s + 8 * g);
                    f32x4 acc[8];
#pragma unroll
                    for (int nt = 0; nt < 8; ++nt) acc[nt] = (f32x4){0.f, 0.f, 0.f, 0.f};
#pragma unroll
                    for (int s = 0; s < 4; ++s)
#pragma unroll
                        for (int nt = 0; nt < 8; ++nt) acc[nt] = MFMA16(frag_tr(B0, lane, nt, s), wf[s], acc[nt]);
                    const int l = 16 * wave + fr;
                    const float bias = bs[h * 128 + l];
                    const bf16* urow = PROJ + (size_t)(t0 + l) * INW + h * 128;
                    bf16* yrow = Y + (size_t)(t0 + l) * D + h * 128;
#pragma unroll
                    for (int nt = 0; nt < 8; ++nt) {
                        const int d0 = 16 * nt + 4 * g;
                        const v2u u2 = *(const v2u*)(urow + d0);
                        v2u w; w.x = pk2(bflo(u2.x) * (acc[nt][0] + bias), bfhi(u2.x) * (acc[nt][1] + bias)); w.y = pk2(bflo(u2.y) * (acc[nt][2] + bias), bfhi(u2.y) * (acc[nt][3] + bias));
                        *(v2u*)(yrow + d0) = w;
                    }
                }
                {
                    f32x4 af[8], ab[8];
#pragma unroll
                    for (int nt = 0; nt < 8; ++nt) { af[nt] = (f32x4){0.f, 0.f, 0.f, 0.f}; ab[nt] = (f32x4){0.f, 0.f, 0.f, 0.f}; }
#pragma unroll
                    for (int s = 0; s < 4; ++s) {
                        const bf16x8 vf = frag_tr(B2, lane, wave, s), vb = frag_tr(B3, lane, wave, s);
#pragma unroll
                        for (int nt = 0; nt < 8; ++nt) { const bf16x8 kf = frag_tr(B1, lane, nt, s); af[nt] = MFMA16(kf, vf, af[nt]); ab[nt] = MFMA16(kf, vb, ab[nt]); }
                    }
                    const size_t u0 = (size_t)((bb * 4 + h) * 32 + cc) * 16384 + (size_t)(16 * wave + fr) * 128;
#pragma unroll
                    for (int nt = 0; nt < 8; ++nt) {
                        const int dk0 = 16 * nt + 4 * g;
                        v2u w; w.x = pk2(af[nt][0], af[nt][1]); w.y = pk2(af[nt][2], af[nt][3]);
                        *(v2u*)(ST + u0 + dk0) = w;
                        w.x = pk2(ab[nt][0], ab[nt][1]); w.y = pk2(ab[nt][2], ab[nt][3]);
                        *(v2u*)(ST + (size_t)1024 * 16384 + u0 + dk0) = w;
                    }
                }
                __syncthreads();
            }
        }
    }

#endif
    GRID_BAR(2);

    if constexpr (IN(3)) for (int rep_ = 0; rep_ < REP3; ++rep_) {
        PHASE_COORDS
        for (size_t v = gt; v < (size_t)2 * 32 * 2048; v += ngt) {
            const int dir = (int)(v >> 16), bh = (int)((v >> 11) & 31), e8 = (int)(v & 2047), h = bh & 3;
            const float lg = log_sigmoid_f(dir == 0 ? args.in[6][h] : args.in[7][h]);
            const float Gc = expf(128.0f * lg);
            float st[8];
#pragma unroll
            for (int j = 0; j < 8; ++j) st[j] = 0.f;
            for (int ci = 0; ci < 32; ++ci) {
                const int c = (dir == 0) ? ci : 31 - ci;
                const size_t off = ((size_t)dir * 1024 + bh * 32 + c) * 16384 + (size_t)e8 * 8;
                v4u o; o.x = pk2(st[0], st[1]); o.y = pk2(st[2], st[3]); o.z = pk2(st[4], st[5]); o.w = pk2(st[6], st[7]);
                *(v4u*)(PREV + off) = o;
                const v4u s = *(const v4u*)(ST + off);
                st[0] = Gc * st[0] + bflo(s.x); st[1] = Gc * st[1] + bfhi(s.x); st[2] = Gc * st[2] + bflo(s.y); st[3] = Gc * st[3] + bfhi(s.y);
                st[4] = Gc * st[4] + bflo(s.z); st[5] = Gc * st[5] + bfhi(s.z); st[6] = Gc * st[6] + bflo(s.w); st[7] = Gc * st[7] + bfhi(s.w);
            }
        }
    }

    GRID_BAR(3);

#if NAIVE_P4
    if constexpr (IN(4)) for (int rep_ = 0; rep_ < REP4; ++rep_) {
        PHASE_COORDS
        const float* gnw = args.in[8];
        for (int ck = bx; ck < NCHUNK; ck += G) {
            const int t0 = ck * 128, bb = ck >> 5, cc = ck & 31;
#pragma unroll 1
            for (int h = 0; h < 4; ++h) {
                const float lgf = log_sigmoid_f(args.in[6][h]), lgb = log_sigmoid_f(args.in[7][h]);
                LAS float* A0 = sm;
                LAS float* A1 = sm + 16384;
                for (int i = tid; i < 16384; i += NTHREADS) {
                    const int l = i >> 7, d = i & 127;
                    A0[i] = bf2f(PROJ[(size_t)(t0 + l) * INW + 1024 + h * 128 + d]);
                    A1[l * 129 + d] = bf2f(PROJ[(size_t)(t0 + l) * INW + 1536 + h * 128 + d]);
                }
                LAS float* qwt = sm + 32896;
                if (tid < 128) { qwt[tid] = expf((float)(tid + 1) * lgf); qwt[128 + tid] = expf((float)(128 - tid) * lgb); qwt[256 + tid] = expf((float)tid * lgf); qwt[384 + tid] = expf((float)tid * lgb); }
                __syncthreads();
                const int c0 = tid & 127, lg4 = tid >> 7;
                float acc[32];
#pragma unroll
                for (int li = 0; li < 32; ++li) acc[li] = 0.f;
#pragma unroll 1
                for (int d = 0; d < 128; ++d) {
                    const float kv = A1[c0 * 129 + d];
#pragma unroll
                    for (int li = 0; li < 32; ++li) acc[li] += A0[(lg4 * 32 + li) * 128 + d] * kv;
                }
                __syncthreads();
#pragma unroll
                for (int li = 0; li < 32; ++li) {
                    const int l = lg4 * 32 + li, m = c0;
                    const float dec = (m <= l) ? qwt[256 + l - m] : qwt[384 + m - l];
                    A0[l * 128 + m] = acc[li] * dec;
                }
                for (int i = tid; i < 16384; i += NTHREADS) {
                    const int l = i >> 7, d = i & 127;
                    A1[l * 129 + d] = bf2f(PROJ[(size_t)(t0 + l) * INW + 2048 + h * 128 + d]);
                }
                __syncthreads();
                float o[32];
#pragma unroll
                for (int li = 0; li < 32; ++li) o[li] = 0.f;
#pragma unroll 1
                for (int m = 0; m < 128; ++m) {
                    const float vv = A1[m * 129 + c0];
#pragma unroll
                    for (int li = 0; li < 32; ++li) o[li] += A0[(lg4 * 32 + li) * 128 + m] * vv;
                }
                __syncthreads();
#pragma unroll 1
                for (int dir = 0; dir < 2; ++dir) {
                    const size_t u0 = ((size_t)dir * 1024 + (bb * 4 + h) * 32 + cc) * 16384;
                    __syncthreads();
                    for (int i = tid; i < 16384; i += NTHREADS) {
                        const int l = i >> 7, d = i & 127;
                        A0[i] = qwt[dir * 128 + l] * bf2f(PROJ[(size_t)(t0 + l) * INW + 1024 + h * 128 + d]);
                        A1[l * 129 + d] = bf2f(PREV[u0 + i]);
                    }
                    __syncthreads();
#pragma unroll 1
                    for (int dk = 0; dk < 128; ++dk) {
                        const float pv = A1[c0 * 129 + dk];
#pragma unroll
                        for (int li = 0; li < 32; ++li) o[li] += A0[(lg4 * 32 + li) * 128 + dk] * pv;
                    }
                }
                __syncthreads();
#pragma unroll
                for (int li = 0; li < 32; ++li) A0[(lg4 * 32 + li) * 128 + c0] = o[li];
                __syncthreads();
                for (int r = wave * 16; r < wave * 16 + 16; ++r) {
                    const float a = A0[r * 128 + lane], b = A0[r * 128 + 64 + lane];
                    const float mean = wave_sum(a + b) * (1.0f / 128.0f);
                    const float da = a - mean, db = b - mean;
                    const float rstd = 1.0f / sqrtf(wave_sum(da * da + db * db) * (1.0f / 128.0f) + GN_EPS);
                    const size_t prow = (size_t)(t0 + r) * INW + 2560 + h * 128;
                    const float ga = bf2f(PROJ[prow + lane]), gb = bf2f(PROJ[prow + 64 + lane]);
                    Y[(size_t)(t0 + r) * D + 512 + h * 128 + lane] = (bf16)f2bf(da * rstd * gnw[h * 128 + lane] * ga);
                    Y[(size_t)(t0 + r) * D + 512 + h * 128 + 64 + lane] = (bf16)f2bf(db * rstd * gnw[h * 128 + 64 + lane] * gb);
                }
                __syncthreads();
            }
        }
    }

#else
    if constexpr (IN(4)) for (int rep_ = 0; rep_ < REP4; ++rep_) {
        PHASE_COORDS
        const float* gnw = args.in[8];
        LAS unsigned char* B0 = lds; LAS unsigned char* B1 = lds + 32768; LAS unsigned char* B2 = lds + 65536; LAS unsigned char* B3 = lds + 98304;
        const int g = lane >> 4, fr = lane & 15;
        for (int ck = bx; ck < NCHUNK; ck += G) {
            const int t0 = ck * 128, bb = ck >> 5, cc = ck & 31;
#pragma unroll 1
            for (int h = 0; h < 4; ++h) {
                const float lf2 = log_sigmoid_f(args.in[6][h]) * 1.4426950408889634f, lb2 = log_sigmoid_f(args.in[7][h]) * 1.4426950408889634f;
                const bf16* prow = PROJ + (size_t)t0 * INW + h * 128;
                stage_tile(B0, prow + 1024, INW, tid);
                stage_tile(B1, prow + 1536, INW, tid);
                __syncthreads();
                bf16x8 qf[4];
#pragma unroll
                for (int s = 0; s < 4; ++s) qf[s] = frag_row(B0, lane, wave, s);
                f32x4 sacc[8];
#pragma unroll
                for (int nt = 0; nt < 8; ++nt) sacc[nt] = (f32x4){0.f, 0.f, 0.f, 0.f};
#pragma unroll
                for (int nt = 0; nt < 8; ++nt)
#pragma unroll
                    for (int s = 0; s < 4; ++s) sacc[nt] = MFMA16(frag_row(B1, lane, nt, s), qf[s], sacc[nt]);
                __syncthreads();
                const size_t u0 = (size_t)((bb * 4 + h) * 32 + cc) * 16384;
                stage_tile(B2, prow + 2048, INW, tid);
                stage_tile(B3, PREV + u0, 128, tid);
                stage_tile(B0, PREV + (size_t)1024 * 16384 + u0, 128, tid);
                const int l = 16 * wave + fr;
#pragma unroll
                for (int nt = 0; nt < 8; ++nt) {
                    const int m0 = 16 * nt + 4 * g;
                    float p[4];
#pragma unroll
                    for (int r = 0; r < 4; ++r) { const int m = m0 + r; p[r] = sacc[nt][r] * exp2f((float)(l - m) * ((m <= l) ? lf2 : -lb2)); }
                    v2u w; w.x = pk2(p[0], p[1]); w.y = pk2(p[2], p[3]);
                    *(LAS v2u*)(B1 + off_b((unsigned)l, (unsigned)(2 * nt + (g >> 1))) + 8 * (g & 1)) = w;
                }
                __syncthreads();
                f32x4 o[8], c2[8];
#pragma unroll
                for (int nt = 0; nt < 8; ++nt) o[nt] = (f32x4){0.f, 0.f, 0.f, 0.f};
#pragma unroll
                for (int s = 0; s < 4; ++s) {
                    const bf16x8 pf = frag_row(B1, lane, wave, s);
#pragma unroll
                    for (int nt = 0; nt < 8; ++nt) o[nt] = MFMA16(frag_tr(B2, lane, nt, s), pf, o[nt]);
                }
#pragma unroll
                for (int dir = 0; dir < 2; ++dir) {
                    const LAS unsigned char* PT = dir ? B0 : B3;
#pragma unroll
                    for (int nt = 0; nt < 8; ++nt) c2[nt] = (f32x4){0.f, 0.f, 0.f, 0.f};
#pragma unroll
                    for (int nt = 0; nt < 8; ++nt)
#pragma unroll
                        for (int s = 0; s < 4; ++s) c2[nt] = MFMA16(frag_row(PT, lane, nt, s), qf[s], c2[nt]);
                    const float qw = dir ? exp2f((float)(128 - l) * lb2) : exp2f((float)(l + 1) * lf2);
#pragma unroll
                    for (int nt = 0; nt < 8; ++nt) o[nt] = o[nt] + c2[nt] * qw;
                }
                float sum = 0.f;
#pragma unroll
                for (int nt = 0; nt < 8; ++nt) sum += (o[nt][0] + o[nt][1]) + (o[nt][2] + o[nt][3]);
                sum += __shfl_xor(sum, 16); sum += __shfl_xor(sum, 32);
                const float mean = sum * (1.0f / 128.0f);
                float sq = 0.f;
#pragma unroll
                for (int nt = 0; nt < 8; ++nt) { o[nt] = o[nt] - mean; sq += (o[nt][0] * o[nt][0] + o[nt][1] * o[nt][1]) + (o[nt][2] * o[nt][2] + o[nt][3] * o[nt][3]); }
                sq += __shfl_xor(sq, 16); sq += __shfl_xor(sq, 32);
                const float rstd = 1.0f / sqrtf(sq * (1.0f / 128.0f) + GN_EPS);
                const bf16* grow = PROJ + (size_t)(t0 + l) * INW + 2560 + h * 128;
                bf16* yrow = Y + (size_t)(t0 + l) * D + 512 + h * 128;
#pragma unroll
                for (int nt = 0; nt < 8; ++nt) {
                    const int dv0 = 16 * nt + 4 * g;
                    const v2u gt2 = *(const v2u*)(grow + dv0);
                    const f32x4 gn = *(const f32x4*)(gnw + h * 128 + dv0);
                    v2u w; w.x = pk2(o[nt][0] * rstd * gn[0] * bflo(gt2.x), o[nt][1] * rstd * gn[1] * bfhi(gt2.x));
                    w.y = pk2(o[nt][2] * rstd * gn[2] * bflo(gt2.y), o[nt][3] * rstd * gn[3] * bfhi(gt2.y));
                    *(v2u*)(yrow + dv0) = w;
                }
                __syncthreads();
            }
        }
    }

#endif
    GRID_BAR(4);

    if constexpr (IN(5)) for (int rep_ = 0; rep_ < REP5; ++rep_) {
        PHASE_COORDS
        pg8::Gemm g{Y, WOUT, M, D, D}; pg8::StaticOrder S; S.init(M, D, G, bx);
        pg8::EpiResF32 E{x, Z, D, ALPHA};
        pg8::gemm_phase<pg8::EpiResF32, pg8::StaticOrder, true, true>(lds, g, S, E);
    }

    GRID_BAR(5);

    if constexpr (IN(6)) for (int rep_ = 0; rep_ < REP6; ++rep_) {
        PHASE_COORDS
        const float* w = args.in[10]; const float* b = args.in[11];
        for (int t = gw; t < M; t += NGW) {
            const f32x4* zr = (const f32x4*)(Z + (size_t)t * D) + lane;
            f32x4 v[4]; float s = 0.f;
#pragma unroll
            for (int j = 0; j < 4; ++j) { v[j] = zr[64 * j]; s += (v[j][0] + v[j][1]) + (v[j][2] + v[j][3]); }
            const float mean = wave_sum(s) * (1.0f / D); float q = 0.f;
#pragma unroll
            for (int j = 0; j < 4; ++j) { v[j] = v[j] - mean; q += (v[j][0] * v[j][0] + v[j][1] * v[j][1]) + (v[j][2] * v[j][2] + v[j][3] * v[j][3]); }
            const float rstd = 1.0f / sqrtf(wave_sum(q) * (1.0f / D) + LN_EPS);
            unsigned long long* o8 = (unsigned long long*)(H + (size_t)t * D) + lane;
#pragma unroll
            for (int j = 0; j < 4; ++j) {
                const f32x4 wv = *((const f32x4*)w + lane + 64 * j), bv = *((const f32x4*)b + lane + 64 * j);
                const f32x4 y = v[j] * rstd * wv + bv;
                o8[64 * j] = (unsigned long long)pk2(y[0], y[1]) | ((unsigned long long)pk2(y[2], y[3]) << 32);
                v[j] = y;
            }
            float mx = 0.f;
#pragma unroll
            for (int j = 0; j < 4; ++j) mx = fmaxf(mx, fmaxf(fmaxf(fabsf(v[j][0]), fabsf(v[j][1])), fmaxf(fabsf(v[j][2]), fabsf(v[j][3]))));
#pragma unroll
            for (int o = 1; o < 64; o <<= 1) mx = fmaxf(mx, __shfl_xor(mx, o));
            const float inv = mx > 0.f ? 127.0f / mx : 0.f;
#pragma unroll
            for (int j = 0; j < 4; ++j) {
                const int q0 = (int)rintf(v[j][0] * inv), q1 = (int)rintf(v[j][1] * inv), q2 = (int)rintf(v[j][2] * inv), q3 = (int)rintf(v[j][3] * inv);
                *(unsigned*)(H8 + ((size_t)(2 * j + (lane >> 5)) * M + t) * 128 + 4 * (lane & 31)) = (unsigned)(q0 & 0xff) | ((unsigned)(q1 & 0xff) << 8) | ((unsigned)(q2 & 0xff) << 16) | ((unsigned)(q3 & 0xff) << 24);
            }
            if (lane == 0) SH[t] = mx * (1.0f / 127.0f);
        }
    }

    GRID_BAR(6);

    if constexpr (IN(7)) for (int rep_ = 0; rep_ < REP7; ++rep_) {
        PHASE_COORDS
        pg8::Gemm g{H, WQ, M, 2048, D}; pg8::StaticOrder S; S.init(M, 2048, G, bx);
        pg8::EpiPlainBf16 E{QP, 2048};
        pg8::gemm_phase<pg8::EpiPlainBf16, pg8::StaticOrder, true, true>(lds, g, S, E);
    }

    GRID_BAR(7);

#if NAIVE_P8
    if constexpr (IN(8)) for (int rep_ = 0; rep_ < REP8; ++rep_) {
        PHASE_COORDS
        const float* keys = args.in[13];
        LAS float* qs = sm;
        LAS float* sc = sm + 64 * 257;
        for (int unit = bx; unit < (M / 64) * PEER_H; unit += G) {
            const int tt0 = (unit >> 3) * 64, hd = unit & 7;
            for (int i = tid; i < 64 * 256; i += NTHREADS) { const int r = i >> 8, c = i & 255; qs[r * 257 + c] = bf2f(QP[(size_t)(tt0 + r) * 2048 + hd * 256 + c]); }
            __syncthreads();
            {
                const int tt = tid & 63, g8 = __builtin_amdgcn_readfirstlane(tid >> 6);
                for (int p = 0; p < 2; ++p) {
                    float acc[16];
#pragma unroll
                    for (int j = 0; j < 16; ++j) acc[j] = 0.f;
                    const float* kp = keys + ((size_t)(hd * 2 + p) * 128 + g8 * 16) * 128;
                    for (int d = 0; d < 128; ++d) {
                        const float qv = qs[tt * 257 + p * 128 + d];
#pragma unroll
                        for (int j = 0; j < 16; ++j) acc[j] += qv * kp[j * 128 + d];
                    }
#pragma unroll
                    for (int j = 0; j < 16; ++j) sc[tt * 257 + p * 128 + g8 * 16 + j] = acc[j];
                }
            }
            __syncthreads();
            LAS float* tops = qs;
            LAS int* topi = (LAS int*)(qs + 2048);
            LAS float* bsc = qs + 4096;
            LAS int* bps = (LAS int*)(qs + 5120);
            if (tid < 128) {
                const int tt = tid & 63, p = tid >> 6;
                LAS float* row = sc + tt * 257 + p * 128;
                for (int r = 0; r < 16; ++r) {
                    float best = -INFINITY; int bi = 0;
                    for (int n = 0; n < 128; ++n) { const float v = row[n]; if (v > best) { best = v; bi = n; } }
                    row[bi] = -INFINITY;
                    tops[(tt * 2 + p) * 16 + r] = best; topi[(tt * 2 + p) * 16 + r] = bi;
                }
            }
            __syncthreads();
            if (tid < 64) {
                const int tt = tid;
                LAS float* cand = sc + tt * 257;
                for (int a = 0; a < 16; ++a) for (int b = 0; b < 16; ++b) cand[a * 16 + b] = tops[(tt * 2) * 16 + a] + tops[(tt * 2 + 1) * 16 + b];
                float mx = -INFINITY;
                for (int r = 0; r < 16; ++r) {
                    float best = -INFINITY; int bi = 0;
                    for (int n = 0; n < 256; ++n) { const float v = cand[n]; if (v > best) { best = v; bi = n; } }
                    cand[bi] = -INFINITY;
                    bsc[tt * 16 + r] = best; bps[tt * 16 + r] = bi;
                    if (r == 0) mx = best;
                }
                float den = 0.f;
                for (int r = 0; r < 16; ++r) den += expf(bsc[tt * 16 + r] - mx);
                const float rden = 1.0f / den;
                for (int r = 0; r < 16; ++r) {
                    const int pos = bps[tt * 16 + r], a = pos >> 4, b = pos & 15;
                    const int e = topi[(tt * 2) * 16 + a] * 128 + topi[(tt * 2 + 1) * 16 + b];
                    IDX[(size_t)(tt0 + tt) * NSEL + hd * 16 + r] = (unsigned short)e;
                    GATE[(size_t)(tt0 + tt) * NSEL + hd * 16 + r] = expf(bsc[tt * 16 + r] - mx) * rden;
                }
            }
            __syncthreads();
        }
    }

#else
    if constexpr (IN(8)) for (int rep_ = 0; rep_ < REP8; ++rep_) {
        PHASE_COORDS
        LAS unsigned char* K0 = lds; LAS unsigned char* K1 = lds + 32768;
        const int g = lane >> 4, fr = lane & 15;
        int cur_hd = -1;
        for (int unit = bx; unit < (M / 128) * PEER_H; unit += G) {
            const int hd = unit & 7, tile = unit >> 3;
            if (hd != cur_hd) {
                __syncthreads();
                stage_tile(K0, SKB + (size_t)(hd * 2 + 0) * 16384, 128, tid);
                stage_tile(K1, SKB + (size_t)(hd * 2 + 1) * 16384, 128, tid);
                __syncthreads();
                cur_hd = hd;
            }
            const int t = tile * 128 + 16 * wave + fr;
            int T[2][16];
#pragma unroll
            for (int p = 0; p < 2; ++p) {
                const LAS unsigned char* KT = p ? K1 : K0;
                bf16x8 qf[4];
#pragma unroll
                for (int s = 0; s < 4; ++s) qf[s] = *(const bf16x8*)(QP + (size_t)t * 2048 + hd * 256 + p * 128 + 32 * s + 8 * g);
                f32x4 acc[8];
#pragma unroll
                for (int nt = 0; nt < 8; ++nt) acc[nt] = (f32x4){0.f, 0.f, 0.f, 0.f};
#pragma unroll
                for (int nt = 0; nt < 8; ++nt)
#pragma unroll
                    for (int s = 0; s < 4; ++s) acc[nt] = MFMA16(frag_row(KT, lane, nt, s), qf[s], acc[nt]);
                int A[16], Bk[16];
#pragma unroll
                for (int nt = 0; nt < 4; ++nt)
#pragma unroll
                    for (int r = 0; r < 4; ++r) { A[nt * 4 + r] = f2key(acc[nt][r], 16 * nt + 4 * g + r); Bk[nt * 4 + r] = f2key(acc[nt + 4][r], 16 * (nt + 4) + 4 * g + r); }
                sort16_desc(A); sort16_desc(Bk);
#pragma unroll
                for (int i = 0; i < 16; ++i) A[i] = max(A[i], Bk[15 - i]);
                merge16_desc(A);
#pragma unroll
                for (int mask = 16; mask <= 32; mask <<= 1) {
                    int P[16];
#pragma unroll
                    for (int i = 0; i < 16; ++i) P[i] = __shfl_xor(A[15 - i], mask);
#pragma unroll
                    for (int i = 0; i < 16; ++i) A[i] = max(A[i], P[i]);
                    merge16_desc(A);
                }
#pragma unroll
                for (int i = 0; i < 16; ++i) T[p][i] = A[i];
            }
            float F0[16], F1[16];
#pragma unroll
            for (int i = 0; i < 16; ++i) { F0[i] = key2f(T[0][i]); F1[i] = key2f(T[1][i]); }
            int C[16];
#pragma unroll
            for (int j = 0; j < 16; ++j) {
                constexpr int a2[16] = {2, 2, 2, 2, 2, 3, 3, 3, 3, 4, 4, 4, 5, 5, 6, 6}, b2[16] = {0, 1, 2, 3, 4, 0, 1, 2, 3, 0, 1, 2, 0, 1, 0, 1};
                const int a1 = (j < 8) ? 1 : j, b1 = (j < 8) ? j : 0;
                const float s0 = F0[0] + F1[j], s1 = F0[a1] + F1[b1], s2 = F0[a2[j]] + F1[b2[j]];
                const int k0 = f2key(s0, j), k1 = f2key(s1, a1 * 16 + b1), k2 = f2key(s2, a2[j] * 16 + b2[j]);
                const int k3 = (j < 2) ? f2key(F0[7] + F1[j], 7 * 16 + j) : (int)0x80000000;
                C[j] = (g == 0) ? k0 : (g == 1) ? k1 : (g == 2) ? k2 : k3;
            }
            sort16_desc(C);
#pragma unroll
            for (int mask = 16; mask <= 32; mask <<= 1) {
                int P[16];
#pragma unroll
                for (int i = 0; i < 16; ++i) P[i] = __shfl_xor(C[15 - i], mask);
#pragma unroll
                for (int i = 0; i < 16; ++i) C[i] = max(C[i], P[i]);
                merge16_desc(C);
            }
            const float mx = key2f(C[0]);
            int kk[4];
#pragma unroll
            for (int k = 0; k < 4; ++k) kk[k] = (g == 0) ? C[k] : (g == 1) ? C[4 + k] : (g == 2) ? C[8 + k] : C[12 + k];
            unsigned pk0[4], pk1[4];
#pragma unroll
            for (int q = 0; q < 4; ++q) {
                pk0[q] = (unsigned)(T[0][4 * q] & 0x7F) | ((unsigned)(T[0][4 * q + 1] & 0x7F) << 8) | ((unsigned)(T[0][4 * q + 2] & 0x7F) << 16) | ((unsigned)(T[0][4 * q + 3] & 0x7F) << 24);
                pk1[q] = (unsigned)(T[1][4 * q] & 0x7F) | ((unsigned)(T[1][4 * q + 1] & 0x7F) << 8) | ((unsigned)(T[1][4 * q + 2] & 0x7F) << 16) | ((unsigned)(T[1][4 * q + 3] & 0x7F) << 24);
            }
            float ev[4]; int ex[4]; float part = 0.f;
#pragma unroll
            for (int k = 0; k < 4; ++k) {
                ev[k] = __expf(key2f(kk[k]) - mx); part += ev[k];
                const int a = (kk[k] >> 4) & 15, b = kk[k] & 15;
                const unsigned w0 = (a >> 2) == 0 ? pk0[0] : (a >> 2) == 1 ? pk0[1] : (a >> 2) == 2 ? pk0[2] : pk0[3];
                const unsigned w1 = (b >> 2) == 0 ? pk1[0] : (b >> 2) == 1 ? pk1[1] : (b >> 2) == 2 ? pk1[2] : pk1[3];
                ex[k] = (int)(((w0 >> (8 * (a & 3))) & 0xFFu) * 128u + ((w1 >> (8 * (b & 3))) & 0xFFu));
            }
            part += __shfl_xor(part, 16); part += __shfl_xor(part, 32);
            const float rden = 1.0f / part;
            *(v2u*)(IDX + (size_t)t * NSEL + hd * 16 + 4 * g) = (v2u){(unsigned)ex[0] | ((unsigned)ex[1] << 16), (unsigned)ex[2] | ((unsigned)ex[3] << 16)};
            *(f32x4*)(GATE + (size_t)t * NSEL + hd * 16 + 4 * g) = (f32x4){ev[0] * rden, ev[1] * rden, ev[2] * rden, ev[3] * rden};
        }
    }

#endif
    GRID_BAR(8);

    if constexpr (IN(9)) for (int rep_ = 0; rep_ < REP9; ++rep_) {
        PHASE_COORDS
        const bool fast = (G & 7) == 0;
        const int nq = fast ? (G >> 3) * NWAVES : NGW, q0 = fast ? (bx >> 3) * NWAVES + wave : gw;
        const long ntask = fast ? (long)M : 8L * M;
        const int c = lane & 7, pg = lane >> 3;
        for (long task = q0; task < ntask; task += nq) {
            const int t = fast ? (int)task : (int)(task >> 3), x = fast ? (bx & 7) : (int)(task & 7);
            const v4u* ip = (const v4u*)(IDX + (size_t)t * NSEL + 16 * pg);
            const v4u e0 = ip[0], e1 = ip[1];
            const unsigned ee[16] = {e0.x & 0xffffu, e0.x >> 16, e0.y & 0xffffu, e0.y >> 16, e0.z & 0xffffu, e0.z >> 16, e0.w & 0xffffu, e0.w >> 16,
                                     e1.x & 0xffffu, e1.x >> 16, e1.y & 0xffffu, e1.y >> 16, e1.z & 0xffffu, e1.z >> 16, e1.w & 0xffffu, e1.w >> 16};
            const v4u hq = *(const v4u*)(H8 + ((size_t)x * M + t) * 128 + 16 * c);
            const unsigned char* ub = U8 + (size_t)x * NEXP * 128 + 16 * c;
            v4u rows[16];
#pragma unroll
            for (int i = 0; i < 16; ++i) rows[i] = *(const v4u*)(ub + (size_t)ee[i] * 128);
            int acc[16];
#pragma unroll
            for (int i = 0; i < 16; ++i) {
                int a = __builtin_amdgcn_sdot4((int)rows[i].x, (int)hq.x, 0, false);
                a = __builtin_amdgcn_sdot4((int)rows[i].y, (int)hq.y, a, false);
                a = __builtin_amdgcn_sdot4((int)rows[i].z, (int)hq.z, a, false);
                a = __builtin_amdgcn_sdot4((int)rows[i].w, (int)hq.w, a, false);
                a += __shfl_xor(a, 1); a += __shfl_xor(a, 2); a += __shfl_xor(a, 4);
                acc[i] = a;
            }
            if (c == 0) {
                v4u* op = (v4u*)(PDOT + ((size_t)x * M + t) * NSEL + 16 * pg);
                op[0] = (v4u){(unsigned)acc[0], (unsigned)acc[1], (unsigned)acc[2], (unsigned)acc[3]};
                op[1] = (v4u){(unsigned)acc[4], (unsigned)acc[5], (unsigned)acc[6], (unsigned)acc[7]};
                op[2] = (v4u){(unsigned)acc[8], (unsigned)acc[9], (unsigned)acc[10], (unsigned)acc[11]};
                op[3] = (v4u){(unsigned)acc[12], (unsigned)acc[13], (unsigned)acc[14], (unsigned)acc[15]};
            }
        }
    }
    GRID_BAR(9);

    if constexpr (IN(10)) for (int rep_ = 0; rep_ < REP10; ++rep_) {
        PHASE_COORDS
        for (int t = gw; t < M; t += NGW) {
            const float sh = SH[t];
            float cp[2]; float mx = 0.f;
#pragma unroll
            for (int k = 0; k < 2; ++k) {
                const int j = 2 * lane + k;
                const int e = (int)IDX[(size_t)t * NSEL + j];
                int sacc = 0;
#pragma unroll
                for (int x = 0; x < 8; ++x) sacc += PDOT[((size_t)x * M + t) * NSEL + j];
                const float dot = SU[e] * sh * (float)sacc;
                cp[k] = GATE[(size_t)t * NSEL + j] * gelu_exact(dot) * SV[e];
                mx = fmaxf(mx, fabsf(cp[k]));
            }
#pragma unroll
            for (int o = 1; o < 64; o <<= 1) mx = fmaxf(mx, __shfl_xor(mx, o));
            const float inv = mx > 0.f ? 32767.0f / mx : 0.f;
            const int q0 = (int)rintf(cp[0] * inv), q1 = (int)rintf(cp[1] * inv);
            *(unsigned*)(CQ + (size_t)t * NSEL + 2 * lane) = ((unsigned)q0 & 0xffffu) | ((unsigned)q1 << 16);
            int qs = q0 + q1;
#pragma unroll
            for (int o = 1; o < 64; o <<= 1) qs += __shfl_xor(qs, o);
            if (lane == 0) { CS[2 * t] = mx * (1.0f / 32767.0f); CS[2 * t + 1] = (float)qs; }
        }
    }
    GRID_BAR(10);

    if constexpr (IN(11)) for (int rep_ = 0; rep_ < REP11; ++rep_) {
        PHASE_COORDS
        const bool fast = (G & 7) == 0;
        const int nq = fast ? (G >> 3) * NWAVES : NGW, q0 = fast ? (bx >> 3) * NWAVES + wave : gw;
        const long ntask = fast ? (long)M : 8L * M;
        const int c = lane & 7, pg = lane >> 3;
        const int d0 = 8 * ((lane >> 5) & 1) + 4 * ((lane >> 4) & 1) + 2 * ((lane >> 3) & 1);
        typedef short s16x2 __attribute__((ext_vector_type(2)));
        typedef float f32x2 __attribute__((ext_vector_type(2)));
        for (long task = q0; task < ntask; task += nq) {
            const int t = fast ? (int)task : (int)(task >> 3), x = fast ? (bx & 7) : (int)(task & 7);
            const v4u* ip = (const v4u*)(IDX + (size_t)t * NSEL + 16 * pg);
            const v4u e0 = ip[0], e1 = ip[1];
            const unsigned ee[16] = {e0.x & 0xffffu, e0.x >> 16, e0.y & 0xffffu, e0.y >> 16, e0.z & 0xffffu, e0.z >> 16, e0.w & 0xffffu, e0.w >> 16,
                                     e1.x & 0xffffu, e1.x >> 16, e1.y & 0xffffu, e1.y >> 16, e1.z & 0xffffu, e1.z >> 16, e1.w & 0xffffu, e1.w >> 16};
            const v4u* qp = (const v4u*)(CQ + (size_t)t * NSEL + 16 * pg);
            const v4u cq0 = qp[0], cq1 = qp[1];
            const unsigned cqp[8] = {cq0.x, cq0.y, cq0.z, cq0.w, cq1.x, cq1.y, cq1.z, cq1.w};
            const f32x2 cs2 = *(const f32x2*)(CS + 2 * (size_t)t);
            const int col = 128 * x + 16 * c + d0;
            const unsigned hw = *(const unsigned*)(H + (size_t)t * D + col);
            const unsigned char* vb = V8 + (size_t)x * NEXP * 128 + 16 * c;
            v4u rows[16];
#pragma unroll
            for (int i = 0; i < 16; ++i) rows[i] = *(const v4u*)(vb + (size_t)ee[i] * 128);
            int acc[16];
#pragma unroll
            for (int d = 0; d < 16; ++d) acc[d] = 0;
#pragma unroll
            for (int i = 0; i < 16; i += 2) {
                const unsigned ra[4] = {rows[i].x, rows[i].y, rows[i].z, rows[i].w}, rb[4] = {rows[i + 1].x, rows[i + 1].y, rows[i + 1].z, rows[i + 1].w};
                const s16x2 cpair = __builtin_bit_cast(s16x2, cqp[i >> 1]);
#pragma unroll
                for (int k = 0; k < 4; ++k) {
                    acc[4 * k + 0] = __builtin_amdgcn_sdot2(__builtin_bit_cast(s16x2, __builtin_amdgcn_perm(rb[k], ra[k], 0x0C040C00u)), cpair, acc[4 * k + 0], false);
                    acc[4 * k + 1] = __builtin_amdgcn_sdot2(__builtin_bit_cast(s16x2, __builtin_amdgcn_perm(rb[k], ra[k], 0x0C050C01u)), cpair, acc[4 * k + 1], false);
                    acc[4 * k + 2] = __builtin_amdgcn_sdot2(__builtin_bit_cast(s16x2, __builtin_amdgcn_perm(rb[k], ra[k], 0x0C060C02u)), cpair, acc[4 * k + 2], false);
                    acc[4 * k + 3] = __builtin_amdgcn_sdot2(__builtin_bit_cast(s16x2, __builtin_amdgcn_perm(rb[k], ra[k], 0x0C070C03u)), cpair, acc[4 * k + 3], false);
                }
            }
            int r8[8], r4[4], r2[2];
            {
                const bool hi = (lane & 32) != 0;
#pragma unroll
                for (int k = 0; k < 8; ++k) { const int keep = hi ? acc[8 + k] : acc[k], send = hi ? acc[k] : acc[8 + k]; r8[k] = keep + __shfl_xor(send, 32); }
            }
            {
                const bool hi = (lane & 16) != 0;
#pragma unroll
                for (int k = 0; k < 4; ++k) { const int keep = hi ? r8[4 + k] : r8[k], send = hi ? r8[k] : r8[4 + k]; r4[k] = keep + __shfl_xor(send, 16); }
            }
            {
                const bool hi = (lane & 8) != 0;
#pragma unroll
                for (int k = 0; k < 2; ++k) { const int keep = hi ? r4[2 + k] : r4[k], send = hi ? r4[k] : r4[2 + k]; r2[k] = keep + __shfl_xor(send, 8); }
            }
            const float off = 128.0f * cs2[1];
            *(f32x2*)(args.out + (size_t)t * D + col) = (f32x2){ALPHA * bflo(hw) + cs2[0] * ((float)r2[0] - off), ALPHA * bfhi(hw) + cs2[0] * ((float)r2[1] - off)};
        }
    }
    GRID_BAR(11);

    if constexpr (IN(12)) for (int rep_ = 0; rep_ < REP12; ++rep_) {
        PHASE_COORDS
        const float* w = args.in[16]; const float* b = args.in[17];
        for (int t = gw; t < M; t += NGW) {
            f32x4* zr = (f32x4*)(args.out + (size_t)t * D) + lane;
            f32x4 v[4]; float s = 0.f;
#pragma unroll
            for (int j = 0; j < 4; ++j) { v[j] = zr[64 * j]; s += (v[j][0] + v[j][1]) + (v[j][2] + v[j][3]); }
            const float mean = wave_sum(s) * (1.0f / D); float q = 0.f;
#pragma unroll
            for (int j = 0; j < 4; ++j) { v[j] = v[j] - mean; q += (v[j][0] * v[j][0] + v[j][1] * v[j][1]) + (v[j][2] * v[j][2] + v[j][3] * v[j][3]); }
            const float rstd = 1.0f / sqrtf(wave_sum(q) * (1.0f / D) + LN_EPS);
#pragma unroll
            for (int j = 0; j < 4; ++j) {
                const f32x4 wv = *((const f32x4*)w + lane + 64 * j), bv = *((const f32x4*)b + lane + 64 * j);
                zr[64 * j] = v[j] * rstd * wv + bv;
            }
        }
    }
#undef IN
#undef BOTH
#undef GRID_BAR
}

extern "C" void kernel_launch(void* const* d_in, const int* in_sizes, int n_in, void* d_out, int out_size, void* d_ws, size_t ws_size, hipStream_t stream) {
    static int grid = 0;
    if (grid == 0) {
        if (n_in != 18 || in_sizes[0] != M * D || out_size != M * D || ws_size < WS_END) {
            fprintf(stderr, "kernel_launch: unexpected shapes: n_in %d in0 %d out %d ws %zu\n", n_in, n_in > 0 ? in_sizes[0] : -1, out_size, ws_size); grid = -1; return; }
        int dev = 0, cus = 0;
        if (hipGetDevice(&dev) != hipSuccess || hipDeviceGetAttribute(&cus, hipDeviceAttributeMultiprocessorCount, dev) != hipSuccess) { grid = -1; return; }
        bool ok = true;
#if N_LAUNCHES == 1
        ok = (hipFuncSetAttribute((const void*)fwd_kernel<0, 13>, hipFuncAttributeMaxDynamicSharedMemorySize, LDS_BYTES) == hipSuccess);
#else
#define SETATTR(k) ok = ok && (hipFuncSetAttribute((const void*)fwd_kernel<k, k + 1>, hipFuncAttributeMaxDynamicSharedMemorySize, LDS_BYTES) == hipSuccess)
        SETATTR(0); SETATTR(1); SETATTR(2); SETATTR(3); SETATTR(4); SETATTR(5); SETATTR(6); SETATTR(7); SETATTR(8); SETATTR(9); SETATTR(10); SETATTR(11); SETATTR(12);
#undef SETATTR
#endif
        if (!ok) { fprintf(stderr, "kernel_launch: hipFuncSetAttribute failed\n"); grid = -1; return; }
        grid = cus;
    }
    if (grid < 0) return;
    (void)hipMemsetAsync((char*)d_ws + WS_CTL, 0, CTL_ZERO_BYTES, stream);
    Args a{};
    for (int i = 0; i < 18; ++i) a.in[i] = (const float*)d_in[i];
    a.out = (float*)d_out; a.ws = (unsigned char*)d_ws;
    a.ph_lo = 0; a.ph_hi = 10;
#if N_LAUNCHES == 1
    hipLaunchKernelGGL((fwd_kernel<0, 13>), dim3(grid), dim3(NTHREADS), LDS_BYTES, stream, a);
#else
#define LAUNCH(k) hipLaunchKernelGGL((fwd_kernel<k, k + 1>), dim3(grid), dim3(NTHREADS), LDS_BYTES, stream, a)
    LAUNCH(0); LAUNCH(1); LAUNCH(2); LAUNCH(3); LAUNCH(4); LAUNCH(5); LAUNCH(6); LAUNCH(7); LAUNCH(8); LAUNCH(9); LAUNCH(10); LAUNCH(11); LAUNCH(12);
#undef LAUNCH
#endif
}
```

```cpp
#include <hip/hip_runtime.h>
#include <cstdio>
#include <cstdint>
#include <cmath>
namespace pg8 {
#define PG8_LAS __attribute__((address_space(3)))
typedef unsigned short bf16_t;
typedef short bf16x8 __attribute__((ext_vector_type(8)));
typedef float f32x4 __attribute__((ext_vector_type(4)));
typedef unsigned u32x4 __attribute__((ext_vector_type(4)));
constexpr int BM = 256, BK = 64, HALF = 128, HTB = HALF * BK * 2  , STAGE_BYTES = 8 * HTB, NXCD = 8, WGM = 8;

__host__ __device__ __forceinline__ int lds_byte(int r, int c) { const int st = (r >> 4) * 2 + (c >> 5), rr = r & 15, cc = c & 31, ob = rr * 64 + cc * 2; return st * 1024 + (ob ^ (((ob >> 9) & 1) << 5)); }
__host__ __device__ __forceinline__ void stage_rc(int b, int& R, int& C) { const int st = b / 1024, sb = b % 1024, swz = sb ^ (((sb >> 9) & 1) << 5); R = (st >> 1) * 16 + swz / 64; C = (st & 1) * 32 + (swz % 64) / 2; }
__host__ __device__ __forceinline__ int perm32(int rho) { const int n = rho >> 4, i = rho & 15; return 8 * (i >> 2) + 4 * n + (i & 3); }

struct Unit { int pm, pn; };
struct Gemm { const bf16_t* A; const bf16_t* Bt; int M, N, K; };

struct StaticOrder {
    int nM, nN, nwg, G, c;
    __host__ __device__ void init(int M, int N, int G_, int c_) { nM = M / BM; nN = N / BM; nwg = nM * nN; G = G_; c = c_; }
    __host__ __device__ bool next(int i, Unit& u) const {
        const long L = (long)i * G + c; if (L >= nwg) return false;
        int wgid = (int)L; { const int q = nwg / NXCD, r = nwg % NXCD, xcd = wgid % NXCD, off = wgid / NXCD; wgid = (xcd < r ? xcd * (q + 1) : r * (q + 1) + (xcd - r) * q) + off; }
        const int nig = WGM * nN, gid = wgid / nig, fm = gid * WGM, gsz = (nM - fm) < WGM ? (nM - fm) : WGM;
        u.pm = fm + ((wgid % nig) % gsz); u.pn = (wgid % nig) / gsz; return true;
    }
    __device__ __forceinline__ void a_ready(const Unit&) const {}
    __device__ __forceinline__ void done(const Unit&) const {}
};

__device__ __forceinline__ unsigned cvt_pk_bf16(float lo, float hi) { unsigned r; asm volatile("v_cvt_pk_bf16_f32 %0, %1, %2" : "=v"(r) : "v"(lo), "v"(hi)); return r; }
typedef float f32x2 __attribute__((ext_vector_type(2)));
__device__ __forceinline__ f32x2 gelu_pk(f32x2 v) {
    const f32x2 av = __builtin_elementwise_abs(v), d = av * 0.2316418882f + 1.0f;
    f32x2 t; t.x = __builtin_amdgcn_rcpf(d.x); t.y = __builtin_amdgcn_rcpf(d.y);
    f32x2 q = t * 0.5307027145f + (-0.7265760135f); q = q * t + 0.7107068705f; q = q * t + (-0.142248368f); q = q * t + 0.127414796f; q = q * t;
    const f32x2 s = (v * v) * (-0.72134752044f);
    f32x2 e; e.x = __builtin_amdgcn_exp2f(s.x); e.y = __builtin_amdgcn_exp2f(s.y);
    const f32x2 m = v * (q * e), r = v - m;
    f32x2 o; o.x = v.x < 0.f ? m.x : r.x; o.y = v.y < 0.f ? m.y : r.y; return o;
}

__device__ __forceinline__ float silu_f(float v) { return v * __builtin_amdgcn_rcpf(1.0f + __expf(-v)); }
struct EpiProj {
    static constexpr bool PERM = true, AFTER_DRAIN = false;
    bf16_t* O; const float* rope;
    __device__ __forceinline__ void operator()(const f32x4 (&acc)[2][2][4][2], const Unit& u, int wr, int wc, int fr, int fq) const {
        const int sec = u.pn >> 1;
        const int row0 = u.pm * BM + wr * 64 + fr, col0 = u.pn * BM + wc * 32 + 8 * fq;
        const int i0 = wc * 16 + 4 * fq;
#pragma unroll
        for (int ai = 0; ai < 2; ++ai)
#pragma unroll
            for (int m = 0; m < 4; ++m) {
                const int row = row0 + ai * HALF + m * 16;
                bf16_t* rowp = O + (size_t)row * 3072 + col0;
                f32x4 r0 = (f32x4){1.f, 0.f, 1.f, 0.f}, r1 = r0;
                if (sec == 2 || sec == 3) { const f32x4* rp = (const f32x4*)(rope + ((size_t)(row & 4095) * 64 + i0) * 2); r0 = rp[0]; r1 = rp[1]; }
#pragma unroll
                for (int bj = 0; bj < 2; ++bj) {
                    f32x4 v0 = acc[ai][bj][m][0], v1 = acc[ai][bj][m][1];
                    if (sec <= 1) {
                        f32x2 a = gelu_pk((f32x2){v0[0], v0[1]}), b = gelu_pk((f32x2){v0[2], v0[3]}), c = gelu_pk((f32x2){v1[0], v1[1]}), d = gelu_pk((f32x2){v1[2], v1[3]});
                        v0 = (f32x4){a.x, a.y, b.x, b.y}; v1 = (f32x4){c.x, c.y, d.x, d.y};
                    } else if (sec <= 3) {
                        const float sc = (sec == 3) ? 0.08838834764831845f : 1.0f;
                        f32x4 w0, w1;
                        w0[0] = (v0[0] * r0[0] - v0[1] * r0[1]) * sc; w0[1] = (v0[0] * r0[1] + v0[1] * r0[0]) * sc;
                        w0[2] = (v0[2] * r0[2] - v0[3] * r0[3]) * sc; w0[3] = (v0[2] * r0[3] + v0[3] * r0[2]) * sc;
                        w1[0] = (v1[0] * r1[0] - v1[1] * r1[1]) * sc; w1[1] = (v1[0] * r1[1] + v1[1] * r1[0]) * sc;
                        w1[2] = (v1[2] * r1[2] - v1[3] * r1[3]) * sc; w1[3] = (v1[2] * r1[3] + v1[3] * r1[2]) * sc;
                        v0 = w0; v1 = w1;
                    } else if (sec == 5) {
#pragma unroll
                        for (int j = 0; j < 4; ++j) { v0[j] = silu_f(v0[j]); v1[j] = silu_f(v1[j]); }
                    }
                    u32x4 w; w.x = cvt_pk_bf16(v0[0], v0[1]); w.y = cvt_pk_bf16(v0[2], v0[3]); w.z = cvt_pk_bf16(v1[0], v1[1]); w.w = cvt_pk_bf16(v1[2], v1[3]);
                    *(u32x4*)(rowp + bj * HALF) = w;
                }
            }
    }
};
struct EpiPlainBf16 {
    static constexpr bool PERM = true, AFTER_DRAIN = false;
    bf16_t* O; int ldc;
    __device__ __forceinline__ void operator()(const f32x4 (&acc)[2][2][4][2], const Unit& u, int wr, int wc, int fr, int fq) const {
        const int row0 = u.pm * BM + wr * 64 + fr, col0 = u.pn * BM + wc * 32 + 8 * fq;
#pragma unroll
        for (int ai = 0; ai < 2; ++ai)
#pragma unroll
            for (int m = 0; m < 4; ++m) { bf16_t* rowp = O + (size_t)(row0 + ai * HALF + m * 16) * ldc + col0;
#pragma unroll
                for (int bj = 0; bj < 2; ++bj) { const f32x4 v0 = acc[ai][bj][m][0], v1 = acc[ai][bj][m][1];
                    u32x4 w; w.x = cvt_pk_bf16(v0[0], v0[1]); w.y = cvt_pk_bf16(v0[2], v0[3]); w.z = cvt_pk_bf16(v1[0], v1[1]); w.w = cvt_pk_bf16(v1[2], v1[3]);
                    *(u32x4*)(rowp + bj * HALF) = w; } }
    }
};
struct EpiResF32 {
    static constexpr bool PERM = false, AFTER_DRAIN = false;
    const float* X; float* Z; int ldc; float alpha;
    __device__ __forceinline__ void operator()(const f32x4 (&acc)[2][2][4][2], const Unit& u, int wr, int wc, int fr, int fq) const {
        const int row0 = u.pm * BM + wr * 64 + fr, col0 = u.pn * BM + wc * 32 + 4 * fq;
#pragma unroll
        for (int ai = 0; ai < 2; ++ai)
#pragma unroll
            for (int m = 0; m < 4; ++m) { const size_t off = (size_t)(row0 + ai * HALF + m * 16) * ldc + col0;
#pragma unroll
                for (int bj = 0; bj < 2; ++bj)
#pragma unroll
                    for (int n = 0; n < 2; ++n) { const f32x4 xv = *(const f32x4*)(X + off + bj * HALF + n * 16); *(f32x4*)(Z + off + bj * HALF + n * 16) = acc[ai][bj][m][n] + xv * alpha; } }
    }
};
template <class Epi, class Sched, bool ALIGN_EPI = false, bool SP2 = false>
__device__ __forceinline__ void gemm_phase(PG8_LAS unsigned char* lds, const Gemm g, const Sched& S, const Epi& E) {
    int tid_ = threadIdx.x; asm volatile("" : "+v"(tid_));
    const int tid = tid_, wid = __builtin_amdgcn_readfirstlane(tid >> 6), lane = tid & 63, wr = wid >> 2, wc = wid & 3, fr = lane & 15, fq = lane >> 4;
    const int K = g.K, nt = K / BK;
    unsigned voffA[2], voffB[2];
#pragma unroll
    for (int i = 0; i < 2; ++i) { int R, C; stage_rc(tid * 16 + i * 8192, R, C); const int Rb = Epi::PERM ? ((R & ~31) + perm32(R & 31)) : R;
        voffA[i] = (unsigned)(R * K + C) * 2u; voffB[i] = (unsigned)(Rb * K + C) * 2u; }
    const size_t kstep = (size_t)(BK * 2);
    const size_t hstep = (size_t)HALF * K * 2;
    const size_t tstep = 2 * hstep;
    const unsigned ldsw = (unsigned)wid * 1024u;
    const int aoff = lds_byte(wr * 64 + fr, fq * 8), boff = lds_byte(wc * 32 + fr, fq * 8);
#define PG8_SA(b, h) (((b) * 2 + (h)) * HTB)
#define PG8_SB(b, h) ((4 + (b) * 2 + (h)) * HTB)
#define PG8_STAGE(bufoff, gbase, voff) do { _Pragma("unroll") for (int _i = 0; _i < 2; ++_i) \
        __builtin_amdgcn_global_load_lds((const unsigned*)((const char*)(gbase) + (voff)[_i]), (PG8_LAS unsigned*)(lds + (bufoff) + ldsw + _i * 8192), 16, 0, 0); } while (0)
#define PG8_LDA(dst, b, h) do { _Pragma("unroll") for (int m = 0; m < 4; ++m) _Pragma("unroll") for (int k = 0; k < 2; ++k) dst[m][k] = *(const PG8_LAS bf16x8*)(lds + PG8_SA(b, h) + aoff + m * 2048 + k * 1024); } while (0)
#define PG8_LDB(dst, b, h) do { _Pragma("unroll") for (int n = 0; n < 2; ++n) _Pragma("unroll") for (int k = 0; k < 2; ++k) dst[n][k] = *(const PG8_LAS bf16x8*)(lds + PG8_SB(b, h) + boff + n * 2048 + k * 1024); } while (0)
#define PG8_MMA(ai, bj, At, Bt) do { __builtin_amdgcn_s_setprio(1); _Pragma("unroll") for (int m = 0; m < 4; ++m) _Pragma("unroll") for (int n = 0; n < 2; ++n) _Pragma("unroll") for (int k = 0; k < 2; ++k) \
        acc[ai][bj][m][n] = __builtin_amdgcn_mfma_f32_16x16x32_bf16(Bt[n][k], At[m][k], acc[ai][bj][m][n], 0, 0, 0); __builtin_amdgcn_s_setprio(0); } while (0)
#define PG8_WAIT_V(n) asm volatile("s_waitcnt vmcnt(" #n ")" ::: "memory")
#define PG8_WAIT_L(n) asm volatile("s_waitcnt lgkmcnt(" #n ")" ::: "memory")
#define PG8_BAR __builtin_amdgcn_s_barrier()
#define PG8_SCHED __builtin_amdgcn_sched_barrier(0)
    Unit cur, nxt; int ui = 0;
    if (!S.next(0, cur)) return;
    f32x4 acc[2][2][4][2];
#pragma unroll
    for (int a = 0; a < 2; ++a)
#pragma unroll
        for (int b = 0; b < 2; ++b)
#pragma unroll
            for (int m = 0; m < 4; ++m)
#pragma unroll
                for (int n = 0; n < 2; ++n) acc[a][b][m][n] = (f32x4){0.f, 0.f, 0.f, 0.f};
    bf16x8 At[4][2], B0[2][2], B1[2][2];
    const char* cA = (const char*)g.A + (size_t)cur.pm * tstep; const char* cB = (const char*)g.Bt + (size_t)cur.pn * tstep;
    S.a_ready(cur);
    if constexpr (SP2) {
        PG8_STAGE(PG8_SB(0, 0), cB, voffB); PG8_STAGE(PG8_SB(0, 1), cB + hstep, voffB); PG8_STAGE(PG8_SA(0, 0), cA, voffA); PG8_STAGE(PG8_SA(0, 1), cA + hstep, voffA);
        if (wr == 1) PG8_BAR;
        PG8_WAIT_V(2); PG8_BAR;
        PG8_STAGE(PG8_SB(1, 0), cB + kstep, voffB); PG8_STAGE(PG8_SA(1, 0), cA + kstep, voffA); PG8_STAGE(PG8_SB(1, 1), cB + hstep + kstep, voffB);
        PG8_WAIT_V(6); PG8_BAR;
    } else {
        PG8_STAGE(PG8_SB(0, 0), cB, voffB); PG8_STAGE(PG8_SA(0, 0), cA, voffA); PG8_STAGE(PG8_SB(0, 1), cB + hstep, voffB); PG8_STAGE(PG8_SA(0, 1), cA + hstep, voffA);
        if (wr == 1) PG8_BAR;
        PG8_WAIT_V(4); PG8_BAR;
        PG8_STAGE(PG8_SB(1, 0), cB + kstep, voffB); PG8_STAGE(PG8_SA(1, 0), cA + kstep, voffA); PG8_STAGE(PG8_SB(1, 1), cB + hstep + kstep, voffB);
        PG8_WAIT_V(6); PG8_BAR;
    }
    for (;;) {
        const bool has_next = S.next(ui + 1, nxt);
        const char* nA = has_next ? (const char*)g.A + (size_t)nxt.pm * tstep : cA; const char* nB = has_next ? (const char*)g.Bt + (size_t)nxt.pn * tstep : cB;
        for (int t = 0; t < nt; t += 2) {
            const bool last = (t == nt - 2);
            const char* a1 = cA + (size_t)(t + 1) * kstep;
            const char* a2 = last ? nA : cA + (size_t)(t + 2) * kstep; const char* b2 = last ? nB : cB + (size_t)(t + 2) * kstep;
            const char* a3 = a2 + kstep; const char* b3 = b2 + kstep;
            if (last && has_next) S.a_ready(nxt);
            if constexpr (SP2) {
            PG8_LDB(B0, 0, 0); PG8_LDB(B1, 0, 1); PG8_SCHED; PG8_LDA(At, 0, 0); PG8_STAGE(PG8_SA(1, 1), a1 + hstep, voffA);
            PG8_WAIT_V(8); PG8_WAIT_L(0); PG8_BAR; PG8_MMA(0, 0, At, B0); PG8_MMA(0, 1, At, B1); PG8_BAR; PG8_SCHED;
            PG8_LDA(At, 0, 1); PG8_STAGE(PG8_SB(0, 0), b2, voffB); PG8_STAGE(PG8_SB(0, 1), b2 + hstep, voffB); PG8_STAGE(PG8_SA(0, 0), a2, voffA);
            PG8_WAIT_V(8); PG8_WAIT_L(0); PG8_BAR; PG8_MMA(1, 0, At, B0); PG8_MMA(1, 1, At, B1); PG8_BAR; PG8_SCHED;
            PG8_LDB(B0, 1, 0); PG8_LDB(B1, 1, 1); PG8_SCHED; PG8_LDA(At, 1, 0); PG8_STAGE(PG8_SA(0, 1), a2 + hstep, voffA);
            PG8_WAIT_V(8); PG8_WAIT_L(0); PG8_BAR; PG8_MMA(0, 0, At, B0); PG8_MMA(0, 1, At, B1); PG8_BAR; PG8_SCHED;
            PG8_LDA(At, 1, 1); PG8_STAGE(PG8_SB(1, 0), b3, voffB); PG8_STAGE(PG8_SB(1, 1), b3 + hstep, voffB); PG8_STAGE(PG8_SA(1, 0), a3, voffA);
            PG8_WAIT_V(8); PG8_WAIT_L(0); PG8_BAR; PG8_MMA(1, 0, At, B0); PG8_MMA(1, 1, At, B1); PG8_BAR; PG8_SCHED;
            } else {
            PG8_LDB(B0, 0, 0); PG8_SCHED; PG8_LDA(At, 0, 0); PG8_STAGE(PG8_SA(1, 1), a1 + hstep, voffA);
            PG8_WAIT_L(8); PG8_BAR; PG8_WAIT_L(0); PG8_MMA(0, 0, At, B0); PG8_BAR; PG8_SCHED;
            PG8_LDB(B1, 0, 1); PG8_STAGE(PG8_SB(0, 0), b2, voffB);
            PG8_BAR; PG8_WAIT_L(0); PG8_MMA(0, 1, At, B1); PG8_BAR;
            PG8_LDA(At, 0, 1); PG8_STAGE(PG8_SA(0, 0), a2, voffA);
            PG8_BAR; PG8_WAIT_L(0); PG8_MMA(1, 0, At, B0); PG8_BAR; PG8_SCHED;
            PG8_STAGE(PG8_SB(0, 1), b2 + hstep, voffB);
            PG8_WAIT_V(6); PG8_BAR; PG8_MMA(1, 1, At, B1); PG8_BAR;
            PG8_LDB(B0, 1, 0); PG8_SCHED; PG8_LDA(At, 1, 0); PG8_STAGE(PG8_SA(0, 1), a2 + hstep, voffA);
            PG8_WAIT_L(8); PG8_BAR; PG8_WAIT_L(0); PG8_MMA(0, 0, At, B0); PG8_BAR; PG8_SCHED;
            PG8_LDB(B1, 1, 1); PG8_STAGE(PG8_SB(1, 0), b3, voffB);
            PG8_BAR; PG8_WAIT_L(0); PG8_MMA(0, 1, At, B1); PG8_BAR;
            PG8_LDA(At, 1, 1); PG8_STAGE(PG8_SA(1, 0), a3, voffA);
            PG8_BAR; PG8_WAIT_L(0); PG8_MMA(1, 0, At, B0); PG8_BAR; PG8_SCHED;
            PG8_STAGE(PG8_SB(1, 1), b3 + hstep, voffB);
            PG8_WAIT_V(6); PG8_BAR; PG8_MMA(1, 1, At, B1); PG8_BAR;
            }
        }
        if constexpr (ALIGN_EPI) { if (wr == 0) PG8_BAR; }
        if constexpr (!Epi::AFTER_DRAIN) { E(acc, cur, wr, wc, fr, fq); S.done(cur); }
        if (!has_next) break;
#pragma unroll
        for (int a = 0; a < 2; ++a)
#pragma unroll
            for (int b = 0; b < 2; ++b)
#pragma unroll
                for (int m = 0; m < 4; ++m)
#pragma unroll
                    for (int n = 0; n < 2; ++n) acc[a][b][m][n] = (f32x4){0.f, 0.f, 0.f, 0.f};
        cur = nxt; cA = nA; cB = nB; ++ui;
        if constexpr (ALIGN_EPI) { if (wr == 1) PG8_BAR; }
    }
    PG8_WAIT_V(0);
    if constexpr (!ALIGN_EPI) { if (wr == 0) PG8_BAR; }
    PG8_BAR;
    if constexpr (Epi::AFTER_DRAIN) { E.fused(acc, cur, wr, wc, fr, fq, lds, wid, lane); S.done(cur); }
#undef PG8_SA
#undef PG8_SB
#undef PG8_STAGE
#undef PG8_LDA
#undef PG8_LDB
#undef PG8_MMA
#undef PG8_WAIT_V
#undef PG8_WAIT_L
#undef PG8_BAR
#undef PG8_SCHED
}
}
#ifndef REP0
#define REP0 1
#endif
#ifndef REP1
#define REP1 1
#endif
#ifndef REP2
#define REP2 1
#endif
#ifndef REP3
#define REP3 1
#endif
#ifndef REP4
#define REP4 1
#endif
#ifndef REP5
#define REP5 1
#endif
#ifndef REP6
#define REP6 1
#endif
#ifndef REP7
#define REP7 1
#endif
#ifndef REP8
#define REP8 1
#endif
#ifndef REP9
#define REP9 1
#endif
#ifndef REP10
#define REP10 1
#endif
#ifndef REP11
#define REP11 1
#endif
#ifndef REP12
#define REP12 1
#endif
#ifndef NAIVE_P4
#define NAIVE_P4 0
#endif
#ifndef NAIVE_P2
#define NAIVE_P2 0
#endif
#ifndef NAIVE_P8
#define NAIVE_P8 0
#endif
#ifndef N_LAUNCHES
#define N_LAUNCHES 1
#endif
constexpr int NWAVES = 8, NTHREADS = 512;
constexpr int BATCH = 8, SEQ = 4096, D = 1024, M = BATCH * SEQ;
constexpr int INW = 3072;
constexpr int NCHUNK = M / 128;
constexpr int PEER_H = 8, PEER_K = 16, NSEL = 128, NEXP = 16384;
constexpr float LN_EPS = 1e-5f, GN_EPS = 1e-5f;
constexpr float ALPHA = 1.189207115002721f;

constexpr size_t MiB = 1u << 20;
constexpr size_t WS_CTL = 0, CTL_ZERO_BYTES = 1 * MiB;
constexpr size_t WS_SKB = 1 * MiB;
constexpr size_t WS_WSB = 1 * MiB + 512 * 1024;
constexpr size_t WS_ROPE = 2 * MiB;
constexpr size_t WS_WIN = 4 * MiB;
constexpr size_t WS_WOUT = 10 * MiB;
constexpr size_t WS_WQ = 12 * MiB;
constexpr size_t WS_U8 = 16 * MiB;
constexpr size_t WS_SU = 32 * MiB;
constexpr size_t WS_SV = 32 * MiB + 65536;
constexpr size_t WS_V8 = 48 * MiB;
constexpr size_t WS_CS = 64 * MiB;
constexpr size_t WS_CQ = 112 * MiB;
constexpr size_t WS_SH = 65 * MiB;
constexpr size_t WS_H8 = 272 * MiB;
constexpr size_t WS_PDOT = 336 * MiB;
constexpr size_t WS_PROJ = 80 * MiB;
constexpr size_t WS_Z = 80 * MiB;
constexpr size_t WS_IDX = 80 * MiB;
constexpr size_t WS_GATE = 96 * MiB;
constexpr size_t WS_H = 208 * MiB;
constexpr size_t WS_XB = 272 * MiB;
constexpr size_t WS_Y = 272 * MiB;
constexpr size_t WS_ST = 336 * MiB;
constexpr size_t WS_PREV = 400 * MiB;
constexpr size_t WS_QP = 336 * MiB;
constexpr size_t WS_END = 464 * MiB;

constexpr int LDS_BYTES = 147456;

#define GAS __attribute__((address_space(1)))
#define LAS __attribute__((address_space(3)))
typedef unsigned short bf16;
typedef unsigned v4u __attribute__((ext_vector_type(4)));
typedef float f32x4 __attribute__((ext_vector_type(4)));

__device__ __forceinline__ unsigned f2bf(float f) { unsigned u = __builtin_bit_cast(unsigned, f); return (u + 0x7fffu + ((u >> 16) & 1u)) >> 16; }
__device__ __forceinline__ unsigned pk2(float lo, float hi) { return f2bf(lo) | (f2bf(hi) << 16); }
__device__ __forceinline__ float bf2f(unsigned short b) { return __builtin_bit_cast(float, (unsigned)b << 16); }
__device__ __forceinline__ float bflo(unsigned w) { return __builtin_bit_cast(float, w << 16); }
__device__ __forceinline__ float bfhi(unsigned w) { return __builtin_bit_cast(float, w & 0xffff0000u); }
__device__ __forceinline__ float wave_sum(float v) {
#pragma unroll
    for (int o = 1; o < 64; o <<= 1) v += __shfl_xor(v, o);
    return v;
}
__device__ __forceinline__ float gelu_exact(float v) { return 0.5f * v * (1.0f + erff(v * 0.70710678118654752f)); }
__device__ __forceinline__ float log_sigmoid_f(float x) { return -log1pf(expf(-x)); }

typedef short bf16x8 __attribute__((ext_vector_type(8)));
typedef short s16x4 __attribute__((ext_vector_type(4)));
typedef unsigned v2u __attribute__((ext_vector_type(2)));
__device__ __forceinline__ unsigned off_b(unsigned row, unsigned ch) { return 256u * row + 16u * (ch ^ (((row & 3u) << 2) | ((row >> 2) & 3u))); }
__device__ __forceinline__ bf16x8 frag_row(const LAS unsigned char* tile, int lane, int rb, int s) {
    return *(const LAS bf16x8*)(tile + off_b((unsigned)((lane & 15) + 16 * rb), (unsigned)(4 * s + (lane >> 4))));
}
__device__ __forceinline__ bf16x8 frag_tr(const LAS unsigned char* tile, int lane, int c, int ks) {
    const unsigned g = (unsigned)lane >> 4, q = ((unsigned)lane & 15u) >> 2, p = (unsigned)lane & 3u;
    const unsigned a0 = off_b(32u * ks + 8u * g + q, 2u * c + (p >> 1)) + 8u * (p & 1u);
    const unsigned a1 = off_b(32u * ks + 8u * g + 4u + q, 2u * c + (p >> 1)) + 8u * (p & 1u);
    typedef short v4i16_t __attribute__((ext_vector_type(4)));
    const s16x4 lo = __builtin_bit_cast(s16x4, __builtin_amdgcn_ds_read_tr16_b64_v4i16((LAS v4i16_t*)(tile + a0)));
    const s16x4 hi = __builtin_bit_cast(s16x4, __builtin_amdgcn_ds_read_tr16_b64_v4i16((LAS v4i16_t*)(tile + a1)));
    return (bf16x8){lo[0], lo[1], lo[2], lo[3], hi[0], hi[1], hi[2], hi[3]};
}
#define MFMA16(a, b, c) __builtin_amdgcn_mfma_f32_16x16x32_bf16((a), (b), (c), 0, 0, 0)
__device__ __forceinline__ void stage_tile(LAS unsigned char* tile, const bf16* src, int ld, int tid) {
    v4u v[4];
#pragma unroll
    for (int i = 0; i < 4; ++i) { const int c = tid + NTHREADS * i, row = c >> 4, ch = c & 15; v[i] = *(const v4u*)(src + (size_t)row * ld + ch * 8); }
#pragma unroll
    for (int i = 0; i < 4; ++i) { const int c = tid + NTHREADS * i, row = c >> 4, ch = c & 15; *(LAS v4u*)(tile + off_b(row, ch)) = v[i]; }
}
__device__ __forceinline__ v4u scale_chunk(v4u v, float s) {
    v4u o; o.x = pk2(bflo(v.x) * s, bfhi(v.x) * s); o.y = pk2(bflo(v.y) * s, bfhi(v.y) * s); o.z = pk2(bflo(v.z) * s, bfhi(v.z) * s); o.w = pk2(bflo(v.w) * s, bfhi(v.w) * s); return o;
}

__device__ __forceinline__ int f2key(float v, int payload) { const int b = __float_as_int(v); const int t = b ^ ((b >> 31) & 0x7fffffff); return (t & ~0xFF) | payload; }
__device__ __forceinline__ float key2f(int k) { const int t = k & ~0xFF; return __int_as_float(t ^ ((t >> 31) & 0x7fffffff)); }
__device__ __forceinline__ void merge16_desc(int (&k)[16]) {
#pragma unroll
    for (int stride = 8; stride > 0; stride >>= 1)
#pragma unroll
        for (int i = 0; i < 16; ++i) { const int l = i ^ stride; if (l > i) { const int a = k[i], b = k[l]; k[i] = max(a, b); k[l] = min(a, b); } }
}
__device__ __forceinline__ void sort16_desc(int (&k)[16]) {
#pragma unroll
    for (int size = 2; size <= 16; size <<= 1)
#pragma unroll
        for (int stride = size >> 1; stride > 0; stride >>= 1)
#pragma unroll
            for (int i = 0; i < 16; ++i) { const int l = i ^ stride; if (l > i) { const int a = k[i], b = k[l]; const bool desc = ((i & size) == 0); k[i] = desc ? max(a, b) : min(a, b); k[l] = desc ? min(a, b) : max(a, b); } }
}

#define XB_TMO      128
#define XB_XCNT(j)  (256  + 64 * (j))
#define XB_XSUB(j)  (1280 + 64 * (j))
#define XB_XGEN(j)  (2304 + 64 * (j))
#define XB_TOP      3328
#define XB_TOPGEN   3392
#define XCD_BAR_WORDS 3456
#define XB_SPIN_CAP (1u << 18)

__device__ __forceinline__ unsigned xb_ld(unsigned* p)              { return __hip_atomic_load(p, __ATOMIC_RELAXED, __HIP_MEMORY_SCOPE_AGENT); }
__device__ __forceinline__ unsigned xb_add(unsigned* p, unsigned v) { return __hip_atomic_fetch_add(p, v, __ATOMIC_RELAXED, __HIP_MEMORY_SCOPE_AGENT); }
__device__ __forceinline__ unsigned xb_xcc_id() { return (unsigned)__builtin_amdgcn_s_getreg((3 << 11) | 20) & 0xFu; }
#define XB_SPIN(cond, bar) do { unsigned _sp = 0; while (cond) { __builtin_amdgcn_s_sleep(1); \
    if ((++_sp & 255u) == 0u) { if (xb_ld(&(bar)[XB_TMO])) break; if (_sp > XB_SPIN_CAP) { atomicAdd(&(bar)[XB_TMO], 1u); break; } } } } while (0)

struct XcdBarrier {
    unsigned* bar; unsigned x;
    volatile LAS unsigned* st;
};

__device__ __forceinline__ XcdBarrier xcd_barrier_post(unsigned* bar, volatile LAS unsigned* st) {
    XcdBarrier b; b.bar = bar; b.x = xb_xcc_id(); b.st = st;
    if (threadIdx.x == 0) (void)xb_add(&bar[XB_XCNT(b.x)], 1u);
    return b;
}
__device__ __forceinline__ void xcd_barrier_complete(unsigned* bar, unsigned x, unsigned& nloc, unsigned& nx) {
    const unsigned G = gridDim.x * gridDim.y * gridDim.z;
    unsigned sum, cnt, mine, sp = 0u;
    for (;;) {
        sum = 0u; cnt = 0u; mine = 0u;
#pragma unroll
        for (unsigned j = 0; j < 16; ++j) { const unsigned c = xb_ld(&bar[XB_XCNT(j)]); sum += c; cnt += (c > 0u) ? 1u : 0u; mine = (j == x) ? c : mine; }
        if (sum == G) break;
        __builtin_amdgcn_s_sleep(1);
        if ((++sp & 255u) == 0u) { if (xb_ld(&bar[XB_TMO])) break; if (sp > XB_SPIN_CAP) { atomicAdd(&bar[XB_TMO], 1u); break; } }
    }
    nloc = mine > 0u ? mine : 1u; nx = cnt > 0u ? cnt : 1u;
}

__device__ __forceinline__ void xcd_barrier(const XcdBarrier& b) {
    asm volatile("s_waitcnt vmcnt(0)" ::: "memory");
    __syncthreads();
    if (threadIdx.x == 0) {
        unsigned* bar = b.bar;
        __builtin_amdgcn_s_waitcnt(0);
        unsigned nloc = b.st[0], nx = b.st[1];
        if (nloc == 0u) { xcd_barrier_complete(bar, b.x, nloc, nx); b.st[0] = nloc; b.st[1] = nx; }
        const unsigned old = xb_add(&bar[XB_XSUB(b.x)], 1u);
        const unsigned gen = old / nloc;
        if (old + 1u == (gen + 1u) * nloc) {
            __builtin_amdgcn_fence(__ATOMIC_RELEASE, "agent");
            asm volatile("s_waitcnt vmcnt(0)" ::: "memory");
            const unsigned og = xb_add(&bar[XB_TOP], 1u);
            const unsigned tg = og / nx;
            if (og + 1u == (tg + 1u) * nx) xb_add(&bar[XB_TOPGEN], 1u);
            else XB_SPIN(xb_ld(&bar[XB_TOPGEN]) == tg, bar);
            __builtin_amdgcn_fence(__ATOMIC_ACQUIRE, "agent");
            xb_add(&bar[XB_XGEN(b.x)], 1u);
            asm volatile("s_waitcnt vmcnt(0)" ::: "memory");
        } else {
            XB_SPIN(xb_ld(&bar[XB_XGEN(b.x)]) == gen, bar);
            __builtin_amdgcn_fence(__ATOMIC_ACQUIRE, "agent");
            asm volatile("s_waitcnt vmcnt(0)" ::: "memory");
        }
    }
    __syncthreads();
}

constexpr int CW_BAR = 4096;
constexpr int MISC_OFF = LDS_BYTES - 64;

struct Args {
    const float* in[18]; float* out; unsigned char* ws; int ph_lo, ph_hi;
};

template <int MODE>
__device__ __forceinline__ int dst_row(int n) {
    if (MODE == 1 && n >= 1024 && n < 2048) { const int j = n & 127; return (n & ~127) + ((j < 64) ? 2 * j : 2 * (j - 64) + 1); }
    return n;
}
template <int MODE>
__device__ __forceinline__ void p0_transpose_item(const float* W, int K, int N, bf16* WT, LAS float* scr, int item, int lane) {
    const int nblk = N / 32, kb = item / nblk, nb = item % nblk, k0 = 64 * kb, n0 = 32 * nb;
#pragma unroll 8
    for (int i = 0; i < 32; ++i) { const int kk = 2 * i + (lane >> 5); scr[kk * 33 + (lane & 31)] = W[(size_t)(k0 + kk) * N + n0 + (lane & 31)]; }
    asm volatile("s_waitcnt lgkmcnt(0)" ::: "memory");
    const int c = lane & 7;
#pragma unroll
    for (int j = 0; j < 4; ++j) { const int n = (lane >> 3) + 8 * j; const LAS float* s = scr + (8 * c) * 33 + n;
        v4u o; o.x = pk2(s[0 * 33], s[1 * 33]); o.y = pk2(s[2 * 33], s[3 * 33]); o.z = pk2(s[4 * 33], s[5 * 33]); o.w = pk2(s[6 * 33], s[7 * 33]);
        *(GAS v4u*)(WT + (size_t)dst_row<MODE>(n0 + n) * K + k0 + 8 * c) = o; }
    asm volatile("s_waitcnt lgkmcnt(0)" ::: "memory");
}
__device__ __forceinline__ void p0_convert(const float* src, bf16* dst, size_t n8, size_t gt, size_t ngt) {
    for (size_t i = gt; i < n8; i += ngt) {
        const f32x4 a = *(const f32x4*)(src + i * 8), b = *(const f32x4*)(src + i * 8 + 4);
        v4u o; o.x = pk2(a[0], a[1]); o.y = pk2(a[2], a[3]); o.z = pk2(b[0], b[1]); o.w = pk2(b[2], b[3]);
        *(v4u*)(dst + i * 8) = o;
    }
}

template <int PH_LO, int PH_HI>
__global__ void __launch_bounds__(NTHREADS, 2) fwd_kernel(Args args) {
    extern __shared__ __attribute__((aligned(16))) unsigned char lds_raw[];
    LAS unsigned char* lds = (LAS unsigned char*)lds_raw;
    LAS float* sm = (LAS float*)lds_raw;
    const int G = gridDim.x, bx = blockIdx.x;
#define PHASE_COORDS \
    int tid = threadIdx.x; asm volatile("" : "+v"(tid)); \
    const int lane = tid & 63, wave = __builtin_amdgcn_readfirstlane(tid >> 6); \
    const int gw = bx * NWAVES + wave, NGW = G * NWAVES; \
    const size_t gt = (size_t)bx * NTHREADS + tid, ngt = (size_t)G * NTHREADS; \
    (void)lane; (void)wave; (void)gw; (void)NGW; (void)gt; (void)ngt;
    unsigned char* ws = args.ws;
    const float* x = args.in[0];
    bf16* SKB = (bf16*)(ws + WS_SKB); bf16* WSB = (bf16*)(ws + WS_WSB); float* ROPE = (float*)(ws + WS_ROPE);
    bf16* WIN = (bf16*)(ws + WS_WIN); bf16* WOUT = (bf16*)(ws + WS_WOUT); bf16* WQ = (bf16*)(ws + WS_WQ);
    unsigned char* U8 = ws + WS_U8; unsigned char* V8 = ws + WS_V8; float* SU = (float*)(ws + WS_SU); float* SV = (float*)(ws + WS_SV);
    float* CS = (float*)(ws + WS_CS); short* CQ = (short*)(ws + WS_CQ); float* SH = (float*)(ws + WS_SH); unsigned char* H8 = ws + WS_H8; int* PDOT = (int*)(ws + WS_PDOT);
    bf16* PROJ = (bf16*)(ws + WS_PROJ); float* Z = (float*)(ws + WS_Z); unsigned short* IDX = (unsigned short*)(ws + WS_IDX); float* GATE = (float*)(ws + WS_GATE);
    bf16* H = (bf16*)(ws + WS_H); bf16* XB = (bf16*)(ws + WS_XB); bf16* Y = (bf16*)(ws + WS_Y);
    bf16* ST = (bf16*)(ws + WS_ST); bf16* PREV = (bf16*)(ws + WS_PREV); bf16* QP = (bf16*)(ws + WS_QP);
#define IN(k) (PH_LO <= (k) && (k) < PH_HI)
#define BOTH(k) (IN(k) && IN((k) + 1))
    volatile LAS unsigned* MISC = (volatile LAS unsigned*)(lds + MISC_OFF);
    XcdBarrier bar; bar.bar = (unsigned*)(ws + WS_CTL) + CW_BAR; bar.x = 0; bar.st = nullptr;
    if constexpr (PH_HI - PH_LO > 1) {
        if (threadIdx.x < 16) MISC[threadIdx.x] = 0u;
        __syncthreads();
        bar = xcd_barrier_post((unsigned*)(ws + WS_CTL) + CW_BAR, MISC + 8);
    }
#define GRID_BAR(k) do { if constexpr (BOTH(k)) xcd_barrier(bar); } while (0)

    if constexpr (IN(0)) for (int rep_ = 0; rep_ < REP0; ++rep_) {
        PHASE_COORDS
        LAS float* scr = sm + wave * 4096;
        constexpr int I_IN = (D / 64) * (INW / 32), I_OUT = (D / 64) * (D / 32), I_Q = (D / 64) * (2048 / 32);
        for (int it = gw; it < I_IN + I_OUT + I_Q; it += NGW) {
            int r = it;
            if (r < I_IN) { p0_transpose_item<1>(args.in[1], D, INW, WIN, scr, r, lane); continue; } r -= I_IN;
            if (r < I_OUT) { p0_transpose_item<0>(args.in[9], D, D, WOUT, scr, r, lane); continue; } r -= I_OUT;
            p0_transpose_item<0>(args.in[12], D, 2048, WQ, scr, r, lane);
        }
        p0_convert(args.in[13], SKB, (size_t)8 * 2 * 128 * 128 / 8, gt, ngt);
        p0_convert(args.in[4], WSB, (size_t)4 * 128 * 128 / 8, gt, ngt);
        for (int r0 = gw * 4; r0 < 2 * NEXP; r0 += NGW * 4) {
            f32x4 a[4][4]; float mx[4];
#pragma unroll
            for (int u = 0; u < 4; ++u) {
                const int r = r0 + u; const bool isv = r >= NEXP; const int e = isv ? r - NEXP : r;
                const float* src = (isv ? args.in[15] : args.in[14]) + (size_t)e * D + lane * 16;
#pragma unroll
                for (int k = 0; k < 4; ++k) a[u][k] = *(const f32x4*)(src + 4 * k);
            }
#pragma unroll
            for (int u = 0; u < 4; ++u) {
                mx[u] = 0.f;
#pragma unroll
                for (int k = 0; k < 4; ++k) mx[u] = fmaxf(mx[u], fmaxf(fmaxf(fabsf(a[u][k][0]), fabsf(a[u][k][1])), fmaxf(fabsf(a[u][k][2]), fabsf(a[u][k][3]))));
            }
#pragma unroll
            for (int o = 1; o < 64; o <<= 1)
#pragma unroll
                for (int u = 0; u < 4; ++u) mx[u] = fmaxf(mx[u], __shfl_xor(mx[u], o));
#pragma unroll
            for (int u = 0; u < 4; ++u) {
                const int r = r0 + u; const bool isv = r >= NEXP; const int e = isv ? r - NEXP : r;
                const float inv = mx[u] > 0.f ? 127.0f / mx[u] : 0.f;
                const int bias = isv ? 128 : 0;
                unsigned wq[4];
#pragma unroll
                for (int k = 0; k < 4; ++k) {
                    const int q0 = (int)rintf(a[u][k][0] * inv) + bias, q1 = (int)rintf(a[u][k][1] * inv) + bias, q2 = (int)rintf(a[u][k][2] * inv) + bias, q3 = (int)rintf(a[u][k][3] * inv) + bias;
                    wq[k] = (unsigned)(q0 & 0xff) | ((unsigned)(q1 & 0xff) << 8) | ((unsigned)(q2 & 0xff) << 16) | ((unsigned)(q3 & 0xff) << 24);
                }
                *(v4u*)((isv ? V8 : U8) + ((size_t)(lane >> 3) * NEXP + e) * 128 + (lane & 7) * 16) = (v4u){wq[0], wq[1], wq[2], wq[3]};
                if (lane == 0) (isv ? SV : SU)[e] = mx[u] * (1.0f / 127.0f);
            }
        }
        p0_convert(x, XB, (size_t)M * D / 8, gt, ngt);
        for (size_t i = gt; i < (size_t)4096 * 64; i += ngt) {
            const int pos = (int)(i >> 6), k = (int)(i & 63);
            const float inv = powf(10000.0f, -(float)k / 64.0f);
            const float ang = (float)pos * inv;
            ROPE[i * 2] = cosf(ang); ROPE[i * 2 + 1] = sinf(ang);
        }
    }

    GRID_BAR(0);

    if constexpr (IN(1)) for (int rep_ = 0; rep_ < REP1; ++rep_) {
        PHASE_COORDS
        pg8::Gemm g{XB, WIN, M, INW, D}; pg8::StaticOrder S; S.init(M, INW, G, bx);
        pg8::EpiProj E{PROJ, ROPE};
        pg8::gemm_phase<pg8::EpiProj, pg8::StaticOrder, true, true>(lds, g, S, E);
    }

    GRID_BAR(1);

#if NAIVE_P2
    if constexpr (IN(2)) for (int rep_ = 0; rep_ < REP2; ++rep_) {
        PHASE_COORDS
        const float* lnw = args.in[2]; const float* lnb = args.in[3]; const float* wsf = args.in[4]; const float* bs = args.in[5];
        for (int ck = bx; ck < NCHUNK; ck += G) {
            const int t0 = ck * 128, bb = ck >> 5, cc = ck & 31;
            LAS float* stat = sm + 16384;
            for (int r = wave * 16; r < wave * 16 + 16; ++r) {
                const v4u raw = *(const v4u*)(PROJ + (size_t)(t0 + r) * INW + 512 + lane * 8);
                float v[8] = {bflo(raw.x), bfhi(raw.x), bflo(raw.y), bfhi(raw.y), bflo(raw.z), bfhi(raw.z), bflo(raw.w), bfhi(raw.w)};
                float s = 0.f;
#pragma unroll
                for (int j = 0; j < 8; ++j) s += v[j];
                const float mean = wave_sum(s) * (1.0f / 512.0f);
                float q = 0.f;
#pragma unroll
                for (int j = 0; j < 8; ++j) { const float d = v[j] - mean; q += d * d; }
                const float rstd = 1.0f / sqrtf(wave_sum(q) * (1.0f / 512.0f) + LN_EPS);
                if (lane == 0) { stat[r * 2] = mean; stat[r * 2 + 1] = rstd; }
            }
            __syncthreads();
#pragma unroll 1
            for (int h = 0; h < 4; ++h) {
                for (int i = tid; i < 16384; i += NTHREADS) {
                    const int m = i >> 7, d = i & 127, col = h * 128 + d;
                    const float v = bf2f(PROJ[(size_t)(t0 + m) * INW + 512 + col]);
                    sm[i] = (v - stat[m * 2]) * stat[m * 2 + 1] * lnw[col] + lnb[col];
                }
                __syncthreads();
                {
                    const int d = tid & 127, lg = tid >> 7;
#pragma unroll 1
                    for (int ps = 0; ps < 4; ++ps) {
                        const int l0 = lg * 32 + ps * 8;
                        float acc[8];
#pragma unroll
                        for (int li = 0; li < 8; ++li) acc[li] = 0.f;
#pragma unroll 2
                        for (int m = 0; m < 128; ++m) {
                            const float vv = sm[m * 128 + d];
#pragma unroll
                            for (int li = 0; li < 8; ++li) acc[li] += wsf[((size_t)h * 128 + l0 + li) * 128 + m] * vv;
                        }
#pragma unroll
                        for (int li = 0; li < 8; ++li) {
                            const int l = l0 + li;
                            const float mixed = acc[li] + bs[h * 128 + l];
                            const float uu = bf2f(PROJ[(size_t)(t0 + l) * INW + h * 128 + d]);
                            Y[(size_t)(t0 + l) * D + h * 128 + d] = (bf16)f2bf(uu * mixed);
                        }
                    }
                }
                __syncthreads();
            }
#pragma unroll 1
            for (int h = 0; h < 4; ++h) {
                LAS float* Kt = sm; LAS float* Vt = sm + 16384;
                for (int i = tid; i < 16384; i += NTHREADS) {
                    const int l = i >> 7, d = i & 127;
                    Kt[i] = bf2f(PROJ[(size_t)(t0 + l) * INW + 1536 + h * 128 + d]);
                    Vt[i] = bf2f(PROJ[(size_t)(t0 + l) * INW + 2048 + h * 128 + d]);
                }
                {
                    const float lgf = log_sigmoid_f(args.in[6][h]), lgb = log_sigmoid_f(args.in[7][h]);
                    if (tid < 128) { sm[32768 + tid] = expf((float)(127 - tid) * lgf); sm[32768 + 128 + tid] = expf((float)tid * lgb); }
                }
                __syncthreads();
                const int dk = tid & 127, g4 = tid >> 7;
                const size_t u0 = (size_t)((bb * 4 + h) * 32 + cc) * 16384;
#pragma unroll 1
                for (int ps = 0; ps < 4; ++ps) {
                    const int dv0 = g4 * 32 + ps * 8;
                    float af[8], ab[8];
#pragma unroll
                    for (int j = 0; j < 8; ++j) { af[j] = 0.f; ab[j] = 0.f; }
#pragma unroll 2
                    for (int l = 0; l < 128; ++l) {
                        const float kv = Kt[l * 128 + dk];
                        const float kf = kv * sm[32768 + l], kb = kv * sm[32768 + 128 + l];
#pragma unroll
                        for (int j = 0; j < 8; ++j) { const float vv = Vt[l * 128 + dv0 + j]; af[j] += kf * vv; ab[j] += kb * vv; }
                    }
#pragma unroll
                    for (int j = 0; j < 8; ++j) {
                        const int dv = dv0 + j;
                        ST[u0 + dv * 128 + dk] = (bf16)f2bf(af[j]);
                        ST[(size_t)1024 * 16384 + u0 + dv * 128 + dk] = (bf16)f2bf(ab[j]);
                    }
                }
                __syncthreads();
            }
        }
    }

#else
    if constexpr (IN(2)) for (int rep_ = 0; rep_ < REP2; ++rep_) {
        PHASE_COORDS
        const float* lnw = args.in[2]; const float* lnb = args.in[3]; const float* bs = args.in[5];
        LAS unsigned char* B0 = lds; LAS unsigned char* B1 = lds + 32768; LAS unsigned char* B2 = lds + 65536; LAS unsigned char* B3 = lds + 98304;
        LAS float* stat = (LAS float*)(lds + 131072);
        const int g = lane >> 4, fr = lane & 15;
        const int nunit = ((NCHUNK - bx + G - 1) / G) * 4;
        unsigned gofP[4], lof[4]; int rowi[4], chi[4];
#pragma unroll
        for (int i = 0; i < 4; ++i) { const int c_ = tid + NTHREADS * i; rowi[i] = c_ >> 4; chi[i] = c_ & 15; gofP[i] = (unsigned)(rowi[i] * INW + chi[i] * 8) * 2u; lof[i] = off_b(rowi[i], chi[i]); }
#define P2_CK(n) (bx + G * ((n) >> 2))
#define LDG16(base, off) (*(const v4u*)((const char*)(base) + (off)))
        v4u ld[12];
#define P2_ISSUE(n) do { const bf16* pr_ = PROJ + (size_t)(P2_CK(n) * 128) * INW + ((n) & 3) * 128; \
            _Pragma("unroll") for (int i = 0; i < 4; ++i) { ld[i] = LDG16(pr_ + 512, gofP[i]); ld[4 + i] = LDG16(pr_ + 1536, gofP[i]); ld[8 + i] = LDG16(pr_ + 2048, gofP[i]); } } while (0)
        if (nunit > 0) P2_ISSUE(0);
#pragma unroll 1
        for (int n = 0; n < nunit; ++n) {
            const int ck = P2_CK(n), h = n & 3;
            const int t0 = ck * 128, bb = ck >> 5, cc = ck & 31;
            if (h == 0) {
                v4u raw[16];
#pragma unroll
                for (int r = 0; r < 16; ++r) raw[r] = *(const v4u*)(PROJ + (size_t)(t0 + wave * 16 + r) * INW + 512 + lane * 8);
                float sm_[16], sq_[16];
#pragma unroll
                for (int r = 0; r < 16; ++r) {
                    const float v0 = bflo(raw[r].x), v1 = bfhi(raw[r].x), v2 = bflo(raw[r].y), v3 = bfhi(raw[r].y), v4 = bflo(raw[r].z), v5 = bfhi(raw[r].z), v6 = bflo(raw[r].w), v7 = bfhi(raw[r].w);
                    sm_[r] = ((v0 + v1) + (v2 + v3)) + ((v4 + v5) + (v6 + v7));
                    sq_[r] = ((v0 * v0 + v1 * v1) + (v2 * v2 + v3 * v3)) + ((v4 * v4 + v5 * v5) + (v6 * v6 + v7 * v7));
                }
#pragma unroll
                for (int o = 1; o < 64; o <<= 1)
#pragma unroll
                    for (int r = 0; r < 16; ++r) { sm_[r] += __shfl_xor(sm_[r], o); sq_[r] += __shfl_xor(sq_[r], o); }
#pragma unroll
                for (int r = 0; r < 16; ++r) {
                    const float mean = sm_[r] * (1.0f / 512.0f);
                    const float var = fmaxf(sq_[r] * (1.0f / 512.0f) - mean * mean, 0.f);
                    if (lane == r) { stat[(wave * 16 + r) * 2] = mean; stat[(wave * 16 + r) * 2 + 1] = 1.0f / sqrtf(var + LN_EPS); }
                }
                __syncthreads();
            }
            const float lf2 = log_sigmoid_f(args.in[6][h]) * 1.4426950408889634f, lb2 = log_sigmoid_f(args.in[7][h]) * 1.4426950408889634f;
#pragma unroll
            for (int i = 0; i < 4; ++i) {
                const int row = rowi[i], ch = chi[i];
                const v4u raw = ld[i];
                const f32x4 w0 = *(const f32x4*)(lnw + h * 128 + ch * 8), w1 = *(const f32x4*)(lnw + h * 128 + ch * 8 + 4);
                const f32x4 b0 = *(const f32x4*)(lnb + h * 128 + ch * 8), b1 = *(const f32x4*)(lnb + h * 128 + ch * 8 + 4);
                const float mean = stat[row * 2], rstd = stat[row * 2 + 1];
                v4u o;
                o.x = pk2((bflo(raw.x) - mean) * rstd * w0[0] + b0[0], (bfhi(raw.x) - mean) * rstd * w0[1] + b0[1]);
                o.y = pk2((bflo(raw.y) - mean) * rstd * w0[2] + b0[2], (bfhi(raw.y) - mean) * rstd * w0[3] + b0[3]);
                o.z = pk2((bflo(raw.z) - mean) * rstd * w1[0] + b1[0], (bfhi(raw.z) - mean) * rstd * w1[1] + b1[1]);
                o.w = pk2((bflo(raw.w) - mean) * rstd * w1[2] + b1[2], (bfhi(raw.w) - mean) * rstd * w1[3] + b1[3]);
                *(LAS v4u*)(B0 + lof[i]) = o;
                *(LAS v4u*)(B1 + lof[i]) = ld[4 + i];
                *(LAS v4u*)(B2 + lof[i]) = scale_chunk(ld[8 + i], __builtin_amdgcn_exp2f((float)(127 - row) * lf2));
                *(LAS v4u*)(B3 + lof[i]) = scale_chunk(ld[8 + i], __builtin_amdgcn_exp2f((float)row * lb2));
            }
            if (n + 1 < nunit) P2_ISSUE(n + 1);
            __syncthreads();
            {
                bf16x8 wf[4];
#pragma unroll
                for (int s = 0; s < 4; ++s) wf[s] = *(const bf16x8*)(WSB + ((size_t)h * 128 + 16 * wave + fr) * 128 + 32 * s + 8 * g);
                const int l = 16 * wave + fr;
                const bf16* urow = PROJ + (size_t)(t0 + l) * INW + h * 128;
                v2u u2[8];
#pragma unroll
                for (int nt = 0; nt < 8; ++nt) u2[nt] = *(const v2u*)(urow + 16 * nt + 4 * g);
                const float bias = bs[h * 128 + l];
                f32x4 acc[8];
#pragma unroll
                for (int nt = 0; nt < 8; ++nt) acc[nt] = (f32x4){0.f, 0.f, 0.f, 0.f};
#pragma unroll
                for (int s = 0; s < 4; ++s)
#pragma unroll
                    for (int nt = 0; nt < 8; ++nt) acc[nt] = MFMA16(frag_tr(B0, lane, nt, s), wf[s], acc[nt]);
                bf16* yrow = Y + (size_t)(t0 + l) * D + h * 128;
#pragma unroll
                for (int nt = 0; nt < 8; ++nt) {
                    const int d0 = 16 * nt + 4 * g;
                    v2u w; w.x = pk2(bflo(u2[nt].x) * (acc[nt][0] + bias), bfhi(u2[nt].x) * (acc[nt][1] + bias)); w.y = pk2(bflo(u2[nt].y) * (acc[nt][2] + bias), bfhi(u2[nt].y) * (acc[nt][3] + bias));
                    *(v2u*)(yrow + d0) = w;
                }
            }
            {
                f32x4 af[8], ab[8];
#pragma unroll
                for (int nt = 0; nt < 8; ++nt) { af[nt] = (f32x4){0.f, 0.f, 0.f, 0.f}; ab[nt] = (f32x4){0.f, 0.f, 0.f, 0.f}; }
#pragma unroll
                for (int s = 0; s < 4; ++s) {
                    const bf16x8 vf = frag_tr(B2, lane, wave, s), vb = frag_tr(B3, lane, wave, s);
#pragma unroll
                    for (int nt = 0; nt < 8; ++nt) { const bf16x8 kf = frag_tr(B1, lane, nt, s); af[nt] = MFMA16(kf, vf, af[nt]); ab[nt] = MFMA16(kf, vb, ab[nt]); }
                }
                const size_t u0 = (size_t)((bb * 4 + h) * 32 + cc) * 16384 + (size_t)(16 * wave + fr) * 128;
#pragma unroll
                for (int nt = 0; nt < 8; ++nt) {
                    const int dk0 = 16 * nt + 4 * g;
                    v2u w; w.x = pk2(af[nt][0], af[nt][1]); w.y = pk2(af[nt][2], af[nt][3]);
                    *(v2u*)(ST + u0 + dk0) = w;
                    w.x = pk2(ab[nt][0], ab[nt][1]); w.y = pk2(ab[nt][2], ab[nt][3]);
                    *(v2u*)(ST + (size_t)1024 * 16384 + u0 + dk0) = w;
                }
            }
            __syncthreads();
        }
#undef P2_CK
#undef P2_ISSUE
#undef LDG16
    }

#endif
    GRID_BAR(2);

    if constexpr (IN(3)) for (int rep_ = 0; rep_ < REP3; ++rep_) {
        PHASE_COORDS
        for (size_t v = gt; v < (size_t)2 * 32 * 2048; v += ngt) {
            const int dir = (int)(v >> 16), bh = (int)((v >> 11) & 31), e8 = (int)(v & 2047), h = bh & 3;
            const float lg = log_sigmoid_f(dir == 0 ? args.in[6][h] : args.in[7][h]);
            const float Gc = expf(128.0f * lg);
            const size_t base = ((size_t)dir * 1024 + bh * 32) * 16384 + (size_t)e8 * 8;
            float st[8];
#pragma unroll
            for (int j = 0; j < 8; ++j) st[j] = 0.f;
#pragma unroll 1
            for (int half = 0; half < 2; ++half) {
                v4u sv[16];
#pragma unroll
                for (int k = 0; k < 16; ++k) { const int ci = half * 16 + k, c = (dir == 0) ? ci : 31 - ci; sv[k] = *(const v4u*)(ST + base + (size_t)c * 16384); }
#pragma unroll
                for (int k = 0; k < 16; ++k) {
                    const int ci = half * 16 + k, c = (dir == 0) ? ci : 31 - ci;
                    v4u o; o.x = pk2(st[0], st[1]); o.y = pk2(st[2], st[3]); o.z = pk2(st[4], st[5]); o.w = pk2(st[6], st[7]);
                    *(v4u*)(PREV + base + (size_t)c * 16384) = o;
                    const v4u s4 = sv[k];
                    st[0] = Gc * st[0] + bflo(s4.x); st[1] = Gc * st[1] + bfhi(s4.x); st[2] = Gc * st[2] + bflo(s4.y); st[3] = Gc * st[3] + bfhi(s4.y);
                    st[4] = Gc * st[4] + bflo(s4.z); st[5] = Gc * st[5] + bfhi(s4.z); st[6] = Gc * st[6] + bflo(s4.w); st[7] = Gc * st[7] + bfhi(s4.w);
                }
            }
        }
    }
    GRID_BAR(3);

#if NAIVE_P4
    if constexpr (IN(4)) for (int rep_ = 0; rep_ < REP4; ++rep_) {
        PHASE_COORDS
        const float* gnw = args.in[8];
        for (int ck = bx; ck < NCHUNK; ck += G) {
            const int t0 = ck * 128, bb = ck >> 5, cc = ck & 31;
#pragma unroll 1
            for (int h = 0; h < 4; ++h) {
                const float lgf = log_sigmoid_f(args.in[6][h]), lgb = log_sigmoid_f(args.in[7][h]);
                LAS float* A0 = sm;
                LAS float* A1 = sm + 16384;
                for (int i = tid; i < 16384; i += NTHREADS) {
                    const int l = i >> 7, d = i & 127;
                    A0[i] = bf2f(PROJ[(size_t)(t0 + l) * INW + 1024 + h * 128 + d]);
                    A1[l * 129 + d] = bf2f(PROJ[(size_t)(t0 + l) * INW + 1536 + h * 128 + d]);
                }
                LAS float* qwt = sm + 32896;
                if (tid < 128) { qwt[tid] = expf((float)(tid + 1) * lgf); qwt[128 + tid] = expf((float)(128 - tid) * lgb); qwt[256 + tid] = expf((float)tid * lgf); qwt[384 + tid] = expf((float)tid * lgb); }
                __syncthreads();
                const int c0 = tid & 127, lg4 = tid >> 7;
                float acc[32];
#pragma unroll
                for (int li = 0; li < 32; ++li) acc[li] = 0.f;
#pragma unroll 1
                for (int d = 0; d < 128; ++d) {
                    const float kv = A1[c0 * 129 + d];
#pragma unroll
                    for (int li = 0; li < 32; ++li) acc[li] += A0[(lg4 * 32 + li) * 128 + d] * kv;
                }
                __syncthreads();
#pragma unroll
                for (int li = 0; li < 32; ++li) {
                    const int l = lg4 * 32 + li, m = c0;
                    const float dec = (m <= l) ? qwt[256 + l - m] : qwt[384 + m - l];
                    A0[l * 128 + m] = acc[li] * dec;
                }
                for (int i = tid; i < 16384; i += NTHREADS) {
                    const int l = i >> 7, d = i & 127;
                    A1[l * 129 + d] = bf2f(PROJ[(size_t)(t0 + l) * INW + 2048 + h * 128 + d]);
                }
                __syncthreads();
                float o[32];
#pragma unroll
                for (int li = 0; li < 32; ++li) o[li] = 0.f;
#pragma unroll 1
                for (int m = 0; m < 128; ++m) {
                    const float vv = A1[m * 129 + c0];
#pragma unroll
                    for (int li = 0; li < 32; ++li) o[li] += A0[(lg4 * 32 + li) * 128 + m] * vv;
                }
                __syncthreads();
#pragma unroll 1
                for (int dir = 0; dir < 2; ++dir) {
                    const size_t u0 = ((size_t)dir * 1024 + (bb * 4 + h) * 32 + cc) * 16384;
                    __syncthreads();
                    for (int i = tid; i < 16384; i += NTHREADS) {
                        const int l = i >> 7, d = i & 127;
                        A0[i] = qwt[dir * 128 + l] * bf2f(PROJ[(size_t)(t0 + l) * INW + 1024 + h * 128 + d]);
                        A1[l * 129 + d] = bf2f(PREV[u0 + i]);
                    }
                    __syncthreads();
#pragma unroll 1
                    for (int dk = 0; dk < 128; ++dk) {
                        const float pv = A1[c0 * 129 + dk];
#pragma unroll
                        for (int li = 0; li < 32; ++li) o[li] += A0[(lg4 * 32 + li) * 128 + dk] * pv;
                    }
                }
                __syncthreads();
#pragma unroll
                for (int li = 0; li < 32; ++li) A0[(lg4 * 32 + li) * 128 + c0] = o[li];
                __syncthreads();
                for (int r = wave * 16; r < wave * 16 + 16; ++r) {
                    const float a = A0[r * 128 + lane], b = A0[r * 128 + 64 + lane];
                    const float mean = wave_sum(a + b) * (1.0f / 128.0f);
                    const float da = a - mean, db = b - mean;
                    const float rstd = 1.0f / sqrtf(wave_sum(da * da + db * db) * (1.0f / 128.0f) + GN_EPS);
                    const size_t prow = (size_t)(t0 + r) * INW + 2560 + h * 128;
                    const float ga = bf2f(PROJ[prow + lane]), gb = bf2f(PROJ[prow + 64 + lane]);
                    Y[(size_t)(t0 + r) * D + 512 + h * 128 + lane] = (bf16)f2bf(da * rstd * gnw[h * 128 + lane] * ga);
                    Y[(size_t)(t0 + r) * D + 512 + h * 128 + 64 + lane] = (bf16)f2bf(db * rstd * gnw[h * 128 + 64 + lane] * gb);
                }
                __syncthreads();
            }
        }
    }

#else
    if constexpr (IN(4)) for (int rep_ = 0; rep_ < REP4; ++rep_) {
        PHASE_COORDS
        const float* gnw = args.in[8];
        LAS unsigned char* B0 = lds; LAS unsigned char* B1 = lds + 32768; LAS unsigned char* B2 = lds + 65536; LAS unsigned char* B3 = lds + 98304;
        const int g = lane >> 4, fr = lane & 15;
        const int nunit = ((NCHUNK - bx + G - 1) / G) * 4;
        v4u qk[8];
        unsigned gofP[4], gofR[4], lof[4];
#pragma unroll
        for (int i = 0; i < 4; ++i) { const int c_ = tid + NTHREADS * i, row_ = c_ >> 4, ch_ = c_ & 15; gofP[i] = (unsigned)(row_ * INW + ch_ * 8) * 2u; gofR[i] = (unsigned)(row_ * 128 + ch_ * 8) * 2u; lof[i] = off_b(row_, ch_); }
#define P4_CK(n) (bx + G * ((n) >> 2))
#define LDG16(base, off) (*(const v4u*)((const char*)(base) + (off)))
#define P4_ISSUE_QK(n) do { const bf16* pr_ = PROJ + (size_t)(P4_CK(n) * 128) * INW + ((n) & 3) * 128; \
            _Pragma("unroll") for (int i = 0; i < 4; ++i) { qk[i] = LDG16(pr_ + 1024, gofP[i]); qk[4 + i] = LDG16(pr_ + 1536, gofP[i]); } } while (0)
        if (nunit > 0) P4_ISSUE_QK(0);
#pragma unroll 1
        for (int n = 0; n < nunit; ++n) {
            const int ck = P4_CK(n), h = n & 3;
            const int t0 = ck * 128, bb = ck >> 5, cc = ck & 31;
            const float lf2 = log_sigmoid_f(args.in[6][h]) * 1.4426950408889634f, lb2 = log_sigmoid_f(args.in[7][h]) * 1.4426950408889634f;
            const bf16* prow = PROJ + (size_t)t0 * INW + h * 128;
#pragma unroll
            for (int i = 0; i < 4; ++i) { *(LAS v4u*)(B0 + lof[i]) = qk[i]; *(LAS v4u*)(B1 + lof[i]) = qk[4 + i]; }
            v4u vpp[12];
            {
                const bf16* pf_ = PREV + (size_t)((bb * 4 + h) * 32 + cc) * 16384;
#pragma unroll
                for (int i = 0; i < 4; ++i) { vpp[i] = LDG16(prow + 2048, gofP[i]); vpp[4 + i] = LDG16(pf_, gofR[i]); vpp[8 + i] = LDG16(pf_ + (size_t)1024 * 16384, gofR[i]); }
            }
            __syncthreads();
            bf16x8 qf[4];
#pragma unroll
            for (int s = 0; s < 4; ++s) qf[s] = frag_row(B0, lane, wave, s);
            const int l = 16 * wave + fr;
            v2u pw[8];
            {
                f32x4 sacc[8];
#pragma unroll
                for (int nt = 0; nt < 8; ++nt) sacc[nt] = (f32x4){0.f, 0.f, 0.f, 0.f};
#pragma unroll
                for (int nt = 0; nt < 8; ++nt)
                { _Pragma("unroll") for (int s = 0; s < 4; ++s) sacc[nt] = MFMA16(frag_row(B1, lane, nt, s), qf[s], sacc[nt]);
                  if ((nt & 1) == 1) __builtin_amdgcn_sched_barrier(0); }
#pragma unroll
                for (int nt = 0; nt < 8; ++nt) {
                    const int m0 = 16 * nt + 4 * g;
                    float p[4];
#pragma unroll
                    for (int r = 0; r < 4; ++r) { const int m = m0 + r; p[r] = sacc[nt][r] * __builtin_amdgcn_exp2f((float)(l - m) * ((m <= l) ? lf2 : -lb2)); }
                    pw[nt].x = pk2(p[0], p[1]); pw[nt].y = pk2(p[2], p[3]);
                }
            }
            __syncthreads();
#pragma unroll
            for (int nt = 0; nt < 8; ++nt) *(LAS v2u*)(B1 + off_b((unsigned)l, (unsigned)(2 * nt + (g >> 1))) + 8 * (g & 1)) = pw[nt];
#pragma unroll
            for (int i = 0; i < 4; ++i) { *(LAS v4u*)(B2 + lof[i]) = vpp[i]; *(LAS v4u*)(B3 + lof[i]) = vpp[4 + i]; *(LAS v4u*)(B0 + lof[i]) = vpp[8 + i]; }
            if (n + 1 < nunit) P4_ISSUE_QK(n + 1);
            const bf16* grow = PROJ + (size_t)(t0 + l) * INW + 2560 + h * 128;
            __syncthreads();
            f32x4 o[8];
#pragma unroll
            for (int nt = 0; nt < 8; ++nt) o[nt] = (f32x4){0.f, 0.f, 0.f, 0.f};
            const float qwf = __builtin_amdgcn_exp2f((float)(l + 1) * lf2), qwb = __builtin_amdgcn_exp2f((float)(128 - l) * lb2);
#pragma unroll
            for (int nt = 0; nt < 8; ++nt)
#pragma unroll
                for (int s = 0; s < 4; ++s) o[nt] = MFMA16(frag_row(B3, lane, nt, s), qf[s], o[nt]);
            {
                const float ratio = qwf * __builtin_amdgcn_rcpf(qwb);
#pragma unroll
                for (int nt = 0; nt < 8; ++nt) o[nt] = o[nt] * ratio;
            }
#pragma unroll
            for (int nt = 0; nt < 8; ++nt)
#pragma unroll
                for (int s = 0; s < 4; ++s) o[nt] = MFMA16(frag_row(B0, lane, nt, s), qf[s], o[nt]);
#pragma unroll
            for (int nt = 0; nt < 8; ++nt) o[nt] = o[nt] * qwb;
#pragma unroll
            for (int s = 0; s < 4; ++s) {
                const bf16x8 pf = frag_row(B1, lane, wave, s);
#pragma unroll
                for (int nt = 0; nt < 8; ++nt) o[nt] = MFMA16(frag_tr(B2, lane, nt, s), pf, o[nt]);
            }
            float sum = 0.f;
#pragma unroll
            for (int nt = 0; nt < 8; ++nt) sum += (o[nt][0] + o[nt][1]) + (o[nt][2] + o[nt][3]);
            sum += __shfl_xor(sum, 16); sum += __shfl_xor(sum, 32);
            const float mean = sum * (1.0f / 128.0f);
            float sq = 0.f;
#pragma unroll
            for (int nt = 0; nt < 8; ++nt) { o[nt] = o[nt] - mean; sq += (o[nt][0] * o[nt][0] + o[nt][1] * o[nt][1]) + (o[nt][2] * o[nt][2] + o[nt][3] * o[nt][3]); }
            sq += __shfl_xor(sq, 16); sq += __shfl_xor(sq, 32);
            const float rstd = 1.0f / sqrtf(sq * (1.0f / 128.0f) + GN_EPS);
            bf16* yrow = Y + (size_t)(t0 + l) * D + 512 + h * 128;
#pragma unroll
            for (int nt = 0; nt < 8; ++nt) {
                const int dv0 = 16 * nt + 4 * g;
                const f32x4 gn = *(const f32x4*)(gnw + h * 128 + dv0);
                const v2u gt2 = *(const v2u*)(grow + dv0);
                v2u w; w.x = pk2(o[nt][0] * rstd * gn[0] * bflo(gt2.x), o[nt][1] * rstd * gn[1] * bfhi(gt2.x));
                w.y = pk2(o[nt][2] * rstd * gn[2] * bflo(gt2.y), o[nt][3] * rstd * gn[3] * bfhi(gt2.y));
                *(v2u*)(yrow + dv0) = w;
            }
            __syncthreads();
        }
#undef P4_CK
#undef P4_ISSUE_QK
#undef LDG16
    }

#endif
    GRID_BAR(4);

    if constexpr (IN(5)) for (int rep_ = 0; rep_ < REP5; ++rep_) {
        PHASE_COORDS
        pg8::Gemm g{Y, WOUT, M, D, D}; pg8::StaticOrder S; S.init(M, D, G, bx);
        pg8::EpiResF32 E{x, Z, D, ALPHA};
        pg8::gemm_phase<pg8::EpiResF32, pg8::StaticOrder, true, true>(lds, g, S, E);
    }

    GRID_BAR(5);

    if constexpr (IN(6)) for (int rep_ = 0; rep_ < REP6; ++rep_) {
        PHASE_COORDS
        const float* w = args.in[10]; const float* b = args.in[11];
        for (int t = gw; t < M; t += NGW) {
            const f32x4* zr = (const f32x4*)(Z + (size_t)t * D) + lane;
            f32x4 v[4]; float s = 0.f;
#pragma unroll
            for (int j = 0; j < 4; ++j) { v[j] = zr[64 * j]; s += (v[j][0] + v[j][1]) + (v[j][2] + v[j][3]); }
            const float mean = wave_sum(s) * (1.0f / D); float q = 0.f;
#pragma unroll
            for (int j = 0; j < 4; ++j) { v[j] = v[j] - mean; q += (v[j][0] * v[j][0] + v[j][1] * v[j][1]) + (v[j][2] * v[j][2] + v[j][3] * v[j][3]); }
            const float rstd = 1.0f / sqrtf(wave_sum(q) * (1.0f / D) + LN_EPS);
            unsigned long long* o8 = (unsigned long long*)(H + (size_t)t * D) + lane;
#pragma unroll
            for (int j = 0; j < 4; ++j) {
                const f32x4 wv = *((const f32x4*)w + lane + 64 * j), bv = *((const f32x4*)b + lane + 64 * j);
                const f32x4 y = v[j] * rstd * wv + bv;
                o8[64 * j] = (unsigned long long)pk2(y[0], y[1]) | ((unsigned long long)pk2(y[2], y[3]) << 32);
                v[j] = y;
            }
            float mx = 0.f;
#pragma unroll
            for (int j = 0; j < 4; ++j) mx = fmaxf(mx, fmaxf(fmaxf(fabsf(v[j][0]), fabsf(v[j][1])), fmaxf(fabsf(v[j][2]), fabsf(v[j][3]))));
#pragma unroll
            for (int o = 1; o < 64; o <<= 1) mx = fmaxf(mx, __shfl_xor(mx, o));
            const float inv = mx > 0.f ? 127.0f / mx : 0.f;
#pragma unroll
            for (int j = 0; j < 4; ++j) {
                const int q0 = (int)rintf(v[j][0] * inv), q1 = (int)rintf(v[j][1] * inv), q2 = (int)rintf(v[j][2] * inv), q3 = (int)rintf(v[j][3] * inv);
                *(unsigned*)(H8 + ((size_t)(2 * j + (lane >> 5)) * M + t) * 128 + 4 * (lane & 31)) = (unsigned)(q0 & 0xff) | ((unsigned)(q1 & 0xff) << 8) | ((unsigned)(q2 & 0xff) << 16) | ((unsigned)(q3 & 0xff) << 24);
            }
            if (lane == 0) SH[t] = mx * (1.0f / 127.0f);
        }
    }

    GRID_BAR(6);

    if constexpr (IN(7)) for (int rep_ = 0; rep_ < REP7; ++rep_) {
        PHASE_COORDS
        pg8::Gemm g{H, WQ, M, 2048, D}; pg8::StaticOrder S; S.init(M, 2048, G, bx);
        pg8::EpiPlainBf16 E{QP, 2048};
        pg8::gemm_phase<pg8::EpiPlainBf16, pg8::StaticOrder, true, true>(lds, g, S, E);
    }

    GRID_BAR(7);

#if NAIVE_P8
    if constexpr (IN(8)) for (int rep_ = 0; rep_ < REP8; ++rep_) {
        PHASE_COORDS
        const float* keys = args.in[13];
        LAS float* qs = sm;
        LAS float* sc = sm + 64 * 257;
        for (int unit = bx; unit < (M / 64) * PEER_H; unit += G) {
            const int tt0 = (unit >> 3) * 64, hd = unit & 7;
            for (int i = tid; i < 64 * 256; i += NTHREADS) { const int r = i >> 8, c = i & 255; qs[r * 257 + c] = bf2f(QP[(size_t)(tt0 + r) * 2048 + hd * 256 + c]); }
            __syncthreads();
            {
                const int tt = tid & 63, g8 = __builtin_amdgcn_readfirstlane(tid >> 6);
                for (int p = 0; p < 2; ++p) {
                    float acc[16];
#pragma unroll
                    for (int j = 0; j < 16; ++j) acc[j] = 0.f;
                    const float* kp = keys + ((size_t)(hd * 2 + p) * 128 + g8 * 16) * 128;
                    for (int d = 0; d < 128; ++d) {
                        const float qv = qs[tt * 257 + p * 128 + d];
#pragma unroll
                        for (int j = 0; j < 16; ++j) acc[j] += qv * kp[j * 128 + d];
                    }
#pragma unroll
                    for (int j = 0; j < 16; ++j) sc[tt * 257 + p * 128 + g8 * 16 + j] = acc[j];
                }
            }
            __syncthreads();
            LAS float* tops = qs;
            LAS int* topi = (LAS int*)(qs + 2048);
            LAS float* bsc = qs + 4096;
            LAS int* bps = (LAS int*)(qs + 5120);
            if (tid < 128) {
                const int tt = tid & 63, p = tid >> 6;
                LAS float* row = sc + tt * 257 + p * 128;
                for (int r = 0; r < 16; ++r) {
                    float best = -INFINITY; int bi = 0;
                    for (int n = 0; n < 128; ++n) { const float v = row[n]; if (v > best) { best = v; bi = n; } }
                    row[bi] = -INFINITY;
                    tops[(tt * 2 + p) * 16 + r] = best; topi[(tt * 2 + p) * 16 + r] = bi;
                }
            }
            __syncthreads();
            if (tid < 64) {
                const int tt = tid;
                LAS float* cand = sc + tt * 257;
                for (int a = 0; a < 16; ++a) for (int b = 0; b < 16; ++b) cand[a * 16 + b] = tops[(tt * 2) * 16 + a] + tops[(tt * 2 + 1) * 16 + b];
                float mx = -INFINITY;
                for (int r = 0; r < 16; ++r) {
                    float best = -INFINITY; int bi = 0;
                    for (int n = 0; n < 256; ++n) { const float v = cand[n]; if (v > best) { best = v; bi = n; } }
                    cand[bi] = -INFINITY;
                    bsc[tt * 16 + r] = best; bps[tt * 16 + r] = bi;
                    if (r == 0) mx = best;
                }
                float den = 0.f;
                for (int r = 0; r < 16; ++r) den += expf(bsc[tt * 16 + r] - mx);
                const float rden = 1.0f / den;
                for (int r = 0; r < 16; ++r) {
                    const int pos = bps[tt * 16 + r], a = pos >> 4, b = pos & 15;
                    const int e = topi[(tt * 2) * 16 + a] * 128 + topi[(tt * 2 + 1) * 16 + b];
                    IDX[(size_t)(tt0 + tt) * NSEL + hd * 16 + r] = (unsigned short)e;
                    GATE[(size_t)(tt0 + tt) * NSEL + hd * 16 + r] = expf(bsc[tt * 16 + r] - mx) * rden;
                }
            }
            __syncthreads();
        }
    }

#else
    if constexpr (IN(8)) for (int rep_ = 0; rep_ < REP8; ++rep_) {
        PHASE_COORDS
        LAS unsigned char* K0 = lds; LAS unsigned char* K1 = lds + 32768;
        const int g = lane >> 4, fr = lane & 15;
        int cur_hd = -1;
        for (int unit = bx; unit < (M / 128) * PEER_H; unit += G) {
            const int hd = unit & 7, tile = unit >> 3;
            if (hd != cur_hd) {
                __syncthreads();
                stage_tile(K0, SKB + (size_t)(hd * 2 + 0) * 16384, 128, tid);
                stage_tile(K1, SKB + (size_t)(hd * 2 + 1) * 16384, 128, tid);
                __syncthreads();
                cur_hd = hd;
            }
            const int t = tile * 128 + 16 * wave + fr;
            int T[2][16];
#pragma unroll
            for (int p = 0; p < 2; ++p) {
                const LAS unsigned char* KT = p ? K1 : K0;
                bf16x8 qf[4];
#pragma unroll
                for (int s = 0; s < 4; ++s) qf[s] = *(const bf16x8*)(QP + (size_t)t * 2048 + hd * 256 + p * 128 + 32 * s + 8 * g);
                f32x4 acc[8];
#pragma unroll
                for (int nt = 0; nt < 8; ++nt) acc[nt] = (f32x4){0.f, 0.f, 0.f, 0.f};
#pragma unroll
                for (int nt = 0; nt < 8; ++nt)
#pragma unroll
                    for (int s = 0; s < 4; ++s) acc[nt] = MFMA16(frag_row(KT, lane, nt, s), qf[s], acc[nt]);
                int A[16], Bk[16];
#pragma unroll
                for (int nt = 0; nt < 4; ++nt)
#pragma unroll
                    for (int r = 0; r < 4; ++r) { A[nt * 4 + r] = f2key(acc[nt][r], 16 * nt + 4 * g + r); Bk[nt * 4 + r] = f2key(acc[nt + 4][r], 16 * (nt + 4) + 4 * g + r); }
                sort16_desc(A); sort16_desc(Bk);
#pragma unroll
                for (int i = 0; i < 16; ++i) A[i] = max(A[i], Bk[15 - i]);
                merge16_desc(A);
#pragma unroll
                for (int mask = 16; mask <= 32; mask <<= 1) {
                    int P[16];
#pragma unroll
                    for (int i = 0; i < 16; ++i) P[i] = __shfl_xor(A[15 - i], mask);
#pragma unroll
                    for (int i = 0; i < 16; ++i) A[i] = max(A[i], P[i]);
                    merge16_desc(A);
                }
#pragma unroll
                for (int i = 0; i < 16; ++i) T[p][i] = A[i];
            }
            float F0[16], F1[16];
#pragma unroll
            for (int i = 0; i < 16; ++i) { F0[i] = key2f(T[0][i]); F1[i] = key2f(T[1][i]); }
            int C[16];
#pragma unroll
            for (int j = 0; j < 16; ++j) {
                constexpr int a2[16] = {2, 2, 2, 2, 2, 3, 3, 3, 3, 4, 4, 4, 5, 5, 6, 6}, b2[16] = {0, 1, 2, 3, 4, 0, 1, 2, 3, 0, 1, 2, 0, 1, 0, 1};
                const int a1 = (j < 8) ? 1 : j, b1 = (j < 8) ? j : 0;
                const float s0 = F0[0] + F1[j], s1 = F0[a1] + F1[b1], s2 = F0[a2[j]] + F1[b2[j]];
                const int k0 = f2key(s0, j), k1 = f2key(s1, a1 * 16 + b1), k2 = f2key(s2, a2[j] * 16 + b2[j]);
                const int k3 = (j < 2) ? f2key(F0[7] + F1[j], 7 * 16 + j) : (int)0x80000000;
                C[j] = (g == 0) ? k0 : (g == 1) ? k1 : (g == 2) ? k2 : k3;
            }
            sort16_desc(C);
#pragma unroll
            for (int mask = 16; mask <= 32; mask <<= 1) {
                int P[16];
#pragma unroll
                for (int i = 0; i < 16; ++i) P[i] = __shfl_xor(C[15 - i], mask);
#pragma unroll
                for (int i = 0; i < 16; ++i) C[i] = max(C[i], P[i]);
                merge16_desc(C);
            }
            const float mx = key2f(C[0]);
            int kk[4];
#pragma unroll
            for (int k = 0; k < 4; ++k) kk[k] = (g == 0) ? C[k] : (g == 1) ? C[4 + k] : (g == 2) ? C[8 + k] : C[12 + k];
            unsigned pk0[4], pk1[4];
#pragma unroll
            for (int q = 0; q < 4; ++q) {
                pk0[q] = (unsigned)(T[0][4 * q] & 0x7F) | ((unsigned)(T[0][4 * q + 1] & 0x7F) << 8) | ((unsigned)(T[0][4 * q + 2] & 0x7F) << 16) | ((unsigned)(T[0][4 * q + 3] & 0x7F) << 24);
                pk1[q] = (unsigned)(T[1][4 * q] & 0x7F) | ((unsigned)(T[1][4 * q + 1] & 0x7F) << 8) | ((unsigned)(T[1][4 * q + 2] & 0x7F) << 16) | ((unsigned)(T[1][4 * q + 3] & 0x7F) << 24);
            }
            float ev[4]; int ex[4]; float part = 0.f;
#pragma unroll
            for (int k = 0; k < 4; ++k) {
                ev[k] = __expf(key2f(kk[k]) - mx); part += ev[k];
                const int a = (kk[k] >> 4) & 15, b = kk[k] & 15;
                const unsigned w0 = (a >> 2) == 0 ? pk0[0] : (a >> 2) == 1 ? pk0[1] : (a >> 2) == 2 ? pk0[2] : pk0[3];
                const unsigned w1 = (b >> 2) == 0 ? pk1[0] : (b >> 2) == 1 ? pk1[1] : (b >> 2) == 2 ? pk1[2] : pk1[3];
                ex[k] = (int)(((w0 >> (8 * (a & 3))) & 0xFFu) * 128u + ((w1 >> (8 * (b & 3))) & 0xFFu));
            }
            part += __shfl_xor(part, 16); part += __shfl_xor(part, 32);
            const float rden = 1.0f / part;
            *(v2u*)(IDX + (size_t)t * NSEL + hd * 16 + 4 * g) = (v2u){(unsigned)ex[0] | ((unsigned)ex[1] << 16), (unsigned)ex[2] | ((unsigned)ex[3] << 16)};
            *(f32x4*)(GATE + (size_t)t * NSEL + hd * 16 + 4 * g) = (f32x4){ev[0] * rden, ev[1] * rden, ev[2] * rden, ev[3] * rden};
        }
    }

#endif
    GRID_BAR(8);

    if constexpr (IN(9)) for (int rep_ = 0; rep_ < REP9; ++rep_) {
        PHASE_COORDS
        const bool fast = (G & 7) == 0;
        const int nq = fast ? (G >> 3) * NWAVES : NGW, q0 = fast ? (bx >> 3) * NWAVES + wave : gw;
        const long ntask = fast ? (long)M : 8L * M;
        const int c = lane & 7, pg = lane >> 3;
        for (long task = q0; task < ntask; task += nq) {
            const int t = fast ? (int)task : (int)(task >> 3), x = fast ? (bx & 7) : (int)(task & 7);
            const v4u* ip = (const v4u*)(IDX + (size_t)t * NSEL + 16 * pg);
            const v4u e0 = ip[0], e1 = ip[1];
            const unsigned ee[16] = {e0.x & 0xffffu, e0.x >> 16, e0.y & 0xffffu, e0.y >> 16, e0.z & 0xffffu, e0.z >> 16, e0.w & 0xffffu, e0.w >> 16,
                                     e1.x & 0xffffu, e1.x >> 16, e1.y & 0xffffu, e1.y >> 16, e1.z & 0xffffu, e1.z >> 16, e1.w & 0xffffu, e1.w >> 16};
            const v4u hq = *(const v4u*)(H8 + ((size_t)x * M + t) * 128 + 16 * c);
            const unsigned char* ub = U8 + (size_t)x * NEXP * 128 + 16 * c;
            v4u rows[16];
#pragma unroll
            for (int i = 0; i < 16; ++i) rows[i] = *(const v4u*)(ub + (size_t)ee[i] * 128);
            int acc[16];
#pragma unroll
            for (int i = 0; i < 16; ++i) {
                int a = __builtin_amdgcn_sdot4((int)rows[i].x, (int)hq.x, 0, false);
                a = __builtin_amdgcn_sdot4((int)rows[i].y, (int)hq.y, a, false);
                a = __builtin_amdgcn_sdot4((int)rows[i].z, (int)hq.z, a, false);
                a = __builtin_amdgcn_sdot4((int)rows[i].w, (int)hq.w, a, false);
                a += __shfl_xor(a, 1); a += __shfl_xor(a, 2); a += __shfl_xor(a, 4);
                acc[i] = a;
            }
            if (c == 0) {
                v4u* op = (v4u*)(PDOT + ((size_t)x * M + t) * NSEL + 16 * pg);
                op[0] = (v4u){(unsigned)acc[0], (unsigned)acc[1], (unsigned)acc[2], (unsigned)acc[3]};
                op[1] = (v4u){(unsigned)acc[4], (unsigned)acc[5], (unsigned)acc[6], (unsigned)acc[7]};
                op[2] = (v4u){(unsigned)acc[8], (unsigned)acc[9], (unsigned)acc[10], (unsigned)acc[11]};
                op[3] = (v4u){(unsigned)acc[12], (unsigned)acc[13], (unsigned)acc[14], (unsigned)acc[15]};
            }
        }
    }
    GRID_BAR(9);

    if constexpr (IN(10)) for (int rep_ = 0; rep_ < REP10; ++rep_) {
        PHASE_COORDS
        for (int tb = gw * 4; tb < M; tb += NGW * 4) {
            int e_[4][2], sacc[4][2]; float gate_[4][2], sh_[4];
#pragma unroll
            for (int u = 0; u < 4; ++u) {
                const int t = tb + u; sh_[u] = SH[t];
#pragma unroll
                for (int k = 0; k < 2; ++k) {
                    const int j = 2 * lane + k;
                    e_[u][k] = (int)IDX[(size_t)t * NSEL + j]; gate_[u][k] = GATE[(size_t)t * NSEL + j];
                    int a = 0;
#pragma unroll
                    for (int x = 0; x < 8; ++x) a += PDOT[((size_t)x * M + t) * NSEL + j];
                    sacc[u][k] = a;
                }
            }
            float su_[4][2], sv_[4][2];
#pragma unroll
            for (int u = 0; u < 4; ++u)
#pragma unroll
                for (int k = 0; k < 2; ++k) { su_[u][k] = SU[e_[u][k]]; sv_[u][k] = SV[e_[u][k]]; }
            float cp[4][2], mx[4];
#pragma unroll
            for (int u = 0; u < 4; ++u) {
                mx[u] = 0.f;
#pragma unroll
                for (int k = 0; k < 2; ++k) { const float dot = su_[u][k] * sh_[u] * (float)sacc[u][k]; cp[u][k] = gate_[u][k] * gelu_exact(dot) * sv_[u][k]; mx[u] = fmaxf(mx[u], fabsf(cp[u][k])); }
            }
#pragma unroll
            for (int o = 1; o < 64; o <<= 1)
#pragma unroll
                for (int u = 0; u < 4; ++u) mx[u] = fmaxf(mx[u], __shfl_xor(mx[u], o));
            int qs[4];
#pragma unroll
            for (int u = 0; u < 4; ++u) {
                const int t = tb + u;
                const float inv = mx[u] > 0.f ? 32767.0f / mx[u] : 0.f;
                const int q0 = (int)rintf(cp[u][0] * inv), q1 = (int)rintf(cp[u][1] * inv);
                *(unsigned*)(CQ + (size_t)t * NSEL + 2 * lane) = ((unsigned)q0 & 0xffffu) | ((unsigned)q1 << 16);
                qs[u] = q0 + q1;
            }
#pragma unroll
            for (int o = 1; o < 64; o <<= 1)
#pragma unroll
                for (int u = 0; u < 4; ++u) qs[u] += __shfl_xor(qs[u], o);
#pragma unroll
            for (int u = 0; u < 4; ++u) if (lane == u) { CS[2 * (tb + u)] = mx[u] * (1.0f / 32767.0f); CS[2 * (tb + u) + 1] = (float)qs[u]; }
        }
    }
    GRID_BAR(10);

    if constexpr (IN(11)) for (int rep_ = 0; rep_ < REP11; ++rep_) {
        PHASE_COORDS
        const bool fast = (G & 7) == 0;
        const int nq = fast ? (G >> 3) * NWAVES : NGW, q0 = fast ? (bx >> 3) * NWAVES + wave : gw;
        const long ntask = fast ? (long)M : 8L * M;
        const int c = lane & 7, pg = lane >> 3;
        const int d0 = 8 * ((lane >> 5) & 1) + 4 * ((lane >> 4) & 1) + 2 * ((lane >> 3) & 1);
        typedef short s16x2 __attribute__((ext_vector_type(2)));
        typedef float f32x2 __attribute__((ext_vector_type(2)));
        for (long task = q0; task < ntask; task += nq) {
            const int t = fast ? (int)task : (int)(task >> 3), x = fast ? (bx & 7) : (int)(task & 7);
            const v4u* ip = (const v4u*)(IDX + (size_t)t * NSEL + 16 * pg);
            const v4u e0 = ip[0], e1 = ip[1];
            const unsigned ee[16] = {e0.x & 0xffffu, e0.x >> 16, e0.y & 0xffffu, e0.y >> 16, e0.z & 0xffffu, e0.z >> 16, e0.w & 0xffffu, e0.w >> 16,
                                     e1.x & 0xffffu, e1.x >> 16, e1.y & 0xffffu, e1.y >> 16, e1.z & 0xffffu, e1.z >> 16, e1.w & 0xffffu, e1.w >> 16};
            const v4u* qp = (const v4u*)(CQ + (size_t)t * NSEL + 16 * pg);
            const v4u cq0 = qp[0], cq1 = qp[1];
            const unsigned cqp[8] = {cq0.x, cq0.y, cq0.z, cq0.w, cq1.x, cq1.y, cq1.z, cq1.w};
            const f32x2 cs2 = *(const f32x2*)(CS + 2 * (size_t)t);
            const int col = 128 * x + 16 * c + d0;
            const unsigned hw = *(const unsigned*)(H + (size_t)t * D + col);
            const unsigned char* vb = V8 + (size_t)x * NEXP * 128 + 16 * c;
            v4u rows[16];
#pragma unroll
            for (int i = 0; i < 16; ++i) rows[i] = *(const v4u*)(vb + (size_t)ee[i] * 128);
            int acc[16];
#pragma unroll
            for (int d = 0; d < 16; ++d) acc[d] = 0;
#pragma unroll
            for (int i = 0; i < 16; i += 2) {
                const unsigned ra[4] = {rows[i].x, rows[i].y, rows[i].z, rows[i].w}, rb[4] = {rows[i + 1].x, rows[i + 1].y, rows[i + 1].z, rows[i + 1].w};
                const s16x2 cpair = __builtin_bit_cast(s16x2, cqp[i >> 1]);
#pragma unroll
                for (int k = 0; k < 4; ++k) {
                    acc[4 * k + 0] = __builtin_amdgcn_sdot2(__builtin_bit_cast(s16x2, __builtin_amdgcn_perm(rb[k], ra[k], 0x0C040C00u)), cpair, acc[4 * k + 0], false);
                    acc[4 * k + 1] = __builtin_amdgcn_sdot2(__builtin_bit_cast(s16x2, __builtin_amdgcn_perm(rb[k], ra[k], 0x0C050C01u)), cpair, acc[4 * k + 1], false);
                    acc[4 * k + 2] = __builtin_amdgcn_sdot2(__builtin_bit_cast(s16x2, __builtin_amdgcn_perm(rb[k], ra[k], 0x0C060C02u)), cpair, acc[4 * k + 2], false);
                    acc[4 * k + 3] = __builtin_amdgcn_sdot2(__builtin_bit_cast(s16x2, __builtin_amdgcn_perm(rb[k], ra[k], 0x0C070C03u)), cpair, acc[4 * k + 3], false);
                }
            }
            int r8[8], r4[4], r2[2];
            {
                const bool hi = (lane & 32) != 0;
#pragma unroll
                for (int k = 0; k < 8; ++k) { const int keep = hi ? acc[8 + k] : acc[k], send = hi ? acc[k] : acc[8 + k]; r8[k] = keep + __shfl_xor(send, 32); }
            }
            {
                const bool hi = (lane & 16) != 0;
#pragma unroll
                for (int k = 0; k < 4; ++k) { const int keep = hi ? r8[4 + k] : r8[k], send = hi ? r8[k] : r8[4 + k]; r4[k] = keep + __shfl_xor(send, 16); }
            }
            {
                const bool hi = (lane & 8) != 0;
#pragma unroll
                for (int k = 0; k < 2; ++k) { const int keep = hi ? r4[2 + k] : r4[k], send = hi ? r4[k] : r4[2 + k]; r2[k] = keep + __shfl_xor(send, 8); }
            }
            const float off = 128.0f * cs2[1];
            *(f32x2*)(args.out + (size_t)t * D + col) = (f32x2){ALPHA * bflo(hw) + cs2[0] * ((float)r2[0] - off), ALPHA * bfhi(hw) + cs2[0] * ((float)r2[1] - off)};
        }
    }
    GRID_BAR(11);

    if constexpr (IN(12)) for (int rep_ = 0; rep_ < REP12; ++rep_) {
        PHASE_COORDS
        const float* w = args.in[16]; const float* b = args.in[17];
        for (int t = gw; t < M; t += NGW) {
            f32x4* zr = (f32x4*)(args.out + (size_t)t * D) + lane;
            f32x4 v[4]; float s = 0.f;
#pragma unroll
            for (int j = 0; j < 4; ++j) { v[j] = zr[64 * j]; s += (v[j][0] + v[j][1]) + (v[j][2] + v[j][3]); }
            const float mean = wave_sum(s) * (1.0f / D); float q = 0.f;
#pragma unroll
            for (int j = 0; j < 4; ++j) { v[j] = v[j] - mean; q += (v[j][0] * v[j][0] + v[j][1] * v[j][1]) + (v[j][2] * v[j][2] + v[j][3] * v[j][3]); }
            const float rstd = 1.0f / sqrtf(wave_sum(q) * (1.0f / D) + LN_EPS);
#pragma unroll
            for (int j = 0; j < 4; ++j) {
                const f32x4 wv = *((const f32x4*)w + lane + 64 * j), bv = *((const f32x4*)b + lane + 64 * j);
                zr[64 * j] = v[j] * rstd * wv + bv;
            }
        }
    }
#undef IN
#undef BOTH
#undef GRID_BAR
}

extern "C" void kernel_launch(void* const* d_in, const int* in_sizes, int n_in, void* d_out, int out_size, void* d_ws, size_t ws_size, hipStream_t stream) {
    static int grid = 0;
    if (grid == 0) {
        if (n_in != 18 || in_sizes[0] != M * D || out_size != M * D || ws_size < WS_END) {
            fprintf(stderr, "kernel_launch: unexpected shapes: n_in %d in0 %d out %d ws %zu\n", n_in, n_in > 0 ? in_sizes[0] : -1, out_size, ws_size); grid = -1; return; }
        int dev = 0, cus = 0;
        if (hipGetDevice(&dev) != hipSuccess || hipDeviceGetAttribute(&cus, hipDeviceAttributeMultiprocessorCount, dev) != hipSuccess) { grid = -1; return; }
        bool ok = true;
#if N_LAUNCHES == 1
        ok = (hipFuncSetAttribute((const void*)fwd_kernel<0, 13>, hipFuncAttributeMaxDynamicSharedMemorySize, LDS_BYTES) == hipSuccess);
#else
#define SETATTR(k) ok = ok && (hipFuncSetAttribute((const void*)fwd_kernel<k, k + 1>, hipFuncAttributeMaxDynamicSharedMemorySize, LDS_BYTES) == hipSuccess)
        SETATTR(0); SETATTR(1); SETATTR(2); SETATTR(3); SETATTR(4); SETATTR(5); SETATTR(6); SETATTR(7); SETATTR(8); SETATTR(9); SETATTR(10); SETATTR(11); SETATTR(12);
#undef SETATTR
#endif
        if (!ok) { fprintf(stderr, "kernel_launch: hipFuncSetAttribute failed\n"); grid = -1; return; }
        grid = cus;
    }
    if (grid < 0) return;
    (void)hipMemsetAsync((char*)d_ws + WS_CTL, 0, CTL_ZERO_BYTES, stream);
    Args a{};
    for (int i = 0; i < 18; ++i) a.in[i] = (const float*)d_in[i];
    a.out = (float*)d_out; a.ws = (unsigned char*)d_ws;
    a.ph_lo = 0; a.ph_hi = 10;
#if N_LAUNCHES == 1
    hipLaunchKernelGGL((fwd_kernel<0, 13>), dim3(grid), dim3(NTHREADS), LDS_BYTES, stream, a);
#else
#define LAUNCH(k) hipLaunchKernelGGL((fwd_kernel<k, k + 1>), dim3(grid), dim3(NTHREADS), LDS_BYTES, stream, a)
    LAUNCH(0); LAUNCH(1); LAUNCH(2); LAUNCH(3); LAUNCH(4); LAUNCH(5); LAUNCH(6); LAUNCH(7); LAUNCH(8); LAUNCH(9); LAUNCH(10); LAUNCH(11); LAUNCH(12);
#undef LAUNCH
#endif
}
```

```cpp
#include <hip/hip_runtime.h>
#include <cstdio>
#include <cstdint>
#include <cmath>
namespace pg8 {
#define PG8_LAS __attribute__((address_space(3)))
typedef unsigned short bf16_t;
typedef short bf16x8 __attribute__((ext_vector_type(8)));
typedef float f32x4 __attribute__((ext_vector_type(4)));
typedef unsigned u32x4 __attribute__((ext_vector_type(4)));
constexpr int BM = 256, BK = 64, HALF = 128, HTB = HALF * BK * 2  , STAGE_BYTES = 8 * HTB, NXCD = 8, WGM = 8;

__host__ __device__ __forceinline__ int lds_byte(int r, int c) { const int st = (r >> 4) * 2 + (c >> 5), rr = r & 15, cc = c & 31, ob = rr * 64 + cc * 2; return st * 1024 + (ob ^ (((ob >> 9) & 1) << 5)); }
__host__ __device__ __forceinline__ void stage_rc(int b, int& R, int& C) { const int st = b / 1024, sb = b % 1024, swz = sb ^ (((sb >> 9) & 1) << 5); R = (st >> 1) * 16 + swz / 64; C = (st & 1) * 32 + (swz % 64) / 2; }
__host__ __device__ __forceinline__ int perm32(int rho) { const int n = rho >> 4, i = rho & 15; return 8 * (i >> 2) + 4 * n + (i & 3); }

struct Unit { int pm, pn; };
struct Gemm { const bf16_t* A; const bf16_t* Bt; int M, N, K; };

struct StaticOrder {
    int nM, nN, nwg, G, c;
    __host__ __device__ void init(int M, int N, int G_, int c_) { nM = M / BM; nN = N / BM; nwg = nM * nN; G = G_; c = c_; }
    __host__ __device__ bool next(int i, Unit& u) const {
        const long L = (long)i * G + c; if (L >= nwg) return false;
        int wgid = (int)L; { const int q = nwg / NXCD, r = nwg % NXCD, xcd = wgid % NXCD, off = wgid / NXCD; wgid = (xcd < r ? xcd * (q + 1) : r * (q + 1) + (xcd - r) * q) + off; }
        const int nig = WGM * nN, gid = wgid / nig, fm = gid * WGM, gsz = (nM - fm) < WGM ? (nM - fm) : WGM;
        u.pm = fm + ((wgid % nig) % gsz); u.pn = (wgid % nig) / gsz; return true;
    }
    __device__ __forceinline__ void a_ready(const Unit&) const {}
    __device__ __forceinline__ void done(const Unit&) const {}
};

__device__ __forceinline__ unsigned cvt_pk_bf16(float lo, float hi) { unsigned r; asm volatile("v_cvt_pk_bf16_f32 %0, %1, %2" : "=v"(r) : "v"(lo), "v"(hi)); return r; }
typedef float f32x2 __attribute__((ext_vector_type(2)));
__device__ __forceinline__ f32x2 gelu_pk(f32x2 v) {
    const f32x2 av = __builtin_elementwise_abs(v), d = av * 0.2316418882f + 1.0f;
    f32x2 t; t.x = __builtin_amdgcn_rcpf(d.x); t.y = __builtin_amdgcn_rcpf(d.y);
    f32x2 q = t * 0.5307027145f + (-0.7265760135f); q = q * t + 0.7107068705f; q = q * t + (-0.142248368f); q = q * t + 0.127414796f; q = q * t;
    const f32x2 s = (v * v) * (-0.72134752044f);
    f32x2 e; e.x = __builtin_amdgcn_exp2f(s.x); e.y = __builtin_amdgcn_exp2f(s.y);
    const f32x2 m = v * (q * e), r = v - m;
    f32x2 o; o.x = v.x < 0.f ? m.x : r.x; o.y = v.y < 0.f ? m.y : r.y; return o;
}

__device__ __forceinline__ float silu_f(float v) { return v * __builtin_amdgcn_rcpf(1.0f + __expf(-v)); }
struct EpiProj {
    static constexpr bool PERM = true, AFTER_DRAIN = false;
    bf16_t* O; const float* rope;
    __device__ __forceinline__ void operator()(const f32x4 (&acc)[2][2][4][2], const Unit& u, int wr, int wc, int fr, int fq) const {
        const int sec = u.pn >> 1;
        const int row0 = u.pm * BM + wr * 64 + fr, col0 = u.pn * BM + wc * 32 + 8 * fq;
        const int i0 = wc * 16 + 4 * fq;
#pragma unroll
        for (int ai = 0; ai < 2; ++ai)
#pragma unroll
            for (int m = 0; m < 4; ++m) {
                const int row = row0 + ai * HALF + m * 16;
                bf16_t* rowp = O + (size_t)row * 3072 + col0;
                f32x4 r0 = (f32x4){1.f, 0.f, 1.f, 0.f}, r1 = r0;
                if (sec == 2 || sec == 3) { const f32x4* rp = (const f32x4*)(rope + ((size_t)(row & 4095) * 64 + i0) * 2); r0 = rp[0]; r1 = rp[1]; }
#pragma unroll
                for (int bj = 0; bj < 2; ++bj) {
                    f32x4 v0 = acc[ai][bj][m][0], v1 = acc[ai][bj][m][1];
                    if (sec <= 1) {
                        f32x2 a = gelu_pk((f32x2){v0[0], v0[1]}), b = gelu_pk((f32x2){v0[2], v0[3]}), c = gelu_pk((f32x2){v1[0], v1[1]}), d = gelu_pk((f32x2){v1[2], v1[3]});
                        v0 = (f32x4){a.x, a.y, b.x, b.y}; v1 = (f32x4){c.x, c.y, d.x, d.y};
                    } else if (sec <= 3) {
                        const float sc = (sec == 3) ? 0.08838834764831845f : 1.0f;
                        f32x4 w0, w1;
                        w0[0] = (v0[0] * r0[0] - v0[1] * r0[1]) * sc; w0[1] = (v0[0] * r0[1] + v0[1] * r0[0]) * sc;
                        w0[2] = (v0[2] * r0[2] - v0[3] * r0[3]) * sc; w0[3] = (v0[2] * r0[3] + v0[3] * r0[2]) * sc;
                        w1[0] = (v1[0] * r1[0] - v1[1] * r1[1]) * sc; w1[1] = (v1[0] * r1[1] + v1[1] * r1[0]) * sc;
                        w1[2] = (v1[2] * r1[2] - v1[3] * r1[3]) * sc; w1[3] = (v1[2] * r1[3] + v1[3] * r1[2]) * sc;
                        v0 = w0; v1 = w1;
                    } else if (sec == 5) {
#pragma unroll
                        for (int j = 0; j < 4; ++j) { v0[j] = silu_f(v0[j]); v1[j] = silu_f(v1[j]); }
                    }
                    u32x4 w; w.x = cvt_pk_bf16(v0[0], v0[1]); w.y = cvt_pk_bf16(v0[2], v0[3]); w.z = cvt_pk_bf16(v1[0], v1[1]); w.w = cvt_pk_bf16(v1[2], v1[3]);
                    *(u32x4*)(rowp + bj * HALF) = w;
                }
            }
    }
};
struct EpiPlainBf16 {
    static constexpr bool PERM = true, AFTER_DRAIN = false;
    bf16_t* O; int ldc;
    __device__ __forceinline__ void operator()(const f32x4 (&acc)[2][2][4][2], const Unit& u, int wr, int wc, int fr, int fq) const {
        const int row0 = u.pm * BM + wr * 64 + fr, col0 = u.pn * BM + wc * 32 + 8 * fq;
#pragma unroll
        for (int ai = 0; ai < 2; ++ai)
#pragma unroll
            for (int m = 0; m < 4; ++m) { bf16_t* rowp = O + (size_t)(row0 + ai * HALF + m * 16) * ldc + col0;
#pragma unroll
                for (int bj = 0; bj < 2; ++bj) { const f32x4 v0 = acc[ai][bj][m][0], v1 = acc[ai][bj][m][1];
                    u32x4 w; w.x = cvt_pk_bf16(v0[0], v0[1]); w.y = cvt_pk_bf16(v0[2], v0[3]); w.z = cvt_pk_bf16(v1[0], v1[1]); w.w = cvt_pk_bf16(v1[2], v1[3]);
                    *(u32x4*)(rowp + bj * HALF) = w; } }
    }
};
struct EpiResBf16 {
    static constexpr bool PERM = true, AFTER_DRAIN = false;
    const bf16_t* X; bf16_t* Z; int ldc; float alpha;
    __device__ __forceinline__ void operator()(const f32x4 (&acc)[2][2][4][2], const Unit& u, int wr, int wc, int fr, int fq) const {
        const int row0 = u.pm * BM + wr * 64 + fr, col0 = u.pn * BM + wc * 32 + 8 * fq;
#pragma unroll
        for (int ai = 0; ai < 2; ++ai)
#pragma unroll
            for (int m = 0; m < 4; ++m) { const size_t off = (size_t)(row0 + ai * HALF + m * 16) * ldc + col0;
#pragma unroll
                for (int bj = 0; bj < 2; ++bj) {
                    const u32x4 xw = *(const u32x4*)(X + off + bj * HALF);
                    const f32x4 x0 = (f32x4){__builtin_bit_cast(float, xw.x << 16), __builtin_bit_cast(float, xw.x & 0xffff0000u), __builtin_bit_cast(float, xw.y << 16), __builtin_bit_cast(float, xw.y & 0xffff0000u)};
                    const f32x4 x1 = (f32x4){__builtin_bit_cast(float, xw.z << 16), __builtin_bit_cast(float, xw.z & 0xffff0000u), __builtin_bit_cast(float, xw.w << 16), __builtin_bit_cast(float, xw.w & 0xffff0000u)};
                    const f32x4 v0 = acc[ai][bj][m][0] + x0 * alpha, v1 = acc[ai][bj][m][1] + x1 * alpha;
                    u32x4 w; w.x = cvt_pk_bf16(v0[0], v0[1]); w.y = cvt_pk_bf16(v0[2], v0[3]); w.z = cvt_pk_bf16(v1[0], v1[1]); w.w = cvt_pk_bf16(v1[2], v1[3]);
                    *(u32x4*)(Z + off + bj * HALF) = w; } }
    }
};
template <class Epi, class Sched, bool ALIGN_EPI = false, bool SP2 = false>
__device__ __forceinline__ void gemm_phase(PG8_LAS unsigned char* lds, const Gemm g, const Sched& S, const Epi& E) {
    int tid_ = threadIdx.x; asm volatile("" : "+v"(tid_));
    const int tid = tid_, wid = __builtin_amdgcn_readfirstlane(tid >> 6), lane = tid & 63, wr = wid >> 2, wc = wid & 3, fr = lane & 15, fq = lane >> 4;
    const int K = g.K, nt = K / BK;
    unsigned voffA[2], voffB[2];
#pragma unroll
    for (int i = 0; i < 2; ++i) { int R, C; stage_rc(tid * 16 + i * 8192, R, C); const int Rb = Epi::PERM ? ((R & ~31) + perm32(R & 31)) : R;
        voffA[i] = (unsigned)(R * K + C) * 2u; voffB[i] = (unsigned)(Rb * K + C) * 2u; }
    const size_t kstep = (size_t)(BK * 2);
    const size_t hstep = (size_t)HALF * K * 2;
    const size_t tstep = 2 * hstep;
    const unsigned ldsw = (unsigned)wid * 1024u;
    const int aoff = lds_byte(wr * 64 + fr, fq * 8), boff = lds_byte(wc * 32 + fr, fq * 8);
#define PG8_SA(b, h) (((b) * 2 + (h)) * HTB)
#define PG8_SB(b, h) ((4 + (b) * 2 + (h)) * HTB)
#define PG8_STAGE(bufoff, gbase, voff) do { _Pragma("unroll") for (int _i = 0; _i < 2; ++_i) \
        __builtin_amdgcn_global_load_lds((const unsigned*)((const char*)(gbase) + (voff)[_i]), (PG8_LAS unsigned*)(lds + (bufoff) + ldsw + _i * 8192), 16, 0, 0); } while (0)
#define PG8_LDA(dst, b, h) do { _Pragma("unroll") for (int m = 0; m < 4; ++m) _Pragma("unroll") for (int k = 0; k < 2; ++k) dst[m][k] = *(const PG8_LAS bf16x8*)(lds + PG8_SA(b, h) + aoff + m * 2048 + k * 1024); } while (0)
#define PG8_LDB(dst, b, h) do { _Pragma("unroll") for (int n = 0; n < 2; ++n) _Pragma("unroll") for (int k = 0; k < 2; ++k) dst[n][k] = *(const PG8_LAS bf16x8*)(lds + PG8_SB(b, h) + boff + n * 2048 + k * 1024); } while (0)
#define PG8_MMA(ai, bj, At, Bt) do { __builtin_amdgcn_s_setprio(1); _Pragma("unroll") for (int m = 0; m < 4; ++m) _Pragma("unroll") for (int n = 0; n < 2; ++n) _Pragma("unroll") for (int k = 0; k < 2; ++k) \
        acc[ai][bj][m][n] = __builtin_amdgcn_mfma_f32_16x16x32_bf16(Bt[n][k], At[m][k], acc[ai][bj][m][n], 0, 0, 0); __builtin_amdgcn_s_setprio(0); } while (0)
#define PG8_WAIT_V(n) asm volatile("s_waitcnt vmcnt(" #n ")" ::: "memory")
#define PG8_WAIT_L(n) asm volatile("s_waitcnt lgkmcnt(" #n ")" ::: "memory")
#define PG8_BAR __builtin_amdgcn_s_barrier()
#define PG8_SCHED __builtin_amdgcn_sched_barrier(0)
    Unit cur, nxt; int ui = 0;
    if (!S.next(0, cur)) return;
    f32x4 acc[2][2][4][2];
#pragma unroll
    for (int a = 0; a < 2; ++a)
#pragma unroll
        for (int b = 0; b < 2; ++b)
#pragma unroll
            for (int m = 0; m < 4; ++m)
#pragma unroll
                for (int n = 0; n < 2; ++n) acc[a][b][m][n] = (f32x4){0.f, 0.f, 0.f, 0.f};
    bf16x8 At[4][2], B0[2][2], B1[2][2];
    const char* cA = (const char*)g.A + (size_t)cur.pm * tstep; const char* cB = (const char*)g.Bt + (size_t)cur.pn * tstep;
    S.a_ready(cur);
    if constexpr (SP2) {
        PG8_STAGE(PG8_SB(0, 0), cB, voffB); PG8_STAGE(PG8_SB(0, 1), cB + hstep, voffB); PG8_STAGE(PG8_SA(0, 0), cA, voffA); PG8_STAGE(PG8_SA(0, 1), cA + hstep, voffA);
        if (wr == 1) PG8_BAR;
        PG8_WAIT_V(2); PG8_BAR;
        PG8_STAGE(PG8_SB(1, 0), cB + kstep, voffB); PG8_STAGE(PG8_SA(1, 0), cA + kstep, voffA); PG8_STAGE(PG8_SB(1, 1), cB + hstep + kstep, voffB);
        PG8_WAIT_V(6); PG8_BAR;
    } else {
        PG8_STAGE(PG8_SB(0, 0), cB, voffB); PG8_STAGE(PG8_SA(0, 0), cA, voffA); PG8_STAGE(PG8_SB(0, 1), cB + hstep, voffB); PG8_STAGE(PG8_SA(0, 1), cA + hstep, voffA);
        if (wr == 1) PG8_BAR;
        PG8_WAIT_V(4); PG8_BAR;
        PG8_STAGE(PG8_SB(1, 0), cB + kstep, voffB); PG8_STAGE(PG8_SA(1, 0), cA + kstep, voffA); PG8_STAGE(PG8_SB(1, 1), cB + hstep + kstep, voffB);
        PG8_WAIT_V(6); PG8_BAR;
    }
    for (;;) {
        const bool has_next = S.next(ui + 1, nxt);
        const char* nA = has_next ? (const char*)g.A + (size_t)nxt.pm * tstep : cA; const char* nB = has_next ? (const char*)g.Bt + (size_t)nxt.pn * tstep : cB;
        for (int t = 0; t < nt; t += 2) {
            const bool last = (t == nt - 2);
            const char* a1 = cA + (size_t)(t + 1) * kstep;
            const char* a2 = last ? nA : cA + (size_t)(t + 2) * kstep; const char* b2 = last ? nB : cB + (size_t)(t + 2) * kstep;
            const char* a3 = a2 + kstep; const char* b3 = b2 + kstep;
            if (last && has_next) S.a_ready(nxt);
            if constexpr (SP2) {
            PG8_LDB(B0, 0, 0); PG8_LDB(B1, 0, 1); PG8_SCHED; PG8_LDA(At, 0, 0); PG8_STAGE(PG8_SA(1, 1), a1 + hstep, voffA);
            PG8_WAIT_V(8); PG8_WAIT_L(0); PG8_BAR; PG8_MMA(0, 0, At, B0); PG8_MMA(0, 1, At, B1); PG8_BAR; PG8_SCHED;
            PG8_LDA(At, 0, 1); PG8_STAGE(PG8_SB(0, 0), b2, voffB); PG8_STAGE(PG8_SB(0, 1), b2 + hstep, voffB); PG8_STAGE(PG8_SA(0, 0), a2, voffA);
            PG8_WAIT_V(8); PG8_WAIT_L(0); PG8_BAR; PG8_MMA(1, 0, At, B0); PG8_MMA(1, 1, At, B1); PG8_BAR; PG8_SCHED;
            PG8_LDB(B0, 1, 0); PG8_LDB(B1, 1, 1); PG8_SCHED; PG8_LDA(At, 1, 0); PG8_STAGE(PG8_SA(0, 1), a2 + hstep, voffA);
            PG8_WAIT_V(8); PG8_WAIT_L(0); PG8_BAR; PG8_MMA(0, 0, At, B0); PG8_MMA(0, 1, At, B1); PG8_BAR; PG8_SCHED;
            PG8_LDA(At, 1, 1); PG8_STAGE(PG8_SB(1, 0), b3, voffB); PG8_STAGE(PG8_SB(1, 1), b3 + hstep, voffB); PG8_STAGE(PG8_SA(1, 0), a3, voffA);
            PG8_WAIT_V(8); PG8_WAIT_L(0); PG8_BAR; PG8_MMA(1, 0, At, B0); PG8_MMA(1, 1, At, B1); PG8_BAR; PG8_SCHED;
            } else {
            PG8_LDB(B0, 0, 0); PG8_SCHED; PG8_LDA(At, 0, 0); PG8_STAGE(PG8_SA(1, 1), a1 + hstep, voffA);
            PG8_WAIT_L(8); PG8_BAR; PG8_WAIT_L(0); PG8_MMA(0, 0, At, B0); PG8_BAR; PG8_SCHED;
            PG8_LDB(B1, 0, 1); PG8_STAGE(PG8_SB(0, 0), b2, voffB);
            PG8_BAR; PG8_WAIT_L(0); PG8_MMA(0, 1, At, B1); PG8_BAR;
            PG8_LDA(At, 0, 1); PG8_STAGE(PG8_SA(0, 0), a2, voffA);
            PG8_BAR; PG8_WAIT_L(0); PG8_MMA(1, 0, At, B0); PG8_BAR; PG8_SCHED;
            PG8_STAGE(PG8_SB(0, 1), b2 + hstep, voffB);
            PG8_WAIT_V(6); PG8_BAR; PG8_MMA(1, 1, At, B1); PG8_BAR;
            PG8_LDB(B0, 1, 0); PG8_SCHED; PG8_LDA(At, 1, 0); PG8_STAGE(PG8_SA(0, 1), a2 + hstep, voffA);
            PG8_WAIT_L(8); PG8_BAR; PG8_WAIT_L(0); PG8_MMA(0, 0, At, B0); PG8_BAR; PG8_SCHED;
            PG8_LDB(B1, 1, 1); PG8_STAGE(PG8_SB(1, 0), b3, voffB);
            PG8_BAR; PG8_WAIT_L(0); PG8_MMA(0, 1, At, B1); PG8_BAR;
            PG8_LDA(At, 1, 1); PG8_STAGE(PG8_SA(1, 0), a3, voffA);
            PG8_BAR; PG8_WAIT_L(0); PG8_MMA(1, 0, At, B0); PG8_BAR; PG8_SCHED;
            PG8_STAGE(PG8_SB(1, 1), b3 + hstep, voffB);
            PG8_WAIT_V(6); PG8_BAR; PG8_MMA(1, 1, At, B1); PG8_BAR;
            }
        }
        if constexpr (ALIGN_EPI) { if (wr == 0) PG8_BAR; }
        if constexpr (!Epi::AFTER_DRAIN) { E(acc, cur, wr, wc, fr, fq); S.done(cur); }
        if (!has_next) break;
#pragma unroll
        for (int a = 0; a < 2; ++a)
#pragma unroll
            for (int b = 0; b < 2; ++b)
#pragma unroll
                for (int m = 0; m < 4; ++m)
#pragma unroll
                    for (int n = 0; n < 2; ++n) acc[a][b][m][n] = (f32x4){0.f, 0.f, 0.f, 0.f};
        cur = nxt; cA = nA; cB = nB; ++ui;
        if constexpr (ALIGN_EPI) { if (wr == 1) PG8_BAR; }
    }
    PG8_WAIT_V(0);
    if constexpr (!ALIGN_EPI) { if (wr == 0) PG8_BAR; }
    PG8_BAR;
    if constexpr (Epi::AFTER_DRAIN) { E.fused(acc, cur, wr, wc, fr, fq, lds, wid, lane); S.done(cur); }
#undef PG8_SA
#undef PG8_SB
#undef PG8_STAGE
#undef PG8_LDA
#undef PG8_LDB
#undef PG8_MMA
#undef PG8_WAIT_V
#undef PG8_WAIT_L
#undef PG8_BAR
#undef PG8_SCHED
}
}
#ifndef REP0
#define REP0 1
#endif
#ifndef REP1
#define REP1 1
#endif
#ifndef REP2
#define REP2 1
#endif
#ifndef REP3
#define REP3 1
#endif
#ifndef REP4
#define REP4 1
#endif
#ifndef REP5
#define REP5 1
#endif
#ifndef REP6
#define REP6 1
#endif
#ifndef REP7
#define REP7 1
#endif
#ifndef REP8
#define REP8 1
#endif
#ifndef REP9
#define REP9 1
#endif
#ifndef REP10
#define REP10 1
#endif
#ifndef REP11
#define REP11 1
#endif
#ifndef REP12
#define REP12 1
#endif
#ifndef NAIVE_P4
#define NAIVE_P4 0
#endif
#ifndef NAIVE_P2
#define NAIVE_P2 0
#endif
#ifndef NAIVE_P8
#define NAIVE_P8 0
#endif
#ifndef N_LAUNCHES
#define N_LAUNCHES 1
#endif
constexpr int NWAVES = 8, NTHREADS = 512;
constexpr int BATCH = 8, SEQ = 4096, D = 1024, M = BATCH * SEQ;
constexpr int INW = 3072;
constexpr int NCHUNK = M / 128;
constexpr int PEER_H = 8, PEER_K = 16, NSEL = 128, NEXP = 16384;
constexpr float LN_EPS = 1e-5f, GN_EPS = 1e-5f;
constexpr float ALPHA = 1.189207115002721f;

constexpr size_t MiB = 1u << 20;
constexpr size_t WS_CTL = 0, CTL_ZERO_BYTES = 1 * MiB;
constexpr size_t WS_SKB = 1 * MiB;
constexpr size_t WS_WSB = 1 * MiB + 512 * 1024;
constexpr size_t WS_ROPE = 2 * MiB;
constexpr size_t WS_WIN = 4 * MiB;
constexpr size_t WS_WOUT = 10 * MiB;
constexpr size_t WS_WQ = 12 * MiB;
constexpr size_t WS_U8 = 16 * MiB;
constexpr size_t WS_SU = 32 * MiB;
constexpr size_t WS_SV = 32 * MiB + 65536;
constexpr size_t WS_V8 = 33 * MiB;
constexpr size_t WS_CS = 49 * MiB;
constexpr size_t WS_SH = 50 * MiB;
constexpr size_t WS_PROJ = 52 * MiB;
constexpr size_t WS_Z = 52 * MiB;
constexpr size_t WS_ZB = 52 * MiB;
constexpr size_t WS_H = 116 * MiB;
constexpr size_t WS_IDX = 180 * MiB;
constexpr size_t WS_GATE = 188 * MiB;
constexpr size_t WS_CQ = 204 * MiB;
constexpr size_t WS_XB = 244 * MiB;
constexpr size_t WS_Y = 308 * MiB;
constexpr size_t WS_H8 = 308 * MiB;
constexpr size_t WS_ST = 372 * MiB;
constexpr size_t WS_PREV = 436 * MiB;
constexpr size_t WS_QP = 372 * MiB;
constexpr size_t WS_PDOT = 372 * MiB;
constexpr size_t WS_END = 500 * MiB;

constexpr int LDS_BYTES = 147456;

#define GAS __attribute__((address_space(1)))
#define LAS __attribute__((address_space(3)))
typedef unsigned short bf16;
typedef unsigned v4u __attribute__((ext_vector_type(4)));
typedef float f32x4 __attribute__((ext_vector_type(4)));

__device__ __forceinline__ unsigned f2bf(float f) { unsigned u = __builtin_bit_cast(unsigned, f); return (u + 0x7fffu + ((u >> 16) & 1u)) >> 16; }
__device__ __forceinline__ unsigned pk2(float lo, float hi) { return f2bf(lo) | (f2bf(hi) << 16); }
__device__ __forceinline__ float bf2f(unsigned short b) { return __builtin_bit_cast(float, (unsigned)b << 16); }
__device__ __forceinline__ float bflo(unsigned w) { return __builtin_bit_cast(float, w << 16); }
__device__ __forceinline__ float bfhi(unsigned w) { return __builtin_bit_cast(float, w & 0xffff0000u); }
__device__ __forceinline__ float wave_sum(float v) {
#pragma unroll
    for (int o = 1; o < 64; o <<= 1) v += __shfl_xor(v, o);
    return v;
}
__device__ __forceinline__ float gelu_exact(float v) { return 0.5f * v * (1.0f + erff(v * 0.70710678118654752f)); }
__device__ __forceinline__ float log_sigmoid_f(float x) { return -log1pf(expf(-x)); }

typedef short bf16x8 __attribute__((ext_vector_type(8)));
typedef short s16x4 __attribute__((ext_vector_type(4)));
typedef unsigned v2u __attribute__((ext_vector_type(2)));
__device__ __forceinline__ unsigned off_b(unsigned row, unsigned ch) { return 256u * row + 16u * (ch ^ (((row & 3u) << 2) | ((row >> 2) & 3u))); }
__device__ __forceinline__ bf16x8 frag_row(const LAS unsigned char* tile, int lane, int rb, int s) {
    return *(const LAS bf16x8*)(tile + off_b((unsigned)((lane & 15) + 16 * rb), (unsigned)(4 * s + (lane >> 4))));
}
__device__ __forceinline__ bf16x8 frag_tr(const LAS unsigned char* tile, int lane, int c, int ks) {
    const unsigned g = (unsigned)lane >> 4, q = ((unsigned)lane & 15u) >> 2, p = (unsigned)lane & 3u;
    const unsigned a0 = off_b(32u * ks + 8u * g + q, 2u * c + (p >> 1)) + 8u * (p & 1u);
    const unsigned a1 = off_b(32u * ks + 8u * g + 4u + q, 2u * c + (p >> 1)) + 8u * (p & 1u);
    typedef short v4i16_t __attribute__((ext_vector_type(4)));
    const s16x4 lo = __builtin_bit_cast(s16x4, __builtin_amdgcn_ds_read_tr16_b64_v4i16((LAS v4i16_t*)(tile + a0)));
    const s16x4 hi = __builtin_bit_cast(s16x4, __builtin_amdgcn_ds_read_tr16_b64_v4i16((LAS v4i16_t*)(tile + a1)));
    return (bf16x8){lo[0], lo[1], lo[2], lo[3], hi[0], hi[1], hi[2], hi[3]};
}
#define MFMA16(a, b, c) __builtin_amdgcn_mfma_f32_16x16x32_bf16((a), (b), (c), 0, 0, 0)
__device__ __forceinline__ void stage_tile(LAS unsigned char* tile, const bf16* src, int ld, int tid) {
    v4u v[4];
#pragma unroll
    for (int i = 0; i < 4; ++i) { const int c = tid + NTHREADS * i, row = c >> 4, ch = c & 15; v[i] = *(const v4u*)(src + (size_t)row * ld + ch * 8); }
#pragma unroll
    for (int i = 0; i < 4; ++i) { const int c = tid + NTHREADS * i, row = c >> 4, ch = c & 15; *(LAS v4u*)(tile + off_b(row, ch)) = v[i]; }
}
__device__ __forceinline__ v4u scale_chunk(v4u v, float s) {
    v4u o; o.x = pk2(bflo(v.x) * s, bfhi(v.x) * s); o.y = pk2(bflo(v.y) * s, bfhi(v.y) * s); o.z = pk2(bflo(v.z) * s, bfhi(v.z) * s); o.w = pk2(bflo(v.w) * s, bfhi(v.w) * s); return o;
}

__device__ __forceinline__ int f2key(float v, int payload) { const int b = __float_as_int(v); const int t = b ^ ((b >> 31) & 0x7fffffff); return (t & ~0xFF) | payload; }
__device__ __forceinline__ float key2f(int k) { const int t = k & ~0xFF; return __int_as_float(t ^ ((t >> 31) & 0x7fffffff)); }
__device__ __forceinline__ void merge16_desc(int (&k)[16]) {
#pragma unroll
    for (int stride = 8; stride > 0; stride >>= 1)
#pragma unroll
        for (int i = 0; i < 16; ++i) { const int l = i ^ stride; if (l > i) { const int a = k[i], b = k[l]; k[i] = max(a, b); k[l] = min(a, b); } }
}
__device__ __forceinline__ void sort16_desc(int (&k)[16]) {
#pragma unroll
    for (int size = 2; size <= 16; size <<= 1)
#pragma unroll
        for (int stride = size >> 1; stride > 0; stride >>= 1)
#pragma unroll
            for (int i = 0; i < 16; ++i) { const int l = i ^ stride; if (l > i) { const int a = k[i], b = k[l]; const bool desc = ((i & size) == 0); k[i] = desc ? max(a, b) : min(a, b); k[l] = desc ? min(a, b) : max(a, b); } }
}

#define XB_TMO      128
#define XB_XCNT(j)  (256  + 64 * (j))
#define XB_XSUB(j)  (1280 + 64 * (j))
#define XB_XGEN(j)  (2304 + 64 * (j))
#define XB_TOP      3328
#define XB_TOPGEN   3392
#define XCD_BAR_WORDS 3456
#define XB_SPIN_CAP (1u << 18)

__device__ __forceinline__ unsigned xb_ld(unsigned* p)              { return __hip_atomic_load(p, __ATOMIC_RELAXED, __HIP_MEMORY_SCOPE_AGENT); }
__device__ __forceinline__ unsigned xb_add(unsigned* p, unsigned v) { return __hip_atomic_fetch_add(p, v, __ATOMIC_RELAXED, __HIP_MEMORY_SCOPE_AGENT); }
__device__ __forceinline__ unsigned xb_xcc_id() { return (unsigned)__builtin_amdgcn_s_getreg((3 << 11) | 20) & 0xFu; }
#define XB_SPIN(cond, bar) do { unsigned _sp = 0; while (cond) { __builtin_amdgcn_s_sleep(1); \
    if ((++_sp & 255u) == 0u) { if (xb_ld(&(bar)[XB_TMO])) break; if (_sp > XB_SPIN_CAP) { atomicAdd(&(bar)[XB_TMO], 1u); break; } } } } while (0)

struct XcdBarrier {
    unsigned* bar; unsigned x;
    volatile LAS unsigned* st;
};

__device__ __forceinline__ XcdBarrier xcd_barrier_post(unsigned* bar, volatile LAS unsigned* st) {
    XcdBarrier b; b.bar = bar; b.x = xb_xcc_id(); b.st = st;
    if (threadIdx.x == 0) (void)xb_add(&bar[XB_XCNT(b.x)], 1u);
    return b;
}
__device__ __forceinline__ void xcd_barrier_complete(unsigned* bar, unsigned x, unsigned& nloc, unsigned& nx) {
    const unsigned G = gridDim.x * gridDim.y * gridDim.z;
    unsigned sum, cnt, mine, sp = 0u;
    for (;;) {
        sum = 0u; cnt = 0u; mine = 0u;
#pragma unroll
        for (unsigned j = 0; j < 16; ++j) { const unsigned c = xb_ld(&bar[XB_XCNT(j)]); sum += c; cnt += (c > 0u) ? 1u : 0u; mine = (j == x) ? c : mine; }
        if (sum == G) break;
        __builtin_amdgcn_s_sleep(1);
        if ((++sp & 255u) == 0u) { if (xb_ld(&bar[XB_TMO])) break; if (sp > XB_SPIN_CAP) { atomicAdd(&bar[XB_TMO], 1u); break; } }
    }
    nloc = mine > 0u ? mine : 1u; nx = cnt > 0u ? cnt : 1u;
}

__device__ __forceinline__ void xcd_barrier(const XcdBarrier& b) {
    asm volatile("s_waitcnt vmcnt(0)" ::: "memory");
    __syncthreads();
    if (threadIdx.x == 0) {
        unsigned* bar = b.bar;
        __builtin_amdgcn_s_waitcnt(0);
        unsigned nloc = b.st[0], nx = b.st[1];
        if (nloc == 0u) { xcd_barrier_complete(bar, b.x, nloc, nx); b.st[0] = nloc; b.st[1] = nx; }
        const unsigned old = xb_add(&bar[XB_XSUB(b.x)], 1u);
        const unsigned gen = old / nloc;
        if (old + 1u == (gen + 1u) * nloc) {
            __builtin_amdgcn_fence(__ATOMIC_RELEASE, "agent");
            asm volatile("s_waitcnt vmcnt(0)" ::: "memory");
            const unsigned og = xb_add(&bar[XB_TOP], 1u);
            const unsigned tg = og / nx;
            if (og + 1u == (tg + 1u) * nx) xb_add(&bar[XB_TOPGEN], 1u);
            else XB_SPIN(xb_ld(&bar[XB_TOPGEN]) == tg, bar);
            __builtin_amdgcn_fence(__ATOMIC_ACQUIRE, "agent");
            xb_add(&bar[XB_XGEN(b.x)], 1u);
            asm volatile("s_waitcnt vmcnt(0)" ::: "memory");
        } else {
            XB_SPIN(xb_ld(&bar[XB_XGEN(b.x)]) == gen, bar);
            __builtin_amdgcn_fence(__ATOMIC_ACQUIRE, "agent");
            asm volatile("s_waitcnt vmcnt(0)" ::: "memory");
        }
    }
    __syncthreads();
}

constexpr int CW_BAR = 4096;
constexpr int MISC_OFF = LDS_BYTES - 64;

struct Args {
    const float* in[18]; float* out; unsigned char* ws; int ph_lo, ph_hi;
};

template <int MODE>
__device__ __forceinline__ int dst_row(int n) {
    if (MODE == 1 && n >= 1024 && n < 2048) { const int j = n & 127; return (n & ~127) + ((j < 64) ? 2 * j : 2 * (j - 64) + 1); }
    return n;
}
template <int MODE>
__device__ __forceinline__ void p0_transpose_item(const float* W, int K, int N, bf16* WT, LAS float* scr, int item, int lane) {
    const int nblk = N / 32, kb = item / nblk, nb = item % nblk, k0 = 64 * kb, n0 = 32 * nb;
#pragma unroll 8
    for (int i = 0; i < 32; ++i) { const int kk = 2 * i + (lane >> 5); scr[kk * 33 + (lane & 31)] = W[(size_t)(k0 + kk) * N + n0 + (lane & 31)]; }
    asm volatile("s_waitcnt lgkmcnt(0)" ::: "memory");
    const int c = lane & 7;
#pragma unroll
    for (int j = 0; j < 4; ++j) { const int n = (lane >> 3) + 8 * j; const LAS float* s = scr + (8 * c) * 33 + n;
        v4u o; o.x = pk2(s[0 * 33], s[1 * 33]); o.y = pk2(s[2 * 33], s[3 * 33]); o.z = pk2(s[4 * 33], s[5 * 33]); o.w = pk2(s[6 * 33], s[7 * 33]);
        *(GAS v4u*)(WT + (size_t)dst_row<MODE>(n0 + n) * K + k0 + 8 * c) = o; }
    asm volatile("s_waitcnt lgkmcnt(0)" ::: "memory");
}
__device__ __forceinline__ void p0_convert(const float* src, bf16* dst, size_t n8, size_t gt, size_t ngt) {
    for (size_t i = gt; i < n8; i += ngt) {
        const f32x4 a = *(const f32x4*)(src + i * 8), b = *(const f32x4*)(src + i * 8 + 4);
        v4u o; o.x = pk2(a[0], a[1]); o.y = pk2(a[2], a[3]); o.z = pk2(b[0], b[1]); o.w = pk2(b[2], b[3]);
        *(v4u*)(dst + i * 8) = o;
    }
}

template <int PH_LO, int PH_HI>
__global__ void __launch_bounds__(NTHREADS, 2) fwd_kernel(Args args) {
    extern __shared__ __attribute__((aligned(16))) unsigned char lds_raw[];
    LAS unsigned char* lds = (LAS unsigned char*)lds_raw;
    LAS float* sm = (LAS float*)lds_raw;
    const int G = gridDim.x, bx = blockIdx.x;
#define PHASE_COORDS \
    int tid = threadIdx.x; asm volatile("" : "+v"(tid)); \
    const int lane = tid & 63, wave = __builtin_amdgcn_readfirstlane(tid >> 6); \
    const int gw = bx * NWAVES + wave, NGW = G * NWAVES; \
    const size_t gt = (size_t)bx * NTHREADS + tid, ngt = (size_t)G * NTHREADS; \
    (void)lane; (void)wave; (void)gw; (void)NGW; (void)gt; (void)ngt;
    unsigned char* ws = args.ws;
    const float* x = args.in[0];
    bf16* SKB = (bf16*)(ws + WS_SKB); bf16* WSB = (bf16*)(ws + WS_WSB); float* ROPE = (float*)(ws + WS_ROPE);
    bf16* WIN = (bf16*)(ws + WS_WIN); bf16* WOUT = (bf16*)(ws + WS_WOUT); bf16* WQ = (bf16*)(ws + WS_WQ);
    unsigned char* U8 = ws + WS_U8; unsigned char* V8 = ws + WS_V8; float* SU = (float*)(ws + WS_SU); float* SV = (float*)(ws + WS_SV);
    float* CS = (float*)(ws + WS_CS); short* CQ = (short*)(ws + WS_CQ); bf16* ZB = (bf16*)(ws + WS_ZB); float* SH = (float*)(ws + WS_SH); unsigned char* H8 = ws + WS_H8; bf16* PDOT = (bf16*)(ws + WS_PDOT);
    bf16* PROJ = (bf16*)(ws + WS_PROJ); bf16* Z = (bf16*)(ws + WS_Z); unsigned short* IDX = (unsigned short*)(ws + WS_IDX); float* GATE = (float*)(ws + WS_GATE);
    bf16* H = (bf16*)(ws + WS_H); bf16* XB = (bf16*)(ws + WS_XB); bf16* Y = (bf16*)(ws + WS_Y);
    bf16* ST = (bf16*)(ws + WS_ST); bf16* PREV = (bf16*)(ws + WS_PREV); bf16* QP = (bf16*)(ws + WS_QP);
#define IN(k) (PH_LO <= (k) && (k) < PH_HI)
#define BOTH(k) (IN(k) && IN((k) + 1))
    volatile LAS unsigned* MISC = (volatile LAS unsigned*)(lds + MISC_OFF);
    XcdBarrier bar; bar.bar = (unsigned*)(ws + WS_CTL) + CW_BAR; bar.x = 0; bar.st = nullptr;
    if constexpr (PH_HI - PH_LO > 1) {
        if (threadIdx.x < 16) MISC[threadIdx.x] = 0u;
        __syncthreads();
        bar = xcd_barrier_post((unsigned*)(ws + WS_CTL) + CW_BAR, MISC + 8);
    }
#define GRID_BAR(k) do { if constexpr (BOTH(k)) xcd_barrier(bar); } while (0)

    if constexpr (IN(0)) for (int rep_ = 0; rep_ < REP0; ++rep_) {
        PHASE_COORDS
        LAS float* scr = sm + wave * 4096;
        constexpr int I_IN = (D / 64) * (INW / 32), I_OUT = (D / 64) * (D / 32), I_Q = (D / 64) * (2048 / 32);
        for (int it = gw; it < I_IN + I_OUT + I_Q; it += NGW) {
            int r = it;
            if (r < I_IN) { p0_transpose_item<1>(args.in[1], D, INW, WIN, scr, r, lane); continue; } r -= I_IN;
            if (r < I_OUT) { p0_transpose_item<0>(args.in[9], D, D, WOUT, scr, r, lane); continue; } r -= I_OUT;
            p0_transpose_item<0>(args.in[12], D, 2048, WQ, scr, r, lane);
        }
        p0_convert(args.in[13], SKB, (size_t)8 * 2 * 128 * 128 / 8, gt, ngt);
        p0_convert(args.in[4], WSB, (size_t)4 * 128 * 128 / 8, gt, ngt);
        for (int r0 = gw * 4; r0 < 2 * NEXP; r0 += NGW * 4) {
            f32x4 a[4][4]; float mx[4];
#pragma unroll
            for (int u = 0; u < 4; ++u) {
                const int r = r0 + u; const bool isv = r >= NEXP; const int e = isv ? r - NEXP : r;
                const float* src = (isv ? args.in[15] : args.in[14]) + (size_t)e * D + lane * 16;
#pragma unroll
                for (int k = 0; k < 4; ++k) a[u][k] = *(const f32x4*)(src + 4 * k);
            }
#pragma unroll
            for (int u = 0; u < 4; ++u) {
                mx[u] = 0.f;
#pragma unroll
                for (int k = 0; k < 4; ++k) mx[u] = fmaxf(mx[u], fmaxf(fmaxf(fabsf(a[u][k][0]), fabsf(a[u][k][1])), fmaxf(fabsf(a[u][k][2]), fabsf(a[u][k][3]))));
            }
#pragma unroll
            for (int o = 1; o < 64; o <<= 1)
#pragma unroll
                for (int u = 0; u < 4; ++u) mx[u] = fmaxf(mx[u], __shfl_xor(mx[u], o));
#pragma unroll
            for (int u = 0; u < 4; ++u) {
                const int r = r0 + u; const bool isv = r >= NEXP; const int e = isv ? r - NEXP : r;
                const float inv = mx[u] > 0.f ? 127.0f / mx[u] : 0.f;
                const int bias = isv ? 128 : 0;
                unsigned wq[4];
#pragma unroll
                for (int k = 0; k < 4; ++k) {
                    const int q0 = (int)rintf(a[u][k][0] * inv) + bias, q1 = (int)rintf(a[u][k][1] * inv) + bias, q2 = (int)rintf(a[u][k][2] * inv) + bias, q3 = (int)rintf(a[u][k][3] * inv) + bias;
                    wq[k] = (unsigned)(q0 & 0xff) | ((unsigned)(q1 & 0xff) << 8) | ((unsigned)(q2 & 0xff) << 16) | ((unsigned)(q3 & 0xff) << 24);
                }
                *(v4u*)((isv ? V8 : U8) + ((size_t)(lane >> 3) * NEXP + e) * 128 + (lane & 7) * 16) = (v4u){wq[0], wq[1], wq[2], wq[3]};
                if (lane == 0) (isv ? SV : SU)[e] = mx[u] * (1.0f / 127.0f);
            }
        }
        p0_convert(x, XB, (size_t)M * D / 8, gt, ngt);
        for (size_t i = gt; i < (size_t)4096 * 64; i += ngt) {
            const int pos = (int)(i >> 6), k = (int)(i & 63);
            const float inv = powf(10000.0f, -(float)k / 64.0f);
            const float ang = (float)pos * inv;
            ROPE[i * 2] = cosf(ang); ROPE[i * 2 + 1] = sinf(ang);
        }
    }

    GRID_BAR(0);

    if constexpr (IN(1)) for (int rep_ = 0; rep_ < REP1; ++rep_) {
        PHASE_COORDS
        pg8::Gemm g{XB, WIN, M, INW, D}; pg8::StaticOrder S; S.init(M, INW, G, bx);
        pg8::EpiProj E{PROJ, ROPE};
        pg8::gemm_phase<pg8::EpiProj, pg8::StaticOrder, true, true>(lds, g, S, E);
    }

    GRID_BAR(1);

#if NAIVE_P2
    if constexpr (IN(2)) for (int rep_ = 0; rep_ < REP2; ++rep_) {
        PHASE_COORDS
        const float* lnw = args.in[2]; const float* lnb = args.in[3]; const float* wsf = args.in[4]; const float* bs = args.in[5];
        for (int ck = bx; ck < NCHUNK; ck += G) {
            const int t0 = ck * 128, bb = ck >> 5, cc = ck & 31;
            LAS float* stat = sm + 16384;
            for (int r = wave * 16; r < wave * 16 + 16; ++r) {
                const v4u raw = *(const v4u*)(PROJ + (size_t)(t0 + r) * INW + 512 + lane * 8);
                float v[8] = {bflo(raw.x), bfhi(raw.x), bflo(raw.y), bfhi(raw.y), bflo(raw.z), bfhi(raw.z), bflo(raw.w), bfhi(raw.w)};
                float s = 0.f;
#pragma unroll
                for (int j = 0; j < 8; ++j) s += v[j];
                const float mean = wave_sum(s) * (1.0f / 512.0f);
                float q = 0.f;
#pragma unroll
                for (int j = 0; j < 8; ++j) { const float d = v[j] - mean; q += d * d; }
                const float rstd = 1.0f / sqrtf(wave_sum(q) * (1.0f / 512.0f) + LN_EPS);
                if (lane == 0) { stat[r * 2] = mean; stat[r * 2 + 1] = rstd; }
            }
            __syncthreads();
#pragma unroll 1
            for (int h = 0; h < 4; ++h) {
                for (int i = tid; i < 16384; i += NTHREADS) {
                    const int m = i >> 7, d = i & 127, col = h * 128 + d;
                    const float v = bf2f(PROJ[(size_t)(t0 + m) * INW + 512 + col]);
                    sm[i] = (v - stat[m * 2]) * stat[m * 2 + 1] * lnw[col] + lnb[col];
                }
                __syncthreads();
                {
                    const int d = tid & 127, lg = tid >> 7;
#pragma unroll 1
                    for (int ps = 0; ps < 4; ++ps) {
                        const int l0 = lg * 32 + ps * 8;
                        float acc[8];
#pragma unroll
                        for (int li = 0; li < 8; ++li) acc[li] = 0.f;
#pragma unroll 2
                        for (int m = 0; m < 128; ++m) {
                            const float vv = sm[m * 128 + d];
#pragma unroll
                            for (int li = 0; li < 8; ++li) acc[li] += wsf[((size_t)h * 128 + l0 + li) * 128 + m] * vv;
                        }
#pragma unroll
                        for (int li = 0; li < 8; ++li) {
                            const int l = l0 + li;
                            const float mixed = acc[li] + bs[h * 128 + l];
                            const float uu = bf2f(PROJ[(size_t)(t0 + l) * INW + h * 128 + d]);
                            Y[(size_t)(t0 + l) * D + h * 128 + d] = (bf16)f2bf(uu * mixed);
                        }
                    }
                }
                __syncthreads();
            }
#pragma unroll 1
            for (int h = 0; h < 4; ++h) {
                LAS float* Kt = sm; LAS float* Vt = sm + 16384;
                for (int i = tid; i < 16384; i += NTHREADS) {
                    const int l = i >> 7, d = i & 127;
                    Kt[i] = bf2f(PROJ[(size_t)(t0 + l) * INW + 1536 + h * 128 + d]);
                    Vt[i] = bf2f(PROJ[(size_t)(t0 + l) * INW + 2048 + h * 128 + d]);
                }
                {
                    const float lgf = log_sigmoid_f(args.in[6][h]), lgb = log_sigmoid_f(args.in[7][h]);
                    if (tid < 128) { sm[32768 + tid] = expf((float)(127 - tid) * lgf); sm[32768 + 128 + tid] = expf((float)tid * lgb); }
                }
                __syncthreads();
                const int dk = tid & 127, g4 = tid >> 7;
                const size_t u0 = (size_t)((bb * 4 + h) * 32 + cc) * 16384;
#pragma unroll 1
                for (int ps = 0; ps < 4; ++ps) {
                    const int dv0 = g4 * 32 + ps * 8;
                    float af[8], ab[8];
#pragma unroll
                    for (int j = 0; j < 8; ++j) { af[j] = 0.f; ab[j] = 0.f; }
#pragma unroll 2
                    for (int l = 0; l < 128; ++l) {
                        const float kv = Kt[l * 128 + dk];
                        const float kf = kv * sm[32768 + l], kb = kv * sm[32768 + 128 + l];
#pragma unroll
                        for (int j = 0; j < 8; ++j) { const float vv = Vt[l * 128 + dv0 + j]; af[j] += kf * vv; ab[j] += kb * vv; }
                    }
#pragma unroll
                    for (int j = 0; j < 8; ++j) {
                        const int dv = dv0 + j;
                        ST[u0 + dv * 128 + dk] = (bf16)f2bf(af[j]);
                        ST[(size_t)1024 * 16384 + u0 + dv * 128 + dk] = (bf16)f2bf(ab[j]);
                    }
                }
                __syncthreads();
            }
        }
    }

#else
    if constexpr (IN(2)) for (int rep_ = 0; rep_ < REP2; ++rep_) {
        PHASE_COORDS
        const float* lnw = args.in[2]; const float* lnb = args.in[3]; const float* bs = args.in[5];
        LAS unsigned char* B0 = lds; LAS unsigned char* B1 = lds + 32768; LAS unsigned char* B2 = lds + 65536; LAS unsigned char* B3 = lds + 98304;
        LAS float* stat = (LAS float*)(lds + 131072);
        const int g = lane >> 4, fr = lane & 15;
        const int nunit = ((NCHUNK - bx + G - 1) / G) * 4;
        unsigned gofP[4], lof[4]; int rowi[4], chi[4];
#pragma unroll
        for (int i = 0; i < 4; ++i) { const int c_ = tid + NTHREADS * i; rowi[i] = c_ >> 4; chi[i] = c_ & 15; gofP[i] = (unsigned)(rowi[i] * INW + chi[i] * 8) * 2u; lof[i] = off_b(rowi[i], chi[i]); }
#define P2_CK(n) (bx + G * ((n) >> 2))
#define LDG16(base, off) (*(const v4u*)((const char*)(base) + (off)))
        v4u ld[12];
#define P2_ISSUE(n) do { const bf16* pr_ = PROJ + (size_t)(P2_CK(n) * 128) * INW + ((n) & 3) * 128; \
            _Pragma("unroll") for (int i = 0; i < 4; ++i) { ld[i] = LDG16(pr_ + 512, gofP[i]); ld[4 + i] = LDG16(pr_ + 1536, gofP[i]); ld[8 + i] = LDG16(pr_ + 2048, gofP[i]); } } while (0)
        if (nunit > 0) P2_ISSUE(0);
#pragma unroll 1
        for (int n = 0; n < nunit; ++n) {
            const int ck = P2_CK(n), h = n & 3;
            const int t0 = ck * 128, bb = ck >> 5, cc = ck & 31;
            if (h == 0) {
                v4u raw[16];
#pragma unroll
                for (int r = 0; r < 16; ++r) raw[r] = *(const v4u*)(PROJ + (size_t)(t0 + wave * 16 + r) * INW + 512 + lane * 8);
                float sm_[16], sq_[16];
#pragma unroll
                for (int r = 0; r < 16; ++r) {
                    const float v0 = bflo(raw[r].x), v1 = bfhi(raw[r].x), v2 = bflo(raw[r].y), v3 = bfhi(raw[r].y), v4 = bflo(raw[r].z), v5 = bfhi(raw[r].z), v6 = bflo(raw[r].w), v7 = bfhi(raw[r].w);
                    sm_[r] = ((v0 + v1) + (v2 + v3)) + ((v4 + v5) + (v6 + v7));
                    sq_[r] = ((v0 * v0 + v1 * v1) + (v2 * v2 + v3 * v3)) + ((v4 * v4 + v5 * v5) + (v6 * v6 + v7 * v7));
                }
#pragma unroll
                for (int o = 1; o < 64; o <<= 1)
#pragma unroll
                    for (int r = 0; r < 16; ++r) { sm_[r] += __shfl_xor(sm_[r], o); sq_[r] += __shfl_xor(sq_[r], o); }
#pragma unroll
                for (int r = 0; r < 16; ++r) {
                    const float mean = sm_[r] * (1.0f / 512.0f);
                    const float var = fmaxf(sq_[r] * (1.0f / 512.0f) - mean * mean, 0.f);
                    if (lane == r) { stat[(wave * 16 + r) * 2] = mean; stat[(wave * 16 + r) * 2 + 1] = 1.0f / sqrtf(var + LN_EPS); }
                }
                __syncthreads();
            }
            const float lf2 = log_sigmoid_f(args.in[6][h]) * 1.4426950408889634f, lb2 = log_sigmoid_f(args.in[7][h]) * 1.4426950408889634f;
#pragma unroll
            for (int i = 0; i < 4; ++i) {
                const int row = rowi[i], ch = chi[i];
                const v4u raw = ld[i];
                const f32x4 w0 = *(const f32x4*)(lnw + h * 128 + ch * 8), w1 = *(const f32x4*)(lnw + h * 128 + ch * 8 + 4);
                const f32x4 b0 = *(const f32x4*)(lnb + h * 128 + ch * 8), b1 = *(const f32x4*)(lnb + h * 128 + ch * 8 + 4);
                const float mean = stat[row * 2], rstd = stat[row * 2 + 1];
                v4u o;
                o.x = pk2((bflo(raw.x) - mean) * rstd * w0[0] + b0[0], (bfhi(raw.x) - mean) * rstd * w0[1] + b0[1]);
                o.y = pk2((bflo(raw.y) - mean) * rstd * w0[2] + b0[2], (bfhi(raw.y) - mean) * rstd * w0[3] + b0[3]);
                o.z = pk2((bflo(raw.z) - mean) * rstd * w1[0] + b1[0], (bfhi(raw.z) - mean) * rstd * w1[1] + b1[1]);
                o.w = pk2((bflo(raw.w) - mean) * rstd * w1[2] + b1[2], (bfhi(raw.w) - mean) * rstd * w1[3] + b1[3]);
                *(LAS v4u*)(B0 + lof[i]) = o;
                *(LAS v4u*)(B1 + lof[i]) = ld[4 + i];
                *(LAS v4u*)(B2 + lof[i]) = scale_chunk(ld[8 + i], __builtin_amdgcn_exp2f((float)(127 - row) * lf2));
                *(LAS v4u*)(B3 + lof[i]) = scale_chunk(ld[8 + i], __builtin_amdgcn_exp2f((float)row * lb2));
            }
            if (n + 1 < nunit) P2_ISSUE(n + 1);
            __syncthreads();
            {
                bf16x8 wf[4];
#pragma unroll
                for (int s = 0; s < 4; ++s) wf[s] = *(const bf16x8*)(WSB + ((size_t)h * 128 + 16 * wave + fr) * 128 + 32 * s + 8 * g);
                const int l = 16 * wave + fr;
                const bf16* urow = PROJ + (size_t)(t0 + l) * INW + h * 128;
                v2u u2[8];
#pragma unroll
                for (int nt = 0; nt < 8; ++nt) u2[nt] = *(const v2u*)(urow + 16 * nt + 4 * g);
                const float bias = bs[h * 128 + l];
                f32x4 acc[8];
#pragma unroll
                for (int nt = 0; nt < 8; ++nt) acc[nt] = (f32x4){0.f, 0.f, 0.f, 0.f};
#pragma unroll
                for (int s = 0; s < 4; ++s)
#pragma unroll
                    for (int nt = 0; nt < 8; ++nt) acc[nt] = MFMA16(frag_tr(B0, lane, nt, s), wf[s], acc[nt]);
                bf16* yrow = Y + (size_t)(t0 + l) * D + h * 128;
#pragma unroll
                for (int nt = 0; nt < 8; ++nt) {
                    const int d0 = 16 * nt + 4 * g;
                    v2u w; w.x = pk2(bflo(u2[nt].x) * (acc[nt][0] + bias), bfhi(u2[nt].x) * (acc[nt][1] + bias)); w.y = pk2(bflo(u2[nt].y) * (acc[nt][2] + bias), bfhi(u2[nt].y) * (acc[nt][3] + bias));
                    *(v2u*)(yrow + d0) = w;
                }
            }
            {
                f32x4 af[8], ab[8];
#pragma unroll
                for (int nt = 0; nt < 8; ++nt) { af[nt] = (f32x4){0.f, 0.f, 0.f, 0.f}; ab[nt] = (f32x4){0.f, 0.f, 0.f, 0.f}; }
#pragma unroll
                for (int s = 0; s < 4; ++s) {
                    const bf16x8 vf = frag_tr(B2, lane, wave, s), vb = frag_tr(B3, lane, wave, s);
#pragma unroll
                    for (int nt = 0; nt < 8; ++nt) { const bf16x8 kf = frag_tr(B1, lane, nt, s); af[nt] = MFMA16(kf, vf, af[nt]); ab[nt] = MFMA16(kf, vb, ab[nt]); }
                }
                const size_t u0 = (size_t)((bb * 4 + h) * 32 + cc) * 16384 + (size_t)(16 * wave + fr) * 128;
#pragma unroll
                for (int nt = 0; nt < 8; ++nt) {
                    const int dk0 = 16 * nt + 4 * g;
                    v2u w; w.x = pk2(af[nt][0], af[nt][1]); w.y = pk2(af[nt][2], af[nt][3]);
                    *(v2u*)(ST + u0 + dk0) = w;
                    w.x = pk2(ab[nt][0], ab[nt][1]); w.y = pk2(ab[nt][2], ab[nt][3]);
                    *(v2u*)(ST + (size_t)1024 * 16384 + u0 + dk0) = w;
                }
            }
            __syncthreads();
        }
#undef P2_CK
#undef P2_ISSUE
#undef LDG16
    }

#endif
    GRID_BAR(2);

    if constexpr (IN(3)) for (int rep_ = 0; rep_ < REP3; ++rep_) {
        PHASE_COORDS
        for (size_t v = gt; v < (size_t)2 * 32 * 2048; v += ngt) {
            const int dir = (int)(v >> 16), bh = (int)((v >> 11) & 31), e8 = (int)(v & 2047), h = bh & 3;
            const float lg = log_sigmoid_f(dir == 0 ? args.in[6][h] : args.in[7][h]);
            const float Gc = expf(128.0f * lg);
            const size_t base = ((size_t)dir * 1024 + bh * 32) * 16384 + (size_t)e8 * 8;
            float st[8];
#pragma unroll
            for (int j = 0; j < 8; ++j) st[j] = 0.f;
#pragma unroll 1
            for (int half = 0; half < 2; ++half) {
                v4u sv[16];
#pragma unroll
                for (int k = 0; k < 16; ++k) { const int ci = half * 16 + k, c = (dir == 0) ? ci : 31 - ci; sv[k] = *(const v4u*)(ST + base + (size_t)c * 16384); }
#pragma unroll
                for (int k = 0; k < 16; ++k) {
                    const int ci = half * 16 + k, c = (dir == 0) ? ci : 31 - ci;
                    v4u o; o.x = pk2(st[0], st[1]); o.y = pk2(st[2], st[3]); o.z = pk2(st[4], st[5]); o.w = pk2(st[6], st[7]);
                    *(v4u*)(PREV + base + (size_t)c * 16384) = o;
                    const v4u s4 = sv[k];
                    st[0] = Gc * st[0] + bflo(s4.x); st[1] = Gc * st[1] + bfhi(s4.x); st[2] = Gc * st[2] + bflo(s4.y); st[3] = Gc * st[3] + bfhi(s4.y);
                    st[4] = Gc * st[4] + bflo(s4.z); st[5] = Gc * st[5] + bfhi(s4.z); st[6] = Gc * st[6] + bflo(s4.w); st[7] = Gc * st[7] + bfhi(s4.w);
                }
            }
        }
    }
    GRID_BAR(3);

#if NAIVE_P4
    if constexpr (IN(4)) for (int rep_ = 0; rep_ < REP4; ++rep_) {
        PHASE_COORDS
        const float* gnw = args.in[8];
        for (int ck = bx; ck < NCHUNK; ck += G) {
            const int t0 = ck * 128, bb = ck >> 5, cc = ck & 31;
#pragma unroll 1
            for (int h = 0; h < 4; ++h) {
                const float lgf = log_sigmoid_f(args.in[6][h]), lgb = log_sigmoid_f(args.in[7][h]);
                LAS float* A0 = sm;
                LAS float* A1 = sm + 16384;
                for (int i = tid; i < 16384; i += NTHREADS) {
                    const int l = i >> 7, d = i & 127;
                    A0[i] = bf2f(PROJ[(size_t)(t0 + l) * INW + 1024 + h * 128 + d]);
                    A1[l * 129 + d] = bf2f(PROJ[(size_t)(t0 + l) * INW + 1536 + h * 128 + d]);
                }
                LAS float* qwt = sm + 32896;
                if (tid < 128) { qwt[tid] = expf((float)(tid + 1) * lgf); qwt[128 + tid] = expf((float)(128 - tid) * lgb); qwt[256 + tid] = expf((float)tid * lgf); qwt[384 + tid] = expf((float)tid * lgb); }
                __syncthreads();
                const int c0 = tid & 127, lg4 = tid >> 7;
                float acc[32];
#pragma unroll
                for (int li = 0; li < 32; ++li) acc[li] = 0.f;
#pragma unroll 1
                for (int d = 0; d < 128; ++d) {
                    const float kv = A1[c0 * 129 + d];
#pragma unroll
                    for (int li = 0; li < 32; ++li) acc[li] += A0[(lg4 * 32 + li) * 128 + d] * kv;
                }
                __syncthreads();
#pragma unroll
                for (int li = 0; li < 32; ++li) {
                    const int l = lg4 * 32 + li, m = c0;
                    const float dec = (m <= l) ? qwt[256 + l - m] : qwt[384 + m - l];
                    A0[l * 128 + m] = acc[li] * dec;
                }
                for (int i = tid; i < 16384; i += NTHREADS) {
                    const int l = i >> 7, d = i & 127;
                    A1[l * 129 + d] = bf2f(PROJ[(size_t)(t0 + l) * INW + 2048 + h * 128 + d]);
                }
                __syncthreads();
                float o[32];
#pragma unroll
                for (int li = 0; li < 32; ++li) o[li] = 0.f;
#pragma unroll 1
                for (int m = 0; m < 128; ++m) {
                    const float vv = A1[m * 129 + c0];
#pragma unroll
                    for (int li = 0; li < 32; ++li) o[li] += A0[(lg4 * 32 + li) * 128 + m] * vv;
                }
                __syncthreads();
#pragma unroll 1
                for (int dir = 0; dir < 2; ++dir) {
                    const size_t u0 = ((size_t)dir * 1024 + (bb * 4 + h) * 32 + cc) * 16384;
                    __syncthreads();
                    for (int i = tid; i < 16384; i += NTHREADS) {
                        const int l = i >> 7, d = i & 127;
                        A0[i] = qwt[dir * 128 + l] * bf2f(PROJ[(size_t)(t0 + l) * INW + 1024 + h * 128 + d]);
                        A1[l * 129 + d] = bf2f(PREV[u0 + i]);
                    }
                    __syncthreads();
#pragma unroll 1
                    for (int dk = 0; dk < 128; ++dk) {
                        const float pv = A1[c0 * 129 + dk];
#pragma unroll
                        for (int li = 0; li < 32; ++li) o[li] += A0[(lg4 * 32 + li) * 128 + dk] * pv;
                    }
                }
                __syncthreads();
#pragma unroll
                for (int li = 0; li < 32; ++li) A0[(lg4 * 32 + li) * 128 + c0] = o[li];
                __syncthreads();
                for (int r = wave * 16; r < wave * 16 + 16; ++r) {
                    const float a = A0[r * 128 + lane], b = A0[r * 128 + 64 + lane];
                    const float mean = wave_sum(a + b) * (1.0f / 128.0f);
                    const float da = a - mean, db = b - mean;
                    const float rstd = 1.0f / sqrtf(wave_sum(da * da + db * db) * (1.0f / 128.0f) + GN_EPS);
                    const size_t prow = (size_t)(t0 + r) * INW + 2560 + h * 128;
                    const float ga = bf2f(PROJ[prow + lane]), gb = bf2f(PROJ[prow + 64 + lane]);
                    Y[(size_t)(t0 + r) * D + 512 + h * 128 + lane] = (bf16)f2bf(da * rstd * gnw[h * 128 + lane] * ga);
                    Y[(size_t)(t0 + r) * D + 512 + h * 128 + 64 + lane] = (bf16)f2bf(db * rstd * gnw[h * 128 + 64 + lane] * gb);
                }
                __syncthreads();
            }
        }
    }

#else
    if constexpr (IN(4)) for (int rep_ = 0; rep_ < REP4; ++rep_) {
        PHASE_COORDS
        const float* gnw = args.in[8];
        LAS unsigned char* B0 = lds; LAS unsigned char* B1 = lds + 32768; LAS unsigned char* B2 = lds + 65536; LAS unsigned char* B3 = lds + 98304;
        const int g = lane >> 4, fr = lane & 15;
        const int nunit = ((NCHUNK - bx + G - 1) / G) * 4;
        v4u qk[8];
        unsigned gofP[4], gofR[4], lof[4];
#pragma unroll
        for (int i = 0; i < 4; ++i) { const int c_ = tid + NTHREADS * i, row_ = c_ >> 4, ch_ = c_ & 15; gofP[i] = (unsigned)(row_ * INW + ch_ * 8) * 2u; gofR[i] = (unsigned)(row_ * 128 + ch_ * 8) * 2u; lof[i] = off_b(row_, ch_); }
#define P4_CK(n) (bx + G * ((n) >> 2))
#define LDG16(base, off) (*(const v4u*)((const char*)(base) + (off)))
#define P4_ISSUE_QK(n) do { const bf16* pr_ = PROJ + (size_t)(P4_CK(n) * 128) * INW + ((n) & 3) * 128; \
            _Pragma("unroll") for (int i = 0; i < 4; ++i) { qk[i] = LDG16(pr_ + 1024, gofP[i]); qk[4 + i] = LDG16(pr_ + 1536, gofP[i]); } } while (0)
        if (nunit > 0) P4_ISSUE_QK(0);
#pragma unroll 1
        for (int n = 0; n < nunit; ++n) {
            const int ck = P4_CK(n), h = n & 3;
            const int t0 = ck * 128, bb = ck >> 5, cc = ck & 31;
            const float lf2 = log_sigmoid_f(args.in[6][h]) * 1.4426950408889634f, lb2 = log_sigmoid_f(args.in[7][h]) * 1.4426950408889634f;
            const bf16* prow = PROJ + (size_t)t0 * INW + h * 128;
#pragma unroll
            for (int i = 0; i < 4; ++i) { *(LAS v4u*)(B0 + lof[i]) = qk[i]; *(LAS v4u*)(B1 + lof[i]) = qk[4 + i]; }
            v4u vpp[12];
            {
                const bf16* pf_ = PREV + (size_t)((bb * 4 + h) * 32 + cc) * 16384;
#pragma unroll
                for (int i = 0; i < 4; ++i) { vpp[i] = LDG16(prow + 2048, gofP[i]); vpp[4 + i] = LDG16(pf_, gofR[i]); vpp[8 + i] = LDG16(pf_ + (size_t)1024 * 16384, gofR[i]); }
            }
            __syncthreads();
            bf16x8 qf[4];
#pragma unroll
            for (int s = 0; s < 4; ++s) qf[s] = frag_row(B0, lane, wave, s);
            const int l = 16 * wave + fr;
            v2u pw[8];
            {
                f32x4 sacc[8];
#pragma unroll
                for (int nt = 0; nt < 8; ++nt) sacc[nt] = (f32x4){0.f, 0.f, 0.f, 0.f};
#pragma unroll
                for (int nt = 0; nt < 8; ++nt)
                { _Pragma("unroll") for (int s = 0; s < 4; ++s) sacc[nt] = MFMA16(frag_row(B1, lane, nt, s), qf[s], sacc[nt]);
                  if ((nt & 1) == 1) __builtin_amdgcn_sched_barrier(0); }
#pragma unroll
                for (int nt = 0; nt < 8; ++nt) {
                    const int m0 = 16 * nt + 4 * g;
                    float p[4];
#pragma unroll
                    for (int r = 0; r < 4; ++r) { const int m = m0 + r; p[r] = sacc[nt][r] * __builtin_amdgcn_exp2f((float)(l - m) * ((m <= l) ? lf2 : -lb2)); }
                    pw[nt].x = pk2(p[0], p[1]); pw[nt].y = pk2(p[2], p[3]);
                }
            }
            __syncthreads();
#pragma unroll
            for (int nt = 0; nt < 8; ++nt) *(LAS v2u*)(B1 + off_b((unsigned)l, (unsigned)(2 * nt + (g >> 1))) + 8 * (g & 1)) = pw[nt];
#pragma unroll
            for (int i = 0; i < 4; ++i) { *(LAS v4u*)(B2 + lof[i]) = vpp[i]; *(LAS v4u*)(B3 + lof[i]) = vpp[4 + i]; *(LAS v4u*)(B0 + lof[i]) = vpp[8 + i]; }
            if (n + 1 < nunit) P4_ISSUE_QK(n + 1);
            const bf16* grow = PROJ + (size_t)(t0 + l) * INW + 2560 + h * 128;
            __syncthreads();
            f32x4 o[8];
#pragma unroll
            for (int nt = 0; nt < 8; ++nt) o[nt] = (f32x4){0.f, 0.f, 0.f, 0.f};
            const float qwf = __builtin_amdgcn_exp2f((float)(l + 1) * lf2), qwb = __builtin_amdgcn_exp2f((float)(128 - l) * lb2);
#pragma unroll
            for (int nt = 0; nt < 8; ++nt)
#pragma unroll
                for (int s = 0; s < 4; ++s) o[nt] = MFMA16(frag_row(B3, lane, nt, s), qf[s], o[nt]);
            {
                const float ratio = qwf * __builtin_amdgcn_rcpf(qwb);
#pragma unroll
                for (int nt = 0; nt < 8; ++nt) o[nt] = o[nt] * ratio;
            }
#pragma unroll
            for (int nt = 0; nt < 8; ++nt)
#pragma unroll
                for (int s = 0; s < 4; ++s) o[nt] = MFMA16(frag_row(B0, lane, nt, s), qf[s], o[nt]);
#pragma unroll
            for (int nt = 0; nt < 8; ++nt) o[nt] = o[nt] * qwb;
#pragma unroll
            for (int s = 0; s < 4; ++s) {
                const bf16x8 pf = frag_row(B1, lane, wave, s);
#pragma unroll
                for (int nt = 0; nt < 8; ++nt) o[nt] = MFMA16(frag_tr(B2, lane, nt, s), pf, o[nt]);
            }
            float sum = 0.f;
#pragma unroll
            for (int nt = 0; nt < 8; ++nt) sum += (o[nt][0] + o[nt][1]) + (o[nt][2] + o[nt][3]);
            sum += __shfl_xor(sum, 16); sum += __shfl_xor(sum, 32);
            const float mean = sum * (1.0f / 128.0f);
            float sq = 0.f;
#pragma unroll
            for (int nt = 0; nt < 8; ++nt) { o[nt] = o[nt] - mean; sq += (o[nt][0] * o[nt][0] + o[nt][1] * o[nt][1]) + (o[nt][2] * o[nt][2] + o[nt][3] * o[nt][3]); }
            sq += __shfl_xor(sq, 16); sq += __shfl_xor(sq, 32);
            const float rstd = 1.0f / sqrtf(sq * (1.0f / 128.0f) + GN_EPS);
            bf16* yrow = Y + (size_t)(t0 + l) * D + 512 + h * 128;
#pragma unroll
            for (int nt = 0; nt < 8; ++nt) {
                const int dv0 = 16 * nt + 4 * g;
                const f32x4 gn = *(const f32x4*)(gnw + h * 128 + dv0);
                const v2u gt2 = *(const v2u*)(grow + dv0);
                v2u w; w.x = pk2(o[nt][0] * rstd * gn[0] * bflo(gt2.x), o[nt][1] * rstd * gn[1] * bfhi(gt2.x));
                w.y = pk2(o[nt][2] * rstd * gn[2] * bflo(gt2.y), o[nt][3] * rstd * gn[3] * bfhi(gt2.y));
                *(v2u*)(yrow + dv0) = w;
            }
            __syncthreads();
        }
#undef P4_CK
#undef P4_ISSUE_QK
#undef LDG16
    }

#endif
    GRID_BAR(4);

    if constexpr (IN(5)) for (int rep_ = 0; rep_ < REP5; ++rep_) {
        PHASE_COORDS
        pg8::Gemm g{Y, WOUT, M, D, D}; pg8::StaticOrder S; S.init(M, D, G, bx);
        pg8::EpiResBf16 E{XB, Z, D, ALPHA};
        pg8::gemm_phase<pg8::EpiResBf16, pg8::StaticOrder, true, true>(lds, g, S, E);
    }

    GRID_BAR(5);

    if constexpr (IN(6)) for (int rep_ = 0; rep_ < REP6; ++rep_) {
        PHASE_COORDS
        const float* w = args.in[10]; const float* b = args.in[11];
        for (int tb = gw * 2; tb < M; tb += NGW * 2) {
            f32x4 v[2][4]; float s_[2], q_[2], mx_[2];
#pragma unroll
            for (int u = 0; u < 2; ++u) {
                const v2u* zr = (const v2u*)(Z + (size_t)(tb + u) * D) + lane;
#pragma unroll
                for (int j = 0; j < 4; ++j) { const v2u w_ = zr[64 * j]; v[u][j] = (f32x4){bflo(w_.x), bfhi(w_.x), bflo(w_.y), bfhi(w_.y)}; }
            }
#pragma unroll
            for (int u = 0; u < 2; ++u) { s_[u] = 0.f;
#pragma unroll
                for (int j = 0; j < 4; ++j) s_[u] += (v[u][j][0] + v[u][j][1]) + (v[u][j][2] + v[u][j][3]); }
#pragma unroll
            for (int o = 1; o < 64; o <<= 1) { s_[0] += __shfl_xor(s_[0], o); s_[1] += __shfl_xor(s_[1], o); }
#pragma unroll
            for (int u = 0; u < 2; ++u) { const float mean = s_[u] * (1.0f / D); q_[u] = 0.f;
#pragma unroll
                for (int j = 0; j < 4; ++j) { v[u][j] = v[u][j] - mean; q_[u] += (v[u][j][0] * v[u][j][0] + v[u][j][1] * v[u][j][1]) + (v[u][j][2] * v[u][j][2] + v[u][j][3] * v[u][j][3]); } }
#pragma unroll
            for (int o = 1; o < 64; o <<= 1) { q_[0] += __shfl_xor(q_[0], o); q_[1] += __shfl_xor(q_[1], o); }
#pragma unroll
            for (int u = 0; u < 2; ++u) {
                const float rstd = 1.0f / sqrtf(q_[u] * (1.0f / D) + LN_EPS);
                unsigned long long* o8 = (unsigned long long*)(H + (size_t)(tb + u) * D) + lane;
                mx_[u] = 0.f;
#pragma unroll
                for (int j = 0; j < 4; ++j) {
                    const f32x4 wv = *((const f32x4*)w + lane + 64 * j), bv = *((const f32x4*)b + lane + 64 * j);
                    const f32x4 y = v[u][j] * rstd * wv + bv;
                    o8[64 * j] = (unsigned long long)pk2(y[0], y[1]) | ((unsigned long long)pk2(y[2], y[3]) << 32);
                    v[u][j] = y;
                    mx_[u] = fmaxf(mx_[u], fmaxf(fmaxf(fabsf(y[0]), fabsf(y[1])), fmaxf(fabsf(y[2]), fabsf(y[3]))));
                }
            }
#pragma unroll
            for (int o = 1; o < 64; o <<= 1) { mx_[0] = fmaxf(mx_[0], __shfl_xor(mx_[0], o)); mx_[1] = fmaxf(mx_[1], __shfl_xor(mx_[1], o)); }
#pragma unroll
            for (int u = 0; u < 2; ++u) {
                const int t = tb + u;
                const float inv = mx_[u] > 0.f ? 127.0f / mx_[u] : 0.f;
#pragma unroll
                for (int j = 0; j < 4; ++j) {
                    const int q0 = (int)rintf(v[u][j][0] * inv), q1 = (int)rintf(v[u][j][1] * inv), q2 = (int)rintf(v[u][j][2] * inv), q3 = (int)rintf(v[u][j][3] * inv);
                    *(unsigned*)(H8 + ((size_t)(2 * j + (lane >> 5)) * M + t) * 128 + 4 * (lane & 31)) = (unsigned)(q0 & 0xff) | ((unsigned)(q1 & 0xff) << 8) | ((unsigned)(q2 & 0xff) << 16) | ((unsigned)(q3 & 0xff) << 24);
                }
                if (lane == 0) SH[t] = mx_[u] * (1.0f / 127.0f);
            }
        }
    }
    GRID_BAR(6);

    if constexpr (IN(7)) for (int rep_ = 0; rep_ < REP7; ++rep_) {
        PHASE_COORDS
        pg8::Gemm g{H, WQ, M, 2048, D}; pg8::StaticOrder S; S.init(M, 2048, G, bx);
        pg8::EpiPlainBf16 E{QP, 2048};
        pg8::gemm_phase<pg8::EpiPlainBf16, pg8::StaticOrder, true, true>(lds, g, S, E);
    }

    GRID_BAR(7);

#if NAIVE_P8
    if constexpr (IN(8)) for (int rep_ = 0; rep_ < REP8; ++rep_) {
        PHASE_COORDS
        const float* keys = args.in[13];
        LAS float* qs = sm;
        LAS float* sc = sm + 64 * 257;
        for (int unit = bx; unit < (M / 64) * PEER_H; unit += G) {
            const int tt0 = (unit >> 3) * 64, hd = unit & 7;
            for (int i = tid; i < 64 * 256; i += NTHREADS) { const int r = i >> 8, c = i & 255; qs[r * 257 + c] = bf2f(QP[(size_t)(tt0 + r) * 2048 + hd * 256 + c]); }
            __syncthreads();
            {
                const int tt = tid & 63, g8 = __builtin_amdgcn_readfirstlane(tid >> 6);
                for (int p = 0; p < 2; ++p) {
                    float acc[16];
#pragma unroll
                    for (int j = 0; j < 16; ++j) acc[j] = 0.f;
                    const float* kp = keys + ((size_t)(hd * 2 + p) * 128 + g8 * 16) * 128;
                    for (int d = 0; d < 128; ++d) {
                        const float qv = qs[tt * 257 + p * 128 + d];
#pragma unroll
                        for (int j = 0; j < 16; ++j) acc[j] += qv * kp[j * 128 + d];
                    }
#pragma unroll
                    for (int j = 0; j < 16; ++j) sc[tt * 257 + p * 128 + g8 * 16 + j] = acc[j];
                }
            }
            __syncthreads();
            LAS float* tops = qs;
            LAS int* topi = (LAS int*)(qs + 2048);
            LAS float* bsc = qs + 4096;
            LAS int* bps = (LAS int*)(qs + 5120);
            if (tid < 128) {
                const int tt = tid & 63, p = tid >> 6;
                LAS float* row = sc + tt * 257 + p * 128;
                for (int r = 0; r < 16; ++r) {
                    float best = -INFINITY; int bi = 0;
                    for (int n = 0; n < 128; ++n) { const float v = row[n]; if (v > best) { best = v; bi = n; } }
                    row[bi] = -INFINITY;
                    tops[(tt * 2 + p) * 16 + r] = best; topi[(tt * 2 + p) * 16 + r] = bi;
                }
            }
            __syncthreads();
            if (tid < 64) {
                const int tt = tid;
                LAS float* cand = sc + tt * 257;
                for (int a = 0; a < 16; ++a) for (int b = 0; b < 16; ++b) cand[a * 16 + b] = tops[(tt * 2) * 16 + a] + tops[(tt * 2 + 1) * 16 + b];
                float mx = -INFINITY;
                for (int r = 0; r < 16; ++r) {
                    float best = -INFINITY; int bi = 0;
                    for (int n = 0; n < 256; ++n) { const float v = cand[n]; if (v > best) { best = v; bi = n; } }
                    cand[bi] = -INFINITY;
                    bsc[tt * 16 + r] = best; bps[tt * 16 + r] = bi;
                    if (r == 0) mx = best;
                }
                float den = 0.f;
                for (int r = 0; r < 16; ++r) den += expf(bsc[tt * 16 + r] - mx);
                const float rden = 1.0f / den;
                for (int r = 0; r < 16; ++r) {
                    const int pos = bps[tt * 16 + r], a = pos >> 4, b = pos & 15;
                    const int e = topi[(tt * 2) * 16 + a] * 128 + topi[(tt * 2 + 1) * 16 + b];
                    IDX[(size_t)(tt0 + tt) * NSEL + hd * 16 + r] = (unsigned short)e;
                    GATE[(size_t)(tt0 + tt) * NSEL + hd * 16 + r] = expf(bsc[tt * 16 + r] - mx) * rden;
                }
            }
            __syncthreads();
        }
    }

#else
    if constexpr (IN(8)) for (int rep_ = 0; rep_ < REP8; ++rep_) {
        PHASE_COORDS
        LAS unsigned char* K0 = lds; LAS unsigned char* K1 = lds + 32768;
        const int g = lane >> 4, fr = lane & 15;
        int cur_hd = -1;
        bf16x8 qnext[2][4];
        {
            const int un = (bx < (M / 128) * PEER_H) ? bx : 0;
            const bf16* qp_ = QP + (size_t)((un >> 3) * 128 + 16 * wave + fr) * 2048 + (un & 7) * 256 + 8 * g;
#pragma unroll
            for (int p = 0; p < 2; ++p)
#pragma unroll
                for (int s = 0; s < 4; ++s) qnext[p][s] = *(const bf16x8*)(qp_ + p * 128 + 32 * s);
        }
        for (int unit = bx; unit < (M / 128) * PEER_H; unit += G) {
            const int hd = unit & 7, tile = unit >> 3;
            if (hd != cur_hd) {
                __syncthreads();
                stage_tile(K0, SKB + (size_t)(hd * 2 + 0) * 16384, 128, tid);
                stage_tile(K1, SKB + (size_t)(hd * 2 + 1) * 16384, 128, tid);
                __syncthreads();
                cur_hd = hd;
            }
            const int t = tile * 128 + 16 * wave + fr;
            bf16x8 qcur[2][4];
#pragma unroll
            for (int p = 0; p < 2; ++p)
#pragma unroll
                for (int s = 0; s < 4; ++s) qcur[p][s] = qnext[p][s];
            {
                const int un = (unit + G < (M / 128) * PEER_H) ? unit + G : unit;
                const bf16* qp_ = QP + (size_t)((un >> 3) * 128 + 16 * wave + fr) * 2048 + (un & 7) * 256 + 8 * g;
#pragma unroll
                for (int p = 0; p < 2; ++p)
#pragma unroll
                    for (int s = 0; s < 4; ++s) qnext[p][s] = *(const bf16x8*)(qp_ + p * 128 + 32 * s);
            }
            int T[2][16];
#pragma unroll
            for (int p = 0; p < 2; ++p) {
                const LAS unsigned char* KT = p ? K1 : K0;
                bf16x8 qf[4];
#pragma unroll
                for (int s = 0; s < 4; ++s) qf[s] = qcur[p][s];
                f32x4 acc[8];
#pragma unroll
                for (int nt = 0; nt < 8; ++nt) acc[nt] = (f32x4){0.f, 0.f, 0.f, 0.f};
#pragma unroll
                for (int nt = 0; nt < 8; ++nt)
#pragma unroll
                    for (int s = 0; s < 4; ++s) acc[nt] = MFMA16(frag_row(KT, lane, nt, s), qf[s], acc[nt]);
                int A[16], Bk[16];
#pragma unroll
                for (int nt = 0; nt < 4; ++nt)
#pragma unroll
                    for (int r = 0; r < 4; ++r) { A[nt * 4 + r] = f2key(acc[nt][r], 16 * nt + 4 * g + r); Bk[nt * 4 + r] = f2key(acc[nt + 4][r], 16 * (nt + 4) + 4 * g + r); }
                sort16_desc(A); sort16_desc(Bk);
#pragma unroll
                for (int i = 0; i < 16; ++i) A[i] = max(A[i], Bk[15 - i]);
                merge16_desc(A);
#pragma unroll
                for (int mask = 16; mask <= 32; mask <<= 1) {
                    int P[16];
#pragma unroll
                    for (int i = 0; i < 16; ++i) P[i] = __shfl_xor(A[15 - i], mask);
#pragma unroll
                    for (int i = 0; i < 16; ++i) A[i] = max(A[i], P[i]);
                    merge16_desc(A);
                }
#pragma unroll
                for (int i = 0; i < 16; ++i) T[p][i] = A[i];
            }
            float F0[16], F1[16];
#pragma unroll
            for (int i = 0; i < 16; ++i) { F0[i] = key2f(T[0][i]); F1[i] = key2f(T[1][i]); }
            int C[16];
#pragma unroll
            for (int j = 0; j < 16; ++j) {
                constexpr int a2[16] = {2, 2, 2, 2, 2, 3, 3, 3, 3, 4, 4, 4, 5, 5, 6, 6}, b2[16] = {0, 1, 2, 3, 4, 0, 1, 2, 3, 0, 1, 2, 0, 1, 0, 1};
                const int a1 = (j < 8) ? 1 : j, b1 = (j < 8) ? j : 0;
                const float s0 = F0[0] + F1[j], s1 = F0[a1] + F1[b1], s2 = F0[a2[j]] + F1[b2[j]];
                const int k0 = f2key(s0, j), k1 = f2key(s1, a1 * 16 + b1), k2 = f2key(s2, a2[j] * 16 + b2[j]);
                const int k3 = (j < 2) ? f2key(F0[7] + F1[j], 7 * 16 + j) : (int)0x80000000;
                C[j] = (g == 0) ? k0 : (g == 1) ? k1 : (g == 2) ? k2 : k3;
            }
            sort16_desc(C);
#pragma unroll
            for (int mask = 16; mask <= 32; mask <<= 1) {
                int P[16];
#pragma unroll
                for (int i = 0; i < 16; ++i) P[i] = __shfl_xor(C[15 - i], mask);
#pragma unroll
                for (int i = 0; i < 16; ++i) C[i] = max(C[i], P[i]);
                merge16_desc(C);
            }
            const float mx = key2f(C[0]);
            int kk[4];
#pragma unroll
            for (int k = 0; k < 4; ++k) kk[k] = (g == 0) ? C[k] : (g == 1) ? C[4 + k] : (g == 2) ? C[8 + k] : C[12 + k];
            unsigned pk0[4], pk1[4];
#pragma unroll
            for (int q = 0; q < 4; ++q) {
                pk0[q] = (unsigned)(T[0][4 * q] & 0x7F) | ((unsigned)(T[0][4 * q + 1] & 0x7F) << 8) | ((unsigned)(T[0][4 * q + 2] & 0x7F) << 16) | ((unsigned)(T[0][4 * q + 3] & 0x7F) << 24);
                pk1[q] = (unsigned)(T[1][4 * q] & 0x7F) | ((unsigned)(T[1][4 * q + 1] & 0x7F) << 8) | ((unsigned)(T[1][4 * q + 2] & 0x7F) << 16) | ((unsigned)(T[1][4 * q + 3] & 0x7F) << 24);
            }
            float ev[4]; int ex[4]; float part = 0.f;
#pragma unroll
            for (int k = 0; k < 4; ++k) {
                ev[k] = __expf(key2f(kk[k]) - mx); part += ev[k];
                const int a = (kk[k] >> 4) & 15, b = kk[k] & 15;
                const unsigned w0 = (a >> 2) == 0 ? pk0[0] : (a >> 2) == 1 ? pk0[1] : (a >> 2) == 2 ? pk0[2] : pk0[3];
                const unsigned w1 = (b >> 2) == 0 ? pk1[0] : (b >> 2) == 1 ? pk1[1] : (b >> 2) == 2 ? pk1[2] : pk1[3];
                ex[k] = (int)(((w0 >> (8 * (a & 3))) & 0xFFu) * 128u + ((w1 >> (8 * (b & 3))) & 0xFFu));
            }
            part += __shfl_xor(part, 16); part += __shfl_xor(part, 32);
            const float rden = 1.0f / part;
            *(v2u*)(IDX + (size_t)t * NSEL + hd * 16 + 4 * g) = (v2u){(unsigned)ex[0] | ((unsigned)ex[1] << 16), (unsigned)ex[2] | ((unsigned)ex[3] << 16)};
            *(f32x4*)(GATE + (size_t)t * NSEL + hd * 16 + 4 * g) = (f32x4){ev[0] * rden, ev[1] * rden, ev[2] * rden, ev[3] * rden};
        }
    }

#endif
    GRID_BAR(8);

    if constexpr (IN(9)) for (int rep_ = 0; rep_ < REP9; ++rep_) {
        PHASE_COORDS
        const bool fast = (G & 7) == 0;
        const int nq = fast ? (G >> 3) * NWAVES : NGW, q0 = fast ? (bx >> 3) * NWAVES + wave : gw;
        const long ntask = fast ? (long)M : 8L * M;
        const int c = lane & 7, pg = lane >> 3;
        for (long task = q0; task < ntask; task += nq) {
            const int t = fast ? (int)task : (int)(task >> 3), x = fast ? (bx & 7) : (int)(task & 7);
            const v4u* ip = (const v4u*)(IDX + (size_t)t * NSEL + 16 * pg);
            const v4u e0 = ip[0], e1 = ip[1];
            const unsigned ee[16] = {e0.x & 0xffffu, e0.x >> 16, e0.y & 0xffffu, e0.y >> 16, e0.z & 0xffffu, e0.z >> 16, e0.w & 0xffffu, e0.w >> 16,
                                     e1.x & 0xffffu, e1.x >> 16, e1.y & 0xffffu, e1.y >> 16, e1.z & 0xffffu, e1.z >> 16, e1.w & 0xffffu, e1.w >> 16};
            const v4u hq = *(const v4u*)(H8 + ((size_t)x * M + t) * 128 + 16 * c);
            const unsigned char* ub = U8 + (size_t)x * NEXP * 128 + 16 * c;
            v4u rows[16];
#pragma unroll
            for (int i = 0; i < 16; ++i) rows[i] = *(const v4u*)(ub + (size_t)ee[i] * 128);
            int acc[16];
#pragma unroll
            for (int i = 0; i < 16; ++i) {
                int a = __builtin_amdgcn_sdot4((int)rows[i].x, (int)hq.x, 0, false);
                a = __builtin_amdgcn_sdot4((int)rows[i].y, (int)hq.y, a, false);
                a = __builtin_amdgcn_sdot4((int)rows[i].z, (int)hq.z, a, false);
                a = __builtin_amdgcn_sdot4((int)rows[i].w, (int)hq.w, a, false);
                a += __shfl_xor(a, 1); a += __shfl_xor(a, 2); a += __shfl_xor(a, 4);
                acc[i] = a;
            }
            if (c == 0) {
                v4u* op = (v4u*)(PDOT + ((size_t)x * M + t) * NSEL + 16 * pg);
                op[0] = (v4u){pk2((float)acc[0], (float)acc[1]), pk2((float)acc[2], (float)acc[3]), pk2((float)acc[4], (float)acc[5]), pk2((float)acc[6], (float)acc[7])};
                op[1] = (v4u){pk2((float)acc[8], (float)acc[9]), pk2((float)acc[10], (float)acc[11]), pk2((float)acc[12], (float)acc[13]), pk2((float)acc[14], (float)acc[15])};
            }
        }
    }
    GRID_BAR(9);

    if constexpr (IN(10)) for (int rep_ = 0; rep_ < REP10; ++rep_) {
        PHASE_COORDS
        for (int tb = gw * 4; tb < M; tb += NGW * 4) {
            int e_[4][2]; float sacc[4][2]; float gate_[4][2], sh_[4];
#pragma unroll
            for (int u = 0; u < 4; ++u) {
                const int t = tb + u; sh_[u] = SH[t];
#pragma unroll
                for (int k = 0; k < 2; ++k) {
                    const int j = 2 * lane + k;
                    e_[u][k] = (int)IDX[(size_t)t * NSEL + j]; gate_[u][k] = GATE[(size_t)t * NSEL + j];
                    float a = 0.f;
#pragma unroll
                    for (int x = 0; x < 8; ++x) a += bf2f(PDOT[((size_t)x * M + t) * NSEL + j]);
                    sacc[u][k] = a;
                }
            }
            float su_[4][2], sv_[4][2];
#pragma unroll
            for (int u = 0; u < 4; ++u)
#pragma unroll
                for (int k = 0; k < 2; ++k) { su_[u][k] = SU[e_[u][k]]; sv_[u][k] = SV[e_[u][k]]; }
            float cp[4][2], mx[4];
#pragma unroll
            for (int u = 0; u < 4; ++u) {
                mx[u] = 0.f;
#pragma unroll
                for (int k = 0; k < 2; ++k) { const float dot = su_[u][k] * sh_[u] * sacc[u][k]; cp[u][k] = gate_[u][k] * gelu_exact(dot) * sv_[u][k]; mx[u] = fmaxf(mx[u], fabsf(cp[u][k])); }
            }
#pragma unroll
            for (int o = 1; o < 64; o <<= 1)
#pragma unroll
                for (int u = 0; u < 4; ++u) mx[u] = fmaxf(mx[u], __shfl_xor(mx[u], o));
            int qs[4];
#pragma unroll
            for (int u = 0; u < 4; ++u) {
                const int t = tb + u;
                const float inv = mx[u] > 0.f ? 32767.0f / mx[u] : 0.f;
                const int q0 = (int)rintf(cp[u][0] * inv), q1 = (int)rintf(cp[u][1] * inv);
                *(unsigned*)(CQ + (size_t)t * NSEL + 2 * lane) = ((unsigned)q0 & 0xffffu) | ((unsigned)q1 << 16);
                qs[u] = q0 + q1;
            }
#pragma unroll
            for (int o = 1; o < 64; o <<= 1)
#pragma unroll
                for (int u = 0; u < 4; ++u) qs[u] += __shfl_xor(qs[u], o);
#pragma unroll
            for (int u = 0; u < 4; ++u) if (lane == u) { CS[2 * (tb + u)] = mx[u] * (1.0f / 32767.0f); CS[2 * (tb + u) + 1] = (float)qs[u]; }
        }
    }
    GRID_BAR(10);

    if constexpr (IN(11)) for (int rep_ = 0; rep_ < REP11; ++rep_) {
        PHASE_COORDS
        const bool fast = (G & 7) == 0;
        const int nq = fast ? (G >> 3) * NWAVES : NGW, q0 = fast ? (bx >> 3) * NWAVES + wave : gw;
        const long ntask = fast ? (long)M : 8L * M;
        const int c = lane & 7, pg = lane >> 3;
        const int d0 = 8 * ((lane >> 5) & 1) + 4 * ((lane >> 4) & 1) + 2 * ((lane >> 3) & 1);
        typedef short s16x2 __attribute__((ext_vector_type(2)));
        typedef float f32x2 __attribute__((ext_vector_type(2)));
        for (long task = q0; task < ntask; task += nq) {
            const int t = fast ? (int)task : (int)(task >> 3), x = fast ? (bx & 7) : (int)(task & 7);
            const v4u* ip = (const v4u*)(IDX + (size_t)t * NSEL + 16 * pg);
            const v4u e0 = ip[0], e1 = ip[1];
            const unsigned ee[16] = {e0.x & 0xffffu, e0.x >> 16, e0.y & 0xffffu, e0.y >> 16, e0.z & 0xffffu, e0.z >> 16, e0.w & 0xffffu, e0.w >> 16,
                                     e1.x & 0xffffu, e1.x >> 16, e1.y & 0xffffu, e1.y >> 16, e1.z & 0xffffu, e1.z >> 16, e1.w & 0xffffu, e1.w >> 16};
            const v4u* qp = (const v4u*)(CQ + (size_t)t * NSEL + 16 * pg);
            const v4u cq0 = qp[0], cq1 = qp[1];
            const unsigned cqp[8] = {cq0.x, cq0.y, cq0.z, cq0.w, cq1.x, cq1.y, cq1.z, cq1.w};
            const f32x2 cs2 = *(const f32x2*)(CS + 2 * (size_t)t);
            const int col = 128 * x + 16 * c + d0;
            const unsigned hw = *(const unsigned*)(H + (size_t)t * D + col);
            const unsigned char* vb = V8 + (size_t)x * NEXP * 128 + 16 * c;
            v4u rows[16];
#pragma unroll
            for (int i = 0; i < 16; ++i) rows[i] = *(const v4u*)(vb + (size_t)ee[i] * 128);
            int acc[16];
#pragma unroll
            for (int d = 0; d < 16; ++d) acc[d] = 0;
#pragma unroll
            for (int i = 0; i < 16; i += 2) {
                const unsigned ra[4] = {rows[i].x, rows[i].y, rows[i].z, rows[i].w}, rb[4] = {rows[i + 1].x, rows[i + 1].y, rows[i + 1].z, rows[i + 1].w};
                const s16x2 cpair = __builtin_bit_cast(s16x2, cqp[i >> 1]);
#pragma unroll
                for (int k = 0; k < 4; ++k) {
                    acc[4 * k + 0] = __builtin_amdgcn_sdot2(__builtin_bit_cast(s16x2, __builtin_amdgcn_perm(rb[k], ra[k], 0x0C040C00u)), cpair, acc[4 * k + 0], false);
                    acc[4 * k + 1] = __builtin_amdgcn_sdot2(__builtin_bit_cast(s16x2, __builtin_amdgcn_perm(rb[k], ra[k], 0x0C050C01u)), cpair, acc[4 * k + 1], false);
                    acc[4 * k + 2] = __builtin_amdgcn_sdot2(__builtin_bit_cast(s16x2, __builtin_amdgcn_perm(rb[k], ra[k], 0x0C060C02u)), cpair, acc[4 * k + 2], false);
                    acc[4 * k + 3] = __builtin_amdgcn_sdot2(__builtin_bit_cast(s16x2, __builtin_amdgcn_perm(rb[k], ra[k], 0x0C070C03u)), cpair, acc[4 * k + 3], false);
                }
            }
            int r8[8], r4[4], r2[2];
            {
                const bool hi = (lane & 32) != 0;
#pragma unroll
                for (int k = 0; k < 8; ++k) { const int keep = hi ? acc[8 + k] : acc[k], send = hi ? acc[k] : acc[8 + k]; r8[k] = keep + __shfl_xor(send, 32); }
            }
            {
                const bool hi = (lane & 16) != 0;
#pragma unroll
                for (int k = 0; k < 4; ++k) { const int keep = hi ? r8[4 + k] : r8[k], send = hi ? r8[k] : r8[4 + k]; r4[k] = keep + __shfl_xor(send, 16); }
            }
            {
                const bool hi = (lane & 8) != 0;
#pragma unroll
                for (int k = 0; k < 2; ++k) { const int keep = hi ? r4[2 + k] : r4[k], send = hi ? r4[k] : r4[2 + k]; r2[k] = keep + __shfl_xor(send, 8); }
            }
            const float off = 128.0f * cs2[1];
            *(unsigned*)(ZB + (size_t)t * D + col) = pk2(ALPHA * bflo(hw) + cs2[0] * ((float)r2[0] - off), ALPHA * bfhi(hw) + cs2[0] * ((float)r2[1] - off));
        }
    }
    GRID_BAR(11);

    if constexpr (IN(12)) for (int rep_ = 0; rep_ < REP12; ++rep_) {
        PHASE_COORDS
        const float* w = args.in[16]; const float* b = args.in[17];
        for (int tb = gw * 2; tb < M; tb += NGW * 2) {
            f32x4 v[2][4]; float s_[2], q_[2];
#pragma unroll
            for (int u = 0; u < 2; ++u) {
                const v2u* zr = (const v2u*)(ZB + (size_t)(tb + u) * D) + lane;
#pragma unroll
                for (int j = 0; j < 4; ++j) { const v2u w_ = zr[64 * j]; v[u][j] = (f32x4){bflo(w_.x), bfhi(w_.x), bflo(w_.y), bfhi(w_.y)}; }
            }
#pragma unroll
            for (int u = 0; u < 2; ++u) { s_[u] = 0.f;
#pragma unroll
                for (int j = 0; j < 4; ++j) s_[u] += (v[u][j][0] + v[u][j][1]) + (v[u][j][2] + v[u][j][3]); }
#pragma unroll
            for (int o = 1; o < 64; o <<= 1) { s_[0] += __shfl_xor(s_[0], o); s_[1] += __shfl_xor(s_[1], o); }
#pragma unroll
            for (int u = 0; u < 2; ++u) { const float mean = s_[u] * (1.0f / D); q_[u] = 0.f;
#pragma unroll
                for (int j = 0; j < 4; ++j) { v[u][j] = v[u][j] - mean; q_[u] += (v[u][j][0] * v[u][j][0] + v[u][j][1] * v[u][j][1]) + (v[u][j][2] * v[u][j][2] + v[u][j][3] * v[u][j][3]); } }
#pragma unroll
            for (int o = 1; o < 64; o <<= 1) { q_[0] += __shfl_xor(q_[0], o); q_[1] += __shfl_xor(q_[1], o); }
#pragma unroll
            for (int u = 0; u < 2; ++u) {
                const float rstd = 1.0f / sqrtf(q_[u] * (1.0f / D) + LN_EPS);
                f32x4* zo = (f32x4*)(args.out + (size_t)(tb + u) * D) + lane;
#pragma unroll
                for (int j = 0; j < 4; ++j) {
                    const f32x4 wv = *((const f32x4*)w + lane + 64 * j), bv = *((const f32x4*)b + lane + 64 * j);
                    zo[64 * j] = v[u][j] * rstd * wv + bv;
                }
            }
        }
    }
#undef IN
#undef BOTH
#undef GRID_BAR
}

extern "C" void kernel_launch(void* const* d_in, const int* in_sizes, int n_in, void* d_out, int out_size, void* d_ws, size_t ws_size, hipStream_t stream) {
    static int grid = 0;
    if (grid == 0) {
        if (n_in != 18 || in_sizes[0] != M * D || out_size != M * D || ws_size < WS_END) {
            fprintf(stderr, "kernel_launch: unexpected shapes: n_in %d in0 %d out %d ws %zu\n", n_in, n_in > 0 ? in_sizes[0] : -1, out_size, ws_size); grid = -1; return; }
        int dev = 0, cus = 0;
        if (hipGetDevice(&dev) != hipSuccess || hipDeviceGetAttribute(&cus, hipDeviceAttributeMultiprocessorCount, dev) != hipSuccess) { grid = -1; return; }
        bool ok = true;
#if N_LAUNCHES == 1
        ok = (hipFuncSetAttribute((const void*)fwd_kernel<0, 13>, hipFuncAttributeMaxDynamicSharedMemorySize, LDS_BYTES) == hipSuccess);
#else
#define SETATTR(k) ok = ok && (hipFuncSetAttribute((const void*)fwd_kernel<k, k + 1>, hipFuncAttributeMaxDynamicSharedMemorySize, LDS_BYTES) == hipSuccess)
        SETATTR(0); SETATTR(1); SETATTR(2); SETATTR(3); SETATTR(4); SETATTR(5); SETATTR(6); SETATTR(7); SETATTR(8); SETATTR(9); SETATTR(10); SETATTR(11); SETATTR(12);
#undef SETATTR
#endif
        if (!ok) { fprintf(stderr, "kernel_launch: hipFuncSetAttribute failed\n"); grid = -1; return; }
        grid = cus;
    }
    if (grid < 0) return;
    (void)hipMemsetAsync((char*)d_ws + WS_CTL, 0, CTL_ZERO_BYTES, stream);
    Args a{};
    for (int i = 0; i < 18; ++i) a.in[i] = (const float*)d_in[i];
    a.out = (float*)d_out; a.ws = (unsigned char*)d_ws;
    a.ph_lo = 0; a.ph_hi = 10;
#if N_LAUNCHES == 1
    hipLaunchKernelGGL((fwd_kernel<0, 13>), dim3(grid), dim3(NTHREADS), LDS_BYTES, stream, a);
#else
#define LAUNCH(k) hipLaunchKernelGGL((fwd_kernel<k, k + 1>), dim3(grid), dim3(NTHREADS), LDS_BYTES, stream, a)
    LAUNCH(0); LAUNCH(1); LAUNCH(2); LAUNCH(3); LAUNCH(4); LAUNCH(5); LAUNCH(6); LAUNCH(7); LAUNCH(8); LAUNCH(9); LAUNCH(10); LAUNCH(11); LAUNCH(12);
#undef LAUNCH
#endif
}
```

```cpp
#include <hip/hip_runtime.h>
#include <cstdio>
#include <cstdint>
#include <cmath>
namespace pg8 {
#define PG8_LAS __attribute__((address_space(3)))
typedef unsigned short bf16_t;
typedef short bf16x8 __attribute__((ext_vector_type(8)));
typedef float f32x4 __attribute__((ext_vector_type(4)));
typedef unsigned u32x4 __attribute__((ext_vector_type(4)));
constexpr int BM = 256, BK = 64, HALF = 128, HTB = HALF * BK * 2  , STAGE_BYTES = 8 * HTB, NXCD = 8, WGM = 8;

__host__ __device__ __forceinline__ int lds_byte(int r, int c) { const int st = (r >> 4) * 2 + (c >> 5), rr = r & 15, cc = c & 31, ob = rr * 64 + cc * 2; return st * 1024 + (ob ^ (((ob >> 9) & 1) << 5)); }
__host__ __device__ __forceinline__ void stage_rc(int b, int& R, int& C) { const int st = b / 1024, sb = b % 1024, swz = sb ^ (((sb >> 9) & 1) << 5); R = (st >> 1) * 16 + swz / 64; C = (st & 1) * 32 + (swz % 64) / 2; }
__host__ __device__ __forceinline__ int perm32(int rho) { const int n = rho >> 4, i = rho & 15; return 8 * (i >> 2) + 4 * n + (i & 3); }

struct Unit { int pm, pn; };
struct Gemm { const bf16_t* A; const bf16_t* Bt; int M, N, K; };

struct StaticOrder {
    int nM, nN, nwg, G, c;
    __host__ __device__ void init(int M, int N, int G_, int c_) { nM = M / BM; nN = N / BM; nwg = nM * nN; G = G_; c = c_; }
    __host__ __device__ bool next(int i, Unit& u) const {
        const long L = (long)i * G + c; if (L >= nwg) return false;
        int wgid = (int)L; { const int q = nwg / NXCD, r = nwg % NXCD, xcd = wgid % NXCD, off = wgid / NXCD; wgid = (xcd < r ? xcd * (q + 1) : r * (q + 1) + (xcd - r) * q) + off; }
        const int nig = WGM * nN, gid = wgid / nig, fm = gid * WGM, gsz = (nM - fm) < WGM ? (nM - fm) : WGM;
        u.pm = fm + ((wgid % nig) % gsz); u.pn = (wgid % nig) / gsz; return true;
    }
    __device__ __forceinline__ void a_ready(const Unit&) const {}
    __device__ __forceinline__ void done(const Unit&) const {}
};

__device__ __forceinline__ unsigned cvt_pk_bf16(float lo, float hi) { unsigned r; asm volatile("v_cvt_pk_bf16_f32 %0, %1, %2" : "=v"(r) : "v"(lo), "v"(hi)); return r; }
typedef float f32x2 __attribute__((ext_vector_type(2)));
__device__ __forceinline__ f32x2 gelu_pk(f32x2 v) {
    const f32x2 av = __builtin_elementwise_abs(v), d = av * 0.2316418882f + 1.0f;
    f32x2 t; t.x = __builtin_amdgcn_rcpf(d.x); t.y = __builtin_amdgcn_rcpf(d.y);
    f32x2 q = t * 0.5307027145f + (-0.7265760135f); q = q * t + 0.7107068705f; q = q * t + (-0.142248368f); q = q * t + 0.127414796f; q = q * t;
    const f32x2 s = (v * v) * (-0.72134752044f);
    f32x2 e; e.x = __builtin_amdgcn_exp2f(s.x); e.y = __builtin_amdgcn_exp2f(s.y);
    const f32x2 m = v * (q * e), r = v - m;
    f32x2 o; o.x = v.x < 0.f ? m.x : r.x; o.y = v.y < 0.f ? m.y : r.y; return o;
}

__device__ __forceinline__ float silu_f(float v) { return v * __builtin_amdgcn_rcpf(1.0f + __expf(-v)); }
struct EpiProj {
    static constexpr bool PERM = true, AFTER_DRAIN = false;
    bf16_t* O; const float* rope;
    __device__ __forceinline__ void operator()(const f32x4 (&acc)[2][2][4][2], const Unit& u, int wr, int wc, int fr, int fq) const {
        const int sec = u.pn >> 1;
        const int row0 = u.pm * BM + wr * 64 + fr, col0 = u.pn * BM + wc * 32 + 8 * fq;
        const int i0 = wc * 16 + 4 * fq;
#pragma unroll
        for (int ai = 0; ai < 2; ++ai)
#pragma unroll
            for (int m = 0; m < 4; ++m) {
                const int row = row0 + ai * HALF + m * 16;
                bf16_t* rowp = O + (size_t)row * 3072 + col0;
                f32x4 r0 = (f32x4){1.f, 0.f, 1.f, 0.f}, r1 = r0;
                if (sec == 2 || sec == 3) { const f32x4* rp = (const f32x4*)(rope + ((size_t)(row & 4095) * 64 + i0) * 2); r0 = rp[0]; r1 = rp[1]; }
#pragma unroll
                for (int bj = 0; bj < 2; ++bj) {
                    f32x4 v0 = acc[ai][bj][m][0], v1 = acc[ai][bj][m][1];
                    if (sec <= 1) {
                        f32x2 a = gelu_pk((f32x2){v0[0], v0[1]}), b = gelu_pk((f32x2){v0[2], v0[3]}), c = gelu_pk((f32x2){v1[0], v1[1]}), d = gelu_pk((f32x2){v1[2], v1[3]});
                        v0 = (f32x4){a.x, a.y, b.x, b.y}; v1 = (f32x4){c.x, c.y, d.x, d.y};
                    } else if (sec <= 3) {
                        const float sc = (sec == 3) ? 0.08838834764831845f : 1.0f;
                        f32x4 w0, w1;
                        w0[0] = (v0[0] * r0[0] - v0[1] * r0[1]) * sc; w0[1] = (v0[0] * r0[1] + v0[1] * r0[0]) * sc;
                        w0[2] = (v0[2] * r0[2] - v0[3] * r0[3]) * sc; w0[3] = (v0[2] * r0[3] + v0[3] * r0[2]) * sc;
                        w1[0] = (v1[0] * r1[0] - v1[1] * r1[1]) * sc; w1[1] = (v1[0] * r1[1] + v1[1] * r1[0]) * sc;
                        w1[2] = (v1[2] * r1[2] - v1[3] * r1[3]) * sc; w1[3] = (v1[2] * r1[3] + v1[3] * r1[2]) * sc;
                        v0 = w0; v1 = w1;
                    } else if (sec == 5) {
#pragma unroll
                        for (int j = 0; j < 4; ++j) { v0[j] = silu_f(v0[j]); v1[j] = silu_f(v1[j]); }
                    }
                    u32x4 w; w.x = cvt_pk_bf16(v0[0], v0[1]); w.y = cvt_pk_bf16(v0[2], v0[3]); w.z = cvt_pk_bf16(v1[0], v1[1]); w.w = cvt_pk_bf16(v1[2], v1[3]);
                    *(u32x4*)(rowp + bj * HALF) = w;
                }
            }
    }
};
struct EpiPlainBf16 {
    static constexpr bool PERM = true, AFTER_DRAIN = false;
    bf16_t* O; int ldc;
    __device__ __forceinline__ void operator()(const f32x4 (&acc)[2][2][4][2], const Unit& u, int wr, int wc, int fr, int fq) const {
        const int row0 = u.pm * BM + wr * 64 + fr, col0 = u.pn * BM + wc * 32 + 8 * fq;
#pragma unroll
        for (int ai = 0; ai < 2; ++ai)
#pragma unroll
            for (int m = 0; m < 4; ++m) { bf16_t* rowp = O + (size_t)(row0 + ai * HALF + m * 16) * ldc + col0;
#pragma unroll
                for (int bj = 0; bj < 2; ++bj) { const f32x4 v0 = acc[ai][bj][m][0], v1 = acc[ai][bj][m][1];
                    u32x4 w; w.x = cvt_pk_bf16(v0[0], v0[1]); w.y = cvt_pk_bf16(v0[2], v0[3]); w.z = cvt_pk_bf16(v1[0], v1[1]); w.w = cvt_pk_bf16(v1[2], v1[3]);
                    *(u32x4*)(rowp + bj * HALF) = w; } }
    }
};
struct EpiResBf16 {
    static constexpr bool PERM = true, AFTER_DRAIN = false;
    const bf16_t* X; bf16_t* Z; int ldc; float alpha;
    __device__ __forceinline__ void operator()(const f32x4 (&acc)[2][2][4][2], const Unit& u, int wr, int wc, int fr, int fq) const {
        const int row0 = u.pm * BM + wr * 64 + fr, col0 = u.pn * BM + wc * 32 + 8 * fq;
#pragma unroll
        for (int ai = 0; ai < 2; ++ai)
#pragma unroll
            for (int m = 0; m < 4; ++m) { const size_t off = (size_t)(row0 + ai * HALF + m * 16) * ldc + col0;
#pragma unroll
                for (int bj = 0; bj < 2; ++bj) {
                    const u32x4 xw = *(const u32x4*)(X + off + bj * HALF);
                    const f32x4 x0 = (f32x4){__builtin_bit_cast(float, xw.x << 16), __builtin_bit_cast(float, xw.x & 0xffff0000u), __builtin_bit_cast(float, xw.y << 16), __builtin_bit_cast(float, xw.y & 0xffff0000u)};
                    const f32x4 x1 = (f32x4){__builtin_bit_cast(float, xw.z << 16), __builtin_bit_cast(float, xw.z & 0xffff0000u), __builtin_bit_cast(float, xw.w << 16), __builtin_bit_cast(float, xw.w & 0xffff0000u)};
                    const f32x4 v0 = acc[ai][bj][m][0] + x0 * alpha, v1 = acc[ai][bj][m][1] + x1 * alpha;
                    u32x4 w; w.x = cvt_pk_bf16(v0[0], v0[1]); w.y = cvt_pk_bf16(v0[2], v0[3]); w.z = cvt_pk_bf16(v1[0], v1[1]); w.w = cvt_pk_bf16(v1[2], v1[3]);
                    *(u32x4*)(Z + off + bj * HALF) = w; } }
    }
};
template <class Epi, class Sched, bool ALIGN_EPI = false, bool SP2 = false>
__device__ __forceinline__ void gemm_phase(PG8_LAS unsigned char* lds, const Gemm g, const Sched& S, const Epi& E) {
    int tid_ = threadIdx.x; asm volatile("" : "+v"(tid_));
    const int tid = tid_, wid = __builtin_amdgcn_readfirstlane(tid >> 6), lane = tid & 63, wr = wid >> 2, wc = wid & 3, fr = lane & 15, fq = lane >> 4;
    const int K = g.K, nt = K / BK;
    unsigned voffA[2], voffB[2];
#pragma unroll
    for (int i = 0; i < 2; ++i) { int R, C; stage_rc(tid * 16 + i * 8192, R, C); const int Rb = Epi::PERM ? ((R & ~31) + perm32(R & 31)) : R;
        voffA[i] = (unsigned)(R * K + C) * 2u; voffB[i] = (unsigned)(Rb * K + C) * 2u; }
    const size_t kstep = (size_t)(BK * 2);
    const size_t hstep = (size_t)HALF * K * 2;
    const size_t tstep = 2 * hstep;
    const unsigned ldsw = (unsigned)wid * 1024u;
    const int aoff = lds_byte(wr * 64 + fr, fq * 8), boff = lds_byte(wc * 32 + fr, fq * 8);
#define PG8_SA(b, h) (((b) * 2 + (h)) * HTB)
#define PG8_SB(b, h) ((4 + (b) * 2 + (h)) * HTB)
#define PG8_STAGE(bufoff, gbase, voff) do { _Pragma("unroll") for (int _i = 0; _i < 2; ++_i) \
        __builtin_amdgcn_global_load_lds((const unsigned*)((const char*)(gbase) + (voff)[_i]), (PG8_LAS unsigned*)(lds + (bufoff) + ldsw + _i * 8192), 16, 0, 0); } while (0)
#define PG8_LDA(dst, b, h) do { _Pragma("unroll") for (int m = 0; m < 4; ++m) _Pragma("unroll") for (int k = 0; k < 2; ++k) dst[m][k] = *(const PG8_LAS bf16x8*)(lds + PG8_SA(b, h) + aoff + m * 2048 + k * 1024); } while (0)
#define PG8_LDB(dst, b, h) do { _Pragma("unroll") for (int n = 0; n < 2; ++n) _Pragma("unroll") for (int k = 0; k < 2; ++k) dst[n][k] = *(const PG8_LAS bf16x8*)(lds + PG8_SB(b, h) + boff + n * 2048 + k * 1024); } while (0)
#define PG8_MMA(ai, bj, At, Bt) do { __builtin_amdgcn_s_setprio(1); _Pragma("unroll") for (int m = 0; m < 4; ++m) _Pragma("unroll") for (int n = 0; n < 2; ++n) _Pragma("unroll") for (int k = 0; k < 2; ++k) \
        acc[ai][bj][m][n] = __builtin_amdgcn_mfma_f32_16x16x32_bf16(Bt[n][k], At[m][k], acc[ai][bj][m][n], 0, 0, 0); __builtin_amdgcn_s_setprio(0); } while (0)
#define PG8_WAIT_V(n) asm volatile("s_waitcnt vmcnt(" #n ")" ::: "memory")
#define PG8_WAIT_L(n) asm volatile("s_waitcnt lgkmcnt(" #n ")" ::: "memory")
#define PG8_BAR __builtin_amdgcn_s_barrier()
#define PG8_SCHED __builtin_amdgcn_sched_barrier(0)
    Unit cur, nxt; int ui = 0;
    if (!S.next(0, cur)) return;
    f32x4 acc[2][2][4][2];
#pragma unroll
    for (int a = 0; a < 2; ++a)
#pragma unroll
        for (int b = 0; b < 2; ++b)
#pragma unroll
            for (int m = 0; m < 4; ++m)
#pragma unroll
                for (int n = 0; n < 2; ++n) acc[a][b][m][n] = (f32x4){0.f, 0.f, 0.f, 0.f};
    bf16x8 At[4][2], B0[2][2], B1[2][2];
    const char* cA = (const char*)g.A + (size_t)cur.pm * tstep; const char* cB = (const char*)g.Bt + (size_t)cur.pn * tstep;
    S.a_ready(cur);
    if constexpr (SP2) {
        PG8_STAGE(PG8_SB(0, 0), cB, voffB); PG8_STAGE(PG8_SB(0, 1), cB + hstep, voffB); PG8_STAGE(PG8_SA(0, 0), cA, voffA); PG8_STAGE(PG8_SA(0, 1), cA + hstep, voffA);
        if (wr == 1) PG8_BAR;
        PG8_WAIT_V(2); PG8_BAR;
        PG8_STAGE(PG8_SB(1, 0), cB + kstep, voffB); PG8_STAGE(PG8_SA(1, 0), cA + kstep, voffA); PG8_STAGE(PG8_SB(1, 1), cB + hstep + kstep, voffB);
        PG8_WAIT_V(6); PG8_BAR;
    } else {
        PG8_STAGE(PG8_SB(0, 0), cB, voffB); PG8_STAGE(PG8_SA(0, 0), cA, voffA); PG8_STAGE(PG8_SB(0, 1), cB + hstep, voffB); PG8_STAGE(PG8_SA(0, 1), cA + hstep, voffA);
        if (wr == 1) PG8_BAR;
        PG8_WAIT_V(4); PG8_BAR;
        PG8_STAGE(PG8_SB(1, 0), cB + kstep, voffB); PG8_STAGE(PG8_SA(1, 0), cA + kstep, voffA); PG8_STAGE(PG8_SB(1, 1), cB + hstep + kstep, voffB);
        PG8_WAIT_V(6); PG8_BAR;
    }
    for (;;) {
        const bool has_next = S.next(ui + 1, nxt);
        const char* nA = has_next ? (const char*)g.A + (size_t)nxt.pm * tstep : cA; const char* nB = has_next ? (const char*)g.Bt + (size_t)nxt.pn * tstep : cB;
        for (int t = 0; t < nt; t += 2) {
            const bool last = (t == nt - 2);
            const char* a1 = cA + (size_t)(t + 1) * kstep;
            const char* a2 = last ? nA : cA + (size_t)(t + 2) * kstep; const char* b2 = last ? nB : cB + (size_t)(t + 2) * kstep;
            const char* a3 = a2 + kstep; const char* b3 = b2 + kstep;
            if (last && has_next) S.a_ready(nxt);
            if constexpr (SP2) {
            PG8_LDB(B0, 0, 0); PG8_LDB(B1, 0, 1); PG8_SCHED; PG8_LDA(At, 0, 0); PG8_STAGE(PG8_SA(1, 1), a1 + hstep, voffA);
            PG8_WAIT_V(8); PG8_WAIT_L(0); PG8_BAR; PG8_MMA(0, 0, At, B0); PG8_MMA(0, 1, At, B1); PG8_BAR; PG8_SCHED;
            PG8_LDA(At, 0, 1); PG8_STAGE(PG8_SB(0, 0), b2, voffB); PG8_STAGE(PG8_SB(0, 1), b2 + hstep, voffB); PG8_STAGE(PG8_SA(0, 0), a2, voffA);
            PG8_WAIT_V(8); PG8_WAIT_L(0); PG8_BAR; PG8_MMA(1, 0, At, B0); PG8_MMA(1, 1, At, B1); PG8_BAR; PG8_SCHED;
            PG8_LDB(B0, 1, 0); PG8_LDB(B1, 1, 1); PG8_SCHED; PG8_LDA(At, 1, 0); PG8_STAGE(PG8_SA(0, 1), a2 + hstep, voffA);
            PG8_WAIT_V(8); PG8_WAIT_L(0); PG8_BAR; PG8_MMA(0, 0, At, B0); PG8_MMA(0, 1, At, B1); PG8_BAR; PG8_SCHED;
            PG8_LDA(At, 1, 1); PG8_STAGE(PG8_SB(1, 0), b3, voffB); PG8_STAGE(PG8_SB(1, 1), b3 + hstep, voffB); PG8_STAGE(PG8_SA(1, 0), a3, voffA);
            PG8_WAIT_V(8); PG8_WAIT_L(0); PG8_BAR; PG8_MMA(1, 0, At, B0); PG8_MMA(1, 1, At, B1); PG8_BAR; PG8_SCHED;
            } else {
            PG8_LDB(B0, 0, 0); PG8_SCHED; PG8_LDA(At, 0, 0); PG8_STAGE(PG8_SA(1, 1), a1 + hstep, voffA);
            PG8_WAIT_L(8); PG8_BAR; PG8_WAIT_L(0); PG8_MMA(0, 0, At, B0); PG8_BAR; PG8_SCHED;
            PG8_LDB(B1, 0, 1); PG8_STAGE(PG8_SB(0, 0), b2, voffB);
            PG8_BAR; PG8_WAIT_L(0); PG8_MMA(0, 1, At, B1); PG8_BAR;
            PG8_LDA(At, 0, 1); PG8_STAGE(PG8_SA(0, 0), a2, voffA);
            PG8_BAR; PG8_WAIT_L(0); PG8_MMA(1, 0, At, B0); PG8_BAR; PG8_SCHED;
            PG8_STAGE(PG8_SB(0, 1), b2 + hstep, voffB);
            PG8_WAIT_V(6); PG8_BAR; PG8_MMA(1, 1, At, B1); PG8_BAR;
            PG8_LDB(B0, 1, 0); PG8_SCHED; PG8_LDA(At, 1, 0); PG8_STAGE(PG8_SA(0, 1), a2 + hstep, voffA);
            PG8_WAIT_L(8); PG8_BAR; PG8_WAIT_L(0); PG8_MMA(0, 0, At, B0); PG8_BAR; PG8_SCHED;
            PG8_LDB(B1, 1, 1); PG8_STAGE(PG8_SB(1, 0), b3, voffB);
            PG8_BAR; PG8_WAIT_L(0); PG8_MMA(0, 1, At, B1); PG8_BAR;
            PG8_LDA(At, 1, 1); PG8_STAGE(PG8_SA(1, 0), a3, voffA);
            PG8_BAR; PG8_WAIT_L(0); PG8_MMA(1, 0, At, B0); PG8_BAR; PG8_SCHED;
            PG8_STAGE(PG8_SB(1, 1), b3 + hstep, voffB);
            PG8_WAIT_V(6); PG8_BAR; PG8_MMA(1, 1, At, B1); PG8_BAR;
            }
        }
        if constexpr (ALIGN_EPI) { if (wr == 0) PG8_BAR; }
        if constexpr (!Epi::AFTER_DRAIN) { E(acc, cur, wr, wc, fr, fq); S.done(cur); }
        if (!has_next) break;
#pragma unroll
        for (int a = 0; a < 2; ++a)
#pragma unroll
            for (int b = 0; b < 2; ++b)
#pragma unroll
                for (int m = 0; m < 4; ++m)
#pragma unroll
                    for (int n = 0; n < 2; ++n) acc[a][b][m][n] = (f32x4){0.f, 0.f, 0.f, 0.f};
        cur = nxt; cA = nA; cB = nB; ++ui;
        if constexpr (ALIGN_EPI) { if (wr == 1) PG8_BAR; }
    }
    PG8_WAIT_V(0);
    if constexpr (!ALIGN_EPI) { if (wr == 0) PG8_BAR; }
    PG8_BAR;
    if constexpr (Epi::AFTER_DRAIN) { E.fused(acc, cur, wr, wc, fr, fq, lds, wid, lane); S.done(cur); }
#undef PG8_SA
#undef PG8_SB
#undef PG8_STAGE
#undef PG8_LDA
#undef PG8_LDB
#undef PG8_MMA
#undef PG8_WAIT_V
#undef PG8_WAIT_L
#undef PG8_BAR
#undef PG8_SCHED
}
}
#ifndef REP0
#define REP0 1
#endif
#ifndef REP1
#define REP1 1
#endif
#ifndef REP2
#define REP2 1
#endif
#ifndef REP3
#define REP3 1
#endif
#ifndef REP4
#define REP4 1
#endif
#ifndef REP5
#define REP5 1
#endif
#ifndef REP6
#define REP6 1
#endif
#ifndef REP7
#define REP7 1
#endif
#ifndef REP8
#define REP8 1
#endif
#ifndef REP9
#define REP9 1
#endif
#ifndef REP10
#define REP10 1
#endif
#ifndef REP11
#define REP11 1
#endif
#ifndef REP12
#define REP12 1
#endif
#ifndef NAIVE_P4
#define NAIVE_P4 0
#endif
#ifndef NAIVE_P2
#define NAIVE_P2 0
#endif
#ifndef NAIVE_P8
#define NAIVE_P8 0
#endif
#ifndef N_LAUNCHES
#define N_LAUNCHES 1
#endif
constexpr int NWAVES = 8, NTHREADS = 512;
constexpr int BATCH = 8, SEQ = 4096, D = 1024, M = BATCH * SEQ;
constexpr int INW = 3072;
constexpr int NCHUNK = M / 128;
constexpr int PEER_H = 8, PEER_K = 16, NSEL = 128, NEXP = 16384;
constexpr float LN_EPS = 1e-5f, GN_EPS = 1e-5f;
constexpr float ALPHA = 1.189207115002721f;

constexpr size_t MiB = 1u << 20;
constexpr size_t WS_CTL = 0, CTL_ZERO_BYTES = 1 * MiB;
constexpr size_t WS_SKB = 1 * MiB;
constexpr size_t WS_WSB = 1 * MiB + 512 * 1024;
constexpr size_t WS_ROPE = 2 * MiB;
constexpr size_t WS_WIN = 4 * MiB;
constexpr size_t WS_WOUT = 10 * MiB;
constexpr size_t WS_WQ = 12 * MiB;
constexpr size_t WS_U8 = 16 * MiB;
constexpr size_t WS_SU = 32 * MiB;
constexpr size_t WS_SV = 32 * MiB + 65536;
constexpr size_t WS_V8 = 33 * MiB;
constexpr size_t WS_CS = 49 * MiB;
constexpr size_t WS_SH = 50 * MiB;
constexpr size_t WS_PROJ = 52 * MiB;
constexpr size_t WS_Z = 52 * MiB;
constexpr size_t WS_ZB = 52 * MiB;
constexpr size_t WS_H = 116 * MiB;
constexpr size_t WS_IDX = 180 * MiB;
constexpr size_t WS_GATE = 188 * MiB;
constexpr size_t WS_CQ = 204 * MiB;
constexpr size_t WS_XB = 244 * MiB;
constexpr size_t WS_Y = 308 * MiB;
constexpr size_t WS_H8 = 308 * MiB;
constexpr size_t WS_ST = 372 * MiB;
constexpr size_t WS_PREV = 436 * MiB;
constexpr size_t WS_QP = 372 * MiB;
constexpr size_t WS_PDOT = 372 * MiB;
constexpr size_t WS_END = 500 * MiB;

constexpr int LDS_BYTES = 147456;

#define GAS __attribute__((address_space(1)))
#define LAS __attribute__((address_space(3)))
typedef unsigned short bf16;
typedef unsigned v4u __attribute__((ext_vector_type(4)));
typedef float f32x4 __attribute__((ext_vector_type(4)));

__device__ __forceinline__ unsigned f2bf(float f) { unsigned u = __builtin_bit_cast(unsigned, f); return (u + 0x7fffu + ((u >> 16) & 1u)) >> 16; }
__device__ __forceinline__ unsigned pk2(float lo, float hi) { return f2bf(lo) | (f2bf(hi) << 16); }
__device__ __forceinline__ float bf2f(unsigned short b) { return __builtin_bit_cast(float, (unsigned)b << 16); }
__device__ __forceinline__ float bflo(unsigned w) { return __builtin_bit_cast(float, w << 16); }
__device__ __forceinline__ float bfhi(unsigned w) { return __builtin_bit_cast(float, w & 0xffff0000u); }
#define DPP_F(v, ctrl) __builtin_bit_cast(float, __builtin_amdgcn_update_dpp(0, __builtin_bit_cast(int, (v)), (ctrl), 0xf, 0xf, false))
__device__ __forceinline__ void swap16_self(unsigned a, unsigned& x, unsigned& y) { unsigned b = a; asm volatile("" : "+v"(b)); const auto r = __builtin_amdgcn_permlane16_swap(a, b, false, false); x = r[0]; y = r[1]; }
__device__ __forceinline__ void swap32_self(unsigned a, unsigned& x, unsigned& y) { unsigned b = a; asm volatile("" : "+v"(b)); const auto r = __builtin_amdgcn_permlane32_swap(a, b, false, false); x = r[0]; y = r[1]; }
__device__ __forceinline__ float wave_sum(float v) {
    v += DPP_F(v, 0xB1); v += DPP_F(v, 0x4E); v += DPP_F(v, 0x141); v += DPP_F(v, 0x140);
    unsigned x, y;
    swap16_self(__builtin_bit_cast(unsigned, v), x, y); v = __builtin_bit_cast(float, x) + __builtin_bit_cast(float, y);
    swap32_self(__builtin_bit_cast(unsigned, v), x, y); v = __builtin_bit_cast(float, x) + __builtin_bit_cast(float, y);
    return v;
}
__device__ __forceinline__ float wave_max(float v) {
    v = fmaxf(v, DPP_F(v, 0xB1)); v = fmaxf(v, DPP_F(v, 0x4E)); v = fmaxf(v, DPP_F(v, 0x141)); v = fmaxf(v, DPP_F(v, 0x140));
    unsigned x, y;
    swap16_self(__builtin_bit_cast(unsigned, v), x, y); v = fmaxf(__builtin_bit_cast(float, x), __builtin_bit_cast(float, y));
    swap32_self(__builtin_bit_cast(unsigned, v), x, y); v = fmaxf(__builtin_bit_cast(float, x), __builtin_bit_cast(float, y));
    return v;
}
__device__ __forceinline__ int wave_sum_i(int v) {
    v += __builtin_amdgcn_update_dpp(0, v, 0xB1, 0xf, 0xf, false); v += __builtin_amdgcn_update_dpp(0, v, 0x4E, 0xf, 0xf, false);
    v += __builtin_amdgcn_update_dpp(0, v, 0x141, 0xf, 0xf, false); v += __builtin_amdgcn_update_dpp(0, v, 0x140, 0xf, 0xf, false);
    unsigned x, y;
    swap16_self((unsigned)v, x, y); v = (int)x + (int)y;
    swap32_self((unsigned)v, x, y); v = (int)x + (int)y;
    return v;
}
__device__ __forceinline__ float gelu_exact(float v) { return 0.5f * v * (1.0f + erff(v * 0.70710678118654752f)); }
__device__ __forceinline__ float log_sigmoid_f(float x) { return -log1pf(expf(-x)); }

typedef short bf16x8 __attribute__((ext_vector_type(8)));
typedef short s16x4 __attribute__((ext_vector_type(4)));
typedef unsigned v2u __attribute__((ext_vector_type(2)));
__device__ __forceinline__ unsigned off_b(unsigned row, unsigned ch) { return 256u * row + 16u * (ch ^ (((row & 3u) << 2) | ((row >> 2) & 3u))); }
__device__ __forceinline__ bf16x8 frag_row(const LAS unsigned char* tile, int lane, int rb, int s) {
    return *(const LAS bf16x8*)(tile + off_b((unsigned)((lane & 15) + 16 * rb), (unsigned)(4 * s + (lane >> 4))));
}
__device__ __forceinline__ bf16x8 frag_tr(const LAS unsigned char* tile, int lane, int c, int ks) {
    const unsigned g = (unsigned)lane >> 4, q = ((unsigned)lane & 15u) >> 2, p = (unsigned)lane & 3u;
    const unsigned a0 = off_b(32u * ks + 8u * g + q, 2u * c + (p >> 1)) + 8u * (p & 1u);
    const unsigned a1 = off_b(32u * ks + 8u * g + 4u + q, 2u * c + (p >> 1)) + 8u * (p & 1u);
    typedef short v4i16_t __attribute__((ext_vector_type(4)));
    const s16x4 lo = __builtin_bit_cast(s16x4, __builtin_amdgcn_ds_read_tr16_b64_v4i16((LAS v4i16_t*)(tile + a0)));
    const s16x4 hi = __builtin_bit_cast(s16x4, __builtin_amdgcn_ds_read_tr16_b64_v4i16((LAS v4i16_t*)(tile + a1)));
    return (bf16x8){lo[0], lo[1], lo[2], lo[3], hi[0], hi[1], hi[2], hi[3]};
}
#define MFMA16(a, b, c) __builtin_amdgcn_mfma_f32_16x16x32_bf16((a), (b), (c), 0, 0, 0)
__device__ __forceinline__ void stage_tile(LAS unsigned char* tile, const bf16* src, int ld, int tid) {
    v4u v[4];
#pragma unroll
    for (int i = 0; i < 4; ++i) { const int c = tid + NTHREADS * i, row = c >> 4, ch = c & 15; v[i] = *(const v4u*)(src + (size_t)row * ld + ch * 8); }
#pragma unroll
    for (int i = 0; i < 4; ++i) { const int c = tid + NTHREADS * i, row = c >> 4, ch = c & 15; *(LAS v4u*)(tile + off_b(row, ch)) = v[i]; }
}
__device__ __forceinline__ v4u scale_chunk(v4u v, float s) {
    v4u o; o.x = pk2(bflo(v.x) * s, bfhi(v.x) * s); o.y = pk2(bflo(v.y) * s, bfhi(v.y) * s); o.z = pk2(bflo(v.z) * s, bfhi(v.z) * s); o.w = pk2(bflo(v.w) * s, bfhi(v.w) * s); return o;
}

__device__ __forceinline__ int f2key(float v, int payload) { const int b = __float_as_int(v); const int t = b ^ ((b >> 31) & 0x7fffffff); return (t & ~0xFF) | payload; }
__device__ __forceinline__ float key2f(int k) { const int t = k & ~0xFF; return __int_as_float(t ^ ((t >> 31) & 0x7fffffff)); }
__device__ __forceinline__ void merge16_desc(int (&k)[16]) {
#pragma unroll
    for (int stride = 8; stride > 0; stride >>= 1)
#pragma unroll
        for (int i = 0; i < 16; ++i) { const int l = i ^ stride; if (l > i) { const int a = k[i], b = k[l]; k[i] = max(a, b); k[l] = min(a, b); } }
}
__device__ __forceinline__ void sort16_desc(int (&k)[16]) {
#pragma unroll
    for (int size = 2; size <= 16; size <<= 1)
#pragma unroll
        for (int stride = size >> 1; stride > 0; stride >>= 1)
#pragma unroll
            for (int i = 0; i < 16; ++i) { const int l = i ^ stride; if (l > i) { const int a = k[i], b = k[l]; const bool desc = ((i & size) == 0); k[i] = desc ? max(a, b) : min(a, b); k[l] = desc ? min(a, b) : max(a, b); } }
}

#define XB_TMO      128
#define XB_XCNT(j)  (256  + 64 * (j))
#define XB_XSUB(j)  (1280 + 64 * (j))
#define XB_XGEN(j)  (2304 + 64 * (j))
#define XB_TOP      3328
#define XB_TOPGEN   3392
#define XCD_BAR_WORDS 3456
#define XB_SPIN_CAP (1u << 18)

__device__ __forceinline__ unsigned xb_ld(unsigned* p)              { return __hip_atomic_load(p, __ATOMIC_RELAXED, __HIP_MEMORY_SCOPE_AGENT); }
__device__ __forceinline__ unsigned xb_add(unsigned* p, unsigned v) { return __hip_atomic_fetch_add(p, v, __ATOMIC_RELAXED, __HIP_MEMORY_SCOPE_AGENT); }
__device__ __forceinline__ unsigned xb_xcc_id() { return (unsigned)__builtin_amdgcn_s_getreg((3 << 11) | 20) & 0xFu; }
#define XB_SPIN(cond, bar) do { unsigned _sp = 0; while (cond) { __builtin_amdgcn_s_sleep(1); \
    if ((++_sp & 255u) == 0u) { if (xb_ld(&(bar)[XB_TMO])) break; if (_sp > XB_SPIN_CAP) { atomicAdd(&(bar)[XB_TMO], 1u); break; } } } } while (0)

struct XcdBarrier {
    unsigned* bar; unsigned x;
    volatile LAS unsigned* st;
};

__device__ __forceinline__ XcdBarrier xcd_barrier_post(unsigned* bar, volatile LAS unsigned* st) {
    XcdBarrier b; b.bar = bar; b.x = xb_xcc_id(); b.st = st;
    if (threadIdx.x == 0) (void)xb_add(&bar[XB_XCNT(b.x)], 1u);
    return b;
}
__device__ __forceinline__ void xcd_barrier_complete(unsigned* bar, unsigned x, unsigned& nloc, unsigned& nx) {
    const unsigned G = gridDim.x * gridDim.y * gridDim.z;
    unsigned sum, cnt, mine, sp = 0u;
    for (;;) {
        sum = 0u; cnt = 0u; mine = 0u;
#pragma unroll
        for (unsigned j = 0; j < 16; ++j) { const unsigned c = xb_ld(&bar[XB_XCNT(j)]); sum += c; cnt += (c > 0u) ? 1u : 0u; mine = (j == x) ? c : mine; }
        if (sum == G) break;
        __builtin_amdgcn_s_sleep(1);
        if ((++sp & 255u) == 0u) { if (xb_ld(&bar[XB_TMO])) break; if (sp > XB_SPIN_CAP) { atomicAdd(&bar[XB_TMO], 1u); break; } }
    }
    nloc = mine > 0u ? mine : 1u; nx = cnt > 0u ? cnt : 1u;
}

__device__ __forceinline__ void xcd_barrier(const XcdBarrier& b) {
    asm volatile("s_waitcnt vmcnt(0)" ::: "memory");
    __syncthreads();
    if (threadIdx.x == 0) {
        unsigned* bar = b.bar;
        __builtin_amdgcn_s_waitcnt(0);
        unsigned nloc = b.st[0], nx = b.st[1];
        if (nloc == 0u) { xcd_barrier_complete(bar, b.x, nloc, nx); b.st[0] = nloc; b.st[1] = nx; }
        const unsigned old = xb_add(&bar[XB_XSUB(b.x)], 1u);
        const unsigned gen = old / nloc;
        if (old + 1u == (gen + 1u) * nloc) {
            __builtin_amdgcn_fence(__ATOMIC_RELEASE, "agent");
            asm volatile("s_waitcnt vmcnt(0)" ::: "memory");
            const unsigned og = xb_add(&bar[XB_TOP], 1u);
            const unsigned tg = og / nx;
            if (og + 1u == (tg + 1u) * nx) xb_add(&bar[XB_TOPGEN], 1u);
            else XB_SPIN(xb_ld(&bar[XB_TOPGEN]) == tg, bar);
            __builtin_amdgcn_fence(__ATOMIC_ACQUIRE, "agent");
            xb_add(&bar[XB_XGEN(b.x)], 1u);
            asm volatile("s_waitcnt vmcnt(0)" ::: "memory");
        } else {
            XB_SPIN(xb_ld(&bar[XB_XGEN(b.x)]) == gen, bar);
            __builtin_amdgcn_fence(__ATOMIC_ACQUIRE, "agent");
            asm volatile("s_waitcnt vmcnt(0)" ::: "memory");
        }
    }
    __syncthreads();
}

constexpr int CW_BAR = 4096;
constexpr int MISC_OFF = LDS_BYTES - 64;

struct Args {
    const float* in[18]; float* out; unsigned char* ws; int ph_lo, ph_hi;
};

template <int MODE>
__device__ __forceinline__ int dst_row(int n) {
    if (MODE == 1 && n >= 1024 && n < 2048) { const int j = n & 127; return (n & ~127) + ((j < 64) ? 2 * j : 2 * (j - 64) + 1); }
    return n;
}
template <int MODE>
__device__ __forceinline__ void p0_transpose_item(const float* W, int K, int N, bf16* WT, LAS float* scr, int item, int lane) {
    const int nblk = N / 32, kb = item / nblk, nb = item % nblk, k0 = 64 * kb, n0 = 32 * nb;
#pragma unroll 8
    for (int i = 0; i < 32; ++i) { const int kk = 2 * i + (lane >> 5); scr[kk * 33 + (lane & 31)] = W[(size_t)(k0 + kk) * N + n0 + (lane & 31)]; }
    asm volatile("s_waitcnt lgkmcnt(0)" ::: "memory");
    const int c = lane & 7;
#pragma unroll
    for (int j = 0; j < 4; ++j) { const int n = (lane >> 3) + 8 * j; const LAS float* s = scr + (8 * c) * 33 + n;
        v4u o; o.x = pk2(s[0 * 33], s[1 * 33]); o.y = pk2(s[2 * 33], s[3 * 33]); o.z = pk2(s[4 * 33], s[5 * 33]); o.w = pk2(s[6 * 33], s[7 * 33]);
        *(GAS v4u*)(WT + (size_t)dst_row<MODE>(n0 + n) * K + k0 + 8 * c) = o; }
    asm volatile("s_waitcnt lgkmcnt(0)" ::: "memory");
}
__device__ __forceinline__ void p0_convert(const float* src, bf16* dst, size_t n8, size_t gt, size_t ngt) {
    for (size_t i = gt; i < n8; i += ngt) {
        const f32x4 a = *(const f32x4*)(src + i * 8), b = *(const f32x4*)(src + i * 8 + 4);
        v4u o; o.x = pk2(a[0], a[1]); o.y = pk2(a[2], a[3]); o.z = pk2(b[0], b[1]); o.w = pk2(b[2], b[3]);
        *(v4u*)(dst + i * 8) = o;
    }
}

template <int PH_LO, int PH_HI>
__global__ void __launch_bounds__(NTHREADS, 2) fwd_kernel(Args args) {
    extern __shared__ __attribute__((aligned(16))) unsigned char lds_raw[];
    LAS unsigned char* lds = (LAS unsigned char*)lds_raw;
    LAS float* sm = (LAS float*)lds_raw;
    const int G = gridDim.x, bx = blockIdx.x;
#define PHASE_COORDS \
    int tid = threadIdx.x; asm volatile("" : "+v"(tid)); \
    const int lane = tid & 63, wave = __builtin_amdgcn_readfirstlane(tid >> 6); \
    const int gw = bx * NWAVES + wave, NGW = G * NWAVES; \
    const size_t gt = (size_t)bx * NTHREADS + tid, ngt = (size_t)G * NTHREADS; \
    (void)lane; (void)wave; (void)gw; (void)NGW; (void)gt; (void)ngt;
    unsigned char* ws = args.ws;
    const float* x = args.in[0];
    bf16* SKB = (bf16*)(ws + WS_SKB); bf16* WSB = (bf16*)(ws + WS_WSB); float* ROPE = (float*)(ws + WS_ROPE);
    bf16* WIN = (bf16*)(ws + WS_WIN); bf16* WOUT = (bf16*)(ws + WS_WOUT); bf16* WQ = (bf16*)(ws + WS_WQ);
    unsigned char* U8 = ws + WS_U8; unsigned char* V8 = ws + WS_V8; float* SU = (float*)(ws + WS_SU); float* SV = (float*)(ws + WS_SV);
    float* CS = (float*)(ws + WS_CS); short* CQ = (short*)(ws + WS_CQ); bf16* ZB = (bf16*)(ws + WS_ZB); float* SH = (float*)(ws + WS_SH); unsigned char* H8 = ws + WS_H8; bf16* PDOT = (bf16*)(ws + WS_PDOT);
    bf16* PROJ = (bf16*)(ws + WS_PROJ); bf16* Z = (bf16*)(ws + WS_Z); unsigned short* IDX = (unsigned short*)(ws + WS_IDX); float* GATE = (float*)(ws + WS_GATE);
    bf16* H = (bf16*)(ws + WS_H); bf16* XB = (bf16*)(ws + WS_XB); bf16* Y = (bf16*)(ws + WS_Y);
    bf16* ST = (bf16*)(ws + WS_ST); bf16* PREV = (bf16*)(ws + WS_PREV); bf16* QP = (bf16*)(ws + WS_QP);
#define IN(k) (PH_LO <= (k) && (k) < PH_HI)
#define BOTH(k) (IN(k) && IN((k) + 1))
    volatile LAS unsigned* MISC = (volatile LAS unsigned*)(lds + MISC_OFF);
    XcdBarrier bar; bar.bar = (unsigned*)(ws + WS_CTL) + CW_BAR; bar.x = 0; bar.st = nullptr;
    if constexpr (PH_HI - PH_LO > 1) {
        if (threadIdx.x < 16) MISC[threadIdx.x] = 0u;
        __syncthreads();
        bar = xcd_barrier_post((unsigned*)(ws + WS_CTL) + CW_BAR, MISC + 8);
    }
#define GRID_BAR(k) do { if constexpr (BOTH(k)) xcd_barrier(bar); } while (0)

    if constexpr (IN(0)) for (int rep_ = 0; rep_ < REP0; ++rep_) {
        PHASE_COORDS
        LAS float* scr = sm + wave * 4096;
        constexpr int I_IN = (D / 64) * (INW / 32), I_OUT = (D / 64) * (D / 32), I_Q = (D / 64) * (2048 / 32);
        for (int it = gw; it < I_IN + I_OUT + I_Q; it += NGW) {
            int r = it;
            if (r < I_IN) { p0_transpose_item<1>(args.in[1], D, INW, WIN, scr, r, lane); continue; } r -= I_IN;
            if (r < I_OUT) { p0_transpose_item<0>(args.in[9], D, D, WOUT, scr, r, lane); continue; } r -= I_OUT;
            p0_transpose_item<0>(args.in[12], D, 2048, WQ, scr, r, lane);
        }
        p0_convert(args.in[13], SKB, (size_t)8 * 2 * 128 * 128 / 8, gt, ngt);
        p0_convert(args.in[4], WSB, (size_t)4 * 128 * 128 / 8, gt, ngt);
        for (int r0 = gw * 4; r0 < 2 * NEXP; r0 += NGW * 4) {
            f32x4 a[4][4]; float mx[4];
#pragma unroll
            for (int u = 0; u < 4; ++u) {
                const int r = r0 + u; const bool isv = r >= NEXP; const int e = isv ? r - NEXP : r;
                const float* src = (isv ? args.in[15] : args.in[14]) + (size_t)e * D + lane * 16;
#pragma unroll
                for (int k = 0; k < 4; ++k) a[u][k] = *(const f32x4*)(src + 4 * k);
            }
#pragma unroll
            for (int u = 0; u < 4; ++u) {
                mx[u] = 0.f;
#pragma unroll
                for (int k = 0; k < 4; ++k) mx[u] = fmaxf(mx[u], fmaxf(fmaxf(fabsf(a[u][k][0]), fabsf(a[u][k][1])), fmaxf(fabsf(a[u][k][2]), fabsf(a[u][k][3]))));
            }
#pragma unroll
            for (int u = 0; u < 4; ++u) mx[u] = wave_max(mx[u]);
#pragma unroll
            for (int u = 0; u < 4; ++u) {
                const int r = r0 + u; const bool isv = r >= NEXP; const int e = isv ? r - NEXP : r;
                const float inv = mx[u] > 0.f ? 127.0f / mx[u] : 0.f;
                const int bias = isv ? 128 : 0;
                unsigned wq[4];
#pragma unroll
                for (int k = 0; k < 4; ++k) {
                    const int q0 = (int)rintf(a[u][k][0] * inv) + bias, q1 = (int)rintf(a[u][k][1] * inv) + bias, q2 = (int)rintf(a[u][k][2] * inv) + bias, q3 = (int)rintf(a[u][k][3] * inv) + bias;
                    wq[k] = (unsigned)(q0 & 0xff) | ((unsigned)(q1 & 0xff) << 8) | ((unsigned)(q2 & 0xff) << 16) | ((unsigned)(q3 & 0xff) << 24);
                }
                *(v4u*)((isv ? V8 : U8) + ((size_t)(lane >> 3) * NEXP + e) * 128 + (lane & 7) * 16) = (v4u){wq[0], wq[1], wq[2], wq[3]};
                if (lane == 0) (isv ? SV : SU)[e] = mx[u] * (1.0f / 127.0f);
            }
        }
        p0_convert(x, XB, (size_t)M * D / 8, gt, ngt);
        for (size_t i = gt; i < (size_t)4096 * 64; i += ngt) {
            const int pos = (int)(i >> 6), k = (int)(i & 63);
            const float inv = powf(10000.0f, -(float)k / 64.0f);
            const float ang = (float)pos * inv;
            ROPE[i * 2] = cosf(ang); ROPE[i * 2 + 1] = sinf(ang);
        }
    }

    GRID_BAR(0);

    if constexpr (IN(1)) for (int rep_ = 0; rep_ < REP1; ++rep_) {
        PHASE_COORDS
        pg8::Gemm g{XB, WIN, M, INW, D}; pg8::StaticOrder S; S.init(M, INW, G, bx);
        pg8::EpiProj E{PROJ, ROPE};
        pg8::gemm_phase<pg8::EpiProj, pg8::StaticOrder, true, true>(lds, g, S, E);
    }

    GRID_BAR(1);

#if NAIVE_P2
    if constexpr (IN(2)) for (int rep_ = 0; rep_ < REP2; ++rep_) {
        PHASE_COORDS
        const float* lnw = args.in[2]; const float* lnb = args.in[3]; const float* wsf = args.in[4]; const float* bs = args.in[5];
        for (int ck = bx; ck < NCHUNK; ck += G) {
            const int t0 = ck * 128, bb = ck >> 5, cc = ck & 31;
            LAS float* stat = sm + 16384;
            for (int r = wave * 16; r < wave * 16 + 16; ++r) {
                const v4u raw = *(const v4u*)(PROJ + (size_t)(t0 + r) * INW + 512 + lane * 8);
                float v[8] = {bflo(raw.x), bfhi(raw.x), bflo(raw.y), bfhi(raw.y), bflo(raw.z), bfhi(raw.z), bflo(raw.w), bfhi(raw.w)};
                float s = 0.f;
#pragma unroll
                for (int j = 0; j < 8; ++j) s += v[j];
                const float mean = wave_sum(s) * (1.0f / 512.0f);
                float q = 0.f;
#pragma unroll
                for (int j = 0; j < 8; ++j) { const float d = v[j] - mean; q += d * d; }
                const float rstd = 1.0f / sqrtf(wave_sum(q) * (1.0f / 512.0f) + LN_EPS);
                if (lane == 0) { stat[r * 2] = mean; stat[r * 2 + 1] = rstd; }
            }
            __syncthreads();
#pragma unroll 1
            for (int h = 0; h < 4; ++h) {
                for (int i = tid; i < 16384; i += NTHREADS) {
                    const int m = i >> 7, d = i & 127, col = h * 128 + d;
                    const float v = bf2f(PROJ[(size_t)(t0 + m) * INW + 512 + col]);
                    sm[i] = (v - stat[m * 2]) * stat[m * 2 + 1] * lnw[col] + lnb[col];
                }
                __syncthreads();
                {
                    const int d = tid & 127, lg = tid >> 7;
#pragma unroll 1
                    for (int ps = 0; ps < 4; ++ps) {
                        const int l0 = lg * 32 + ps * 8;
                        float acc[8];
#pragma unroll
                        for (int li = 0; li < 8; ++li) acc[li] = 0.f;
#pragma unroll 2
                        for (int m = 0; m < 128; ++m) {
                            const float vv = sm[m * 128 + d];
#pragma unroll
                            for (int li = 0; li < 8; ++li) acc[li] += wsf[((size_t)h * 128 + l0 + li) * 128 + m] * vv;
                        }
#pragma unroll
                        for (int li = 0; li < 8; ++li) {
                            const int l = l0 + li;
                            const float mixed = acc[li] + bs[h * 128 + l];
                            const float uu = bf2f(PROJ[(size_t)(t0 + l) * INW + h * 128 + d]);
                            Y[(size_t)(t0 + l) * D + h * 128 + d] = (bf16)f2bf(uu * mixed);
                        }
                    }
                }
                __syncthreads();
            }
#pragma unroll 1
            for (int h = 0; h < 4; ++h) {
                LAS float* Kt = sm; LAS float* Vt = sm + 16384;
                for (int i = tid; i < 16384; i += NTHREADS) {
                    const int l = i >> 7, d = i & 127;
                    Kt[i] = bf2f(PROJ[(size_t)(t0 + l) * INW + 1536 + h * 128 + d]);
                    Vt[i] = bf2f(PROJ[(size_t)(t0 + l) * INW + 2048 + h * 128 + d]);
                }
                {
                    const float lgf = log_sigmoid_f(args.in[6][h]), lgb = log_sigmoid_f(args.in[7][h]);
                    if (tid < 128) { sm[32768 + tid] = expf((float)(127 - tid) * lgf); sm[32768 + 128 + tid] = expf((float)tid * lgb); }
                }
                __syncthreads();
                const int dk = tid & 127, g4 = tid >> 7;
                const size_t u0 = (size_t)((bb * 4 + h) * 32 + cc) * 16384;
#pragma unroll 1
                for (int ps = 0; ps < 4; ++ps) {
                    const int dv0 = g4 * 32 + ps * 8;
                    float af[8], ab[8];
#pragma unroll
                    for (int j = 0; j < 8; ++j) { af[j] = 0.f; ab[j] = 0.f; }
#pragma unroll 2
                    for (int l = 0; l < 128; ++l) {
                        const float kv = Kt[l * 128 + dk];
                        const float kf = kv * sm[32768 + l], kb = kv * sm[32768 + 128 + l];
#pragma unroll
                        for (int j = 0; j < 8; ++j) { const float vv = Vt[l * 128 + dv0 + j]; af[j] += kf * vv; ab[j] += kb * vv; }
                    }
#pragma unroll
                    for (int j = 0; j < 8; ++j) {
                        const int dv = dv0 + j;
                        ST[u0 + dv * 128 + dk] = (bf16)f2bf(af[j]);
                        ST[(size_t)1024 * 16384 + u0 + dv * 128 + dk] = (bf16)f2bf(ab[j]);
                    }
                }
                __syncthreads();
            }
        }
    }

#else
    if constexpr (IN(2)) for (int rep_ = 0; rep_ < REP2; ++rep_) {
        PHASE_COORDS
        const float* lnw = args.in[2]; const float* lnb = args.in[3]; const float* bs = args.in[5];
        LAS unsigned char* B0 = lds; LAS unsigned char* B1 = lds + 32768; LAS unsigned char* B2 = lds + 65536; LAS unsigned char* B3 = lds + 98304;
        LAS float* stat = (LAS float*)(lds + 131072);
        const int g = lane >> 4, fr = lane & 15;
        const int nunit = ((NCHUNK - bx + G - 1) / G) * 4;
        unsigned gofP[4], lof[4]; int rowi[4], chi[4];
#pragma unroll
        for (int i = 0; i < 4; ++i) { const int c_ = tid + NTHREADS * i; rowi[i] = c_ >> 4; chi[i] = c_ & 15; gofP[i] = (unsigned)(rowi[i] * INW + chi[i] * 8) * 2u; lof[i] = off_b(rowi[i], chi[i]); }
#define P2_CK(n) (bx + G * ((n) >> 2))
#define LDG16(base, off) (*(const v4u*)((const char*)(base) + (off)))
        v4u ld[12];
#define P2_ISSUE(n) do { const bf16* pr_ = PROJ + (size_t)(P2_CK(n) * 128) * INW + ((n) & 3) * 128; \
            _Pragma("unroll") for (int i = 0; i < 4; ++i) { ld[i] = LDG16(pr_ + 512, gofP[i]); ld[4 + i] = LDG16(pr_ + 1536, gofP[i]); ld[8 + i] = LDG16(pr_ + 2048, gofP[i]); } } while (0)
        if (nunit > 0) P2_ISSUE(0);
#pragma unroll 1
        for (int n = 0; n < nunit; ++n) {
            const int ck = P2_CK(n), h = n & 3;
            const int t0 = ck * 128, bb = ck >> 5, cc = ck & 31;
            if (h == 0) {
                v4u raw[16];
#pragma unroll
                for (int r = 0; r < 16; ++r) raw[r] = *(const v4u*)(PROJ + (size_t)(t0 + wave * 16 + r) * INW + 512 + lane * 8);
                float sm_[16], sq_[16];
#pragma unroll
                for (int r = 0; r < 16; ++r) {
                    const float v0 = bflo(raw[r].x), v1 = bfhi(raw[r].x), v2 = bflo(raw[r].y), v3 = bfhi(raw[r].y), v4 = bflo(raw[r].z), v5 = bfhi(raw[r].z), v6 = bflo(raw[r].w), v7 = bfhi(raw[r].w);
                    sm_[r] = ((v0 + v1) + (v2 + v3)) + ((v4 + v5) + (v6 + v7));
                    sq_[r] = ((v0 * v0 + v1 * v1) + (v2 * v2 + v3 * v3)) + ((v4 * v4 + v5 * v5) + (v6 * v6 + v7 * v7));
                }
#pragma unroll
                for (int r = 0; r < 16; ++r) { sm_[r] = wave_sum(sm_[r]); sq_[r] = wave_sum(sq_[r]); }
#pragma unroll
                for (int r = 0; r < 16; ++r) {
                    const float mean = sm_[r] * (1.0f / 512.0f);
                    const float var = fmaxf(sq_[r] * (1.0f / 512.0f) - mean * mean, 0.f);
                    if (lane == r) { stat[(wave * 16 + r) * 2] = mean; stat[(wave * 16 + r) * 2 + 1] = 1.0f / sqrtf(var + LN_EPS); }
                }
                __syncthreads();
            }
            const float lf2 = log_sigmoid_f(args.in[6][h]) * 1.4426950408889634f, lb2 = log_sigmoid_f(args.in[7][h]) * 1.4426950408889634f;
#pragma unroll
            for (int i = 0; i < 4; ++i) {
                const int row = rowi[i], ch = chi[i];
                const v4u raw = ld[i];
                const f32x4 w0 = *(const f32x4*)(lnw + h * 128 + ch * 8), w1 = *(const f32x4*)(lnw + h * 128 + ch * 8 + 4);
                const f32x4 b0 = *(const f32x4*)(lnb + h * 128 + ch * 8), b1 = *(const f32x4*)(lnb + h * 128 + ch * 8 + 4);
                const float mean = stat[row * 2], rstd = stat[row * 2 + 1];
                v4u o;
                o.x = pk2((bflo(raw.x) - mean) * rstd * w0[0] + b0[0], (bfhi(raw.x) - mean) * rstd * w0[1] + b0[1]);
                o.y = pk2((bflo(raw.y) - mean) * rstd * w0[2] + b0[2], (bfhi(raw.y) - mean) * rstd * w0[3] + b0[3]);
                o.z = pk2((bflo(raw.z) - mean) * rstd * w1[0] + b1[0], (bfhi(raw.z) - mean) * rstd * w1[1] + b1[1]);
                o.w = pk2((bflo(raw.w) - mean) * rstd * w1[2] + b1[2], (bfhi(raw.w) - mean) * rstd * w1[3] + b1[3]);
                *(LAS v4u*)(B0 + lof[i]) = o;
                *(LAS v4u*)(B1 + lof[i]) = ld[4 + i];
                *(LAS v4u*)(B2 + lof[i]) = scale_chunk(ld[8 + i], __builtin_amdgcn_exp2f((float)(127 - row) * lf2));
                *(LAS v4u*)(B3 + lof[i]) = scale_chunk(ld[8 + i], __builtin_amdgcn_exp2f((float)row * lb2));
            }
            if (n + 1 < nunit) P2_ISSUE(n + 1);
            __syncthreads();
            {
                bf16x8 wf[4];
#pragma unroll
                for (int s = 0; s < 4; ++s) wf[s] = *(const bf16x8*)(WSB + ((size_t)h * 128 + 16 * wave + fr) * 128 + 32 * s + 8 * g);
                const int l = 16 * wave + fr;
                const bf16* urow = PROJ + (size_t)(t0 + l) * INW + h * 128;
                v2u u2[8];
#pragma unroll
                for (int nt = 0; nt < 8; ++nt) u2[nt] = *(const v2u*)(urow + 16 * nt + 4 * g);
                const float bias = bs[h * 128 + l];
                f32x4 acc[8];
#pragma unroll
                for (int nt = 0; nt < 8; ++nt) acc[nt] = (f32x4){0.f, 0.f, 0.f, 0.f};
#pragma unroll
                for (int s = 0; s < 4; ++s)
#pragma unroll
                    for (int nt = 0; nt < 8; ++nt) acc[nt] = MFMA16(frag_tr(B0, lane, nt, s), wf[s], acc[nt]);
                bf16* yrow = Y + (size_t)(t0 + l) * D + h * 128;
#pragma unroll
                for (int nt = 0; nt < 8; ++nt) {
                    const int d0 = 16 * nt + 4 * g;
                    v2u w; w.x = pk2(bflo(u2[nt].x) * (acc[nt][0] + bias), bfhi(u2[nt].x) * (acc[nt][1] + bias)); w.y = pk2(bflo(u2[nt].y) * (acc[nt][2] + bias), bfhi(u2[nt].y) * (acc[nt][3] + bias));
                    *(v2u*)(yrow + d0) = w;
                }
            }
            {
                f32x4 af[8], ab[8];
#pragma unroll
                for (int nt = 0; nt < 8; ++nt) { af[nt] = (f32x4){0.f, 0.f, 0.f, 0.f}; ab[nt] = (f32x4){0.f, 0.f, 0.f, 0.f}; }
#pragma unroll
                for (int s = 0; s < 4; ++s) {
                    const bf16x8 vf = frag_tr(B2, lane, wave, s), vb = frag_tr(B3, lane, wave, s);
#pragma unroll
                    for (int nt = 0; nt < 8; ++nt) { const bf16x8 kf = frag_tr(B1, lane, nt, s); af[nt] = MFMA16(kf, vf, af[nt]); ab[nt] = MFMA16(kf, vb, ab[nt]); }
                }
                const size_t u0 = (size_t)((bb * 4 + h) * 32 + cc) * 16384 + (size_t)(16 * wave + fr) * 128;
#pragma unroll
                for (int nt = 0; nt < 8; ++nt) {
                    const int dk0 = 16 * nt + 4 * g;
                    v2u w; w.x = pk2(af[nt][0], af[nt][1]); w.y = pk2(af[nt][2], af[nt][3]);
                    *(v2u*)(ST + u0 + dk0) = w;
                    w.x = pk2(ab[nt][0], ab[nt][1]); w.y = pk2(ab[nt][2], ab[nt][3]);
                    *(v2u*)(ST + (size_t)1024 * 16384 + u0 + dk0) = w;
                }
            }
            __syncthreads();
        }
#undef P2_CK
#undef P2_ISSUE
#undef LDG16
    }

#endif
    GRID_BAR(2);

    if constexpr (IN(3)) for (int rep_ = 0; rep_ < REP3; ++rep_) {
        PHASE_COORDS
        for (size_t v = gt; v < (size_t)2 * 32 * 2048; v += ngt) {
            const int dir = (int)(v >> 16), bh = (int)((v >> 11) & 31), e8 = (int)(v & 2047), h = bh & 3;
            const float lg = log_sigmoid_f(dir == 0 ? args.in[6][h] : args.in[7][h]);
            const float Gc = expf(128.0f * lg);
            const size_t base = ((size_t)dir * 1024 + bh * 32) * 16384 + (size_t)e8 * 8;
            float st[8];
#pragma unroll
            for (int j = 0; j < 8; ++j) st[j] = 0.f;
#pragma unroll 1
            for (int half = 0; half < 2; ++half) {
                v4u sv[16];
#pragma unroll
                for (int k = 0; k < 16; ++k) { const int ci = half * 16 + k, c = (dir == 0) ? ci : 31 - ci; sv[k] = *(const v4u*)(ST + base + (size_t)c * 16384); }
#pragma unroll
                for (int k = 0; k < 16; ++k) {
                    const int ci = half * 16 + k, c = (dir == 0) ? ci : 31 - ci;
                    v4u o; o.x = pk2(st[0], st[1]); o.y = pk2(st[2], st[3]); o.z = pk2(st[4], st[5]); o.w = pk2(st[6], st[7]);
                    *(v4u*)(PREV + base + (size_t)c * 16384) = o;
                    const v4u s4 = sv[k];
                    st[0] = Gc * st[0] + bflo(s4.x); st[1] = Gc * st[1] + bfhi(s4.x); st[2] = Gc * st[2] + bflo(s4.y); st[3] = Gc * st[3] + bfhi(s4.y);
                    st[4] = Gc * st[4] + bflo(s4.z); st[5] = Gc * st[5] + bfhi(s4.z); st[6] = Gc * st[6] + bflo(s4.w); st[7] = Gc * st[7] + bfhi(s4.w);
                }
            }
        }
    }
    GRID_BAR(3);

#if NAIVE_P4
    if constexpr (IN(4)) for (int rep_ = 0; rep_ < REP4; ++rep_) {
        PHASE_COORDS
        const float* gnw = args.in[8];
        for (int ck = bx; ck < NCHUNK; ck += G) {
            const int t0 = ck * 128, bb = ck >> 5, cc = ck & 31;
#pragma unroll 1
            for (int h = 0; h < 4; ++h) {
                const float lgf = log_sigmoid_f(args.in[6][h]), lgb = log_sigmoid_f(args.in[7][h]);
                LAS float* A0 = sm;
                LAS float* A1 = sm + 16384;
                for (int i = tid; i < 16384; i += NTHREADS) {
                    const int l = i >> 7, d = i & 127;
                    A0[i] = bf2f(PROJ[(size_t)(t0 + l) * INW + 1024 + h * 128 + d]);
                    A1[l * 129 + d] = bf2f(PROJ[(size_t)(t0 + l) * INW + 1536 + h * 128 + d]);
                }
                LAS float* qwt = sm + 32896;
                if (tid < 128) { qwt[tid] = expf((float)(tid + 1) * lgf); qwt[128 + tid] = expf((float)(128 - tid) * lgb); qwt[256 + tid] = expf((float)tid * lgf); qwt[384 + tid] = expf((float)tid * lgb); }
                __syncthreads();
                const int c0 = tid & 127, lg4 = tid >> 7;
                float acc[32];
#pragma unroll
                for (int li = 0; li < 32; ++li) acc[li] = 0.f;
#pragma unroll 1
                for (int d = 0; d < 128; ++d) {
                    const float kv = A1[c0 * 129 + d];
#pragma unroll
                    for (int li = 0; li < 32; ++li) acc[li] += A0[(lg4 * 32 + li) * 128 + d] * kv;
                }
                __syncthreads();
#pragma unroll
                for (int li = 0; li < 32; ++li) {
                    const int l = lg4 * 32 + li, m = c0;
                    const float dec = (m <= l) ? qwt[256 + l - m] : qwt[384 + m - l];
                    A0[l * 128 + m] = acc[li] * dec;
                }
                for (int i = tid; i < 16384; i += NTHREADS) {
                    const int l = i >> 7, d = i & 127;
                    A1[l * 129 + d] = bf2f(PROJ[(size_t)(t0 + l) * INW + 2048 + h * 128 + d]);
                }
                __syncthreads();
                float o[32];
#pragma unroll
                for (int li = 0; li < 32; ++li) o[li] = 0.f;
#pragma unroll 1
                for (int m = 0; m < 128; ++m) {
                    const float vv = A1[m * 129 + c0];
#pragma unroll
                    for (int li = 0; li < 32; ++li) o[li] += A0[(lg4 * 32 + li) * 128 + m] * vv;
                }
                __syncthreads();
#pragma unroll 1
                for (int dir = 0; dir < 2; ++dir) {
                    const size_t u0 = ((size_t)dir * 1024 + (bb * 4 + h) * 32 + cc) * 16384;
                    __syncthreads();
                    for (int i = tid; i < 16384; i += NTHREADS) {
                        const int l = i >> 7, d = i & 127;
                        A0[i] = qwt[dir * 128 + l] * bf2f(PROJ[(size_t)(t0 + l) * INW + 1024 + h * 128 + d]);
                        A1[l * 129 + d] = bf2f(PREV[u0 + i]);
                    }
                    __syncthreads();
#pragma unroll 1
                    for (int dk = 0; dk < 128; ++dk) {
                        const float pv = A1[c0 * 129 + dk];
#pragma unroll
                        for (int li = 0; li < 32; ++li) o[li] += A0[(lg4 * 32 + li) * 128 + dk] * pv;
                    }
                }
                __syncthreads();
#pragma unroll
                for (int li = 0; li < 32; ++li) A0[(lg4 * 32 + li) * 128 + c0] = o[li];
                __syncthreads();
                for (int r = wave * 16; r < wave * 16 + 16; ++r) {
                    const float a = A0[r * 128 + lane], b = A0[r * 128 + 64 + lane];
                    const float mean = wave_sum(a + b) * (1.0f / 128.0f);
                    const float da = a - mean, db = b - mean;
                    const float rstd = 1.0f / sqrtf(wave_sum(da * da + db * db) * (1.0f / 128.0f) + GN_EPS);
                    const size_t prow = (size_t)(t0 + r) * INW + 2560 + h * 128;
                    const float ga = bf2f(PROJ[prow + lane]), gb = bf2f(PROJ[prow + 64 + lane]);
                    Y[(size_t)(t0 + r) * D + 512 + h * 128 + lane] = (bf16)f2bf(da * rstd * gnw[h * 128 + lane] * ga);
                    Y[(size_t)(t0 + r) * D + 512 + h * 128 + 64 + lane] = (bf16)f2bf(db * rstd * gnw[h * 128 + 64 + lane] * gb);
                }
                __syncthreads();
            }
        }
    }

#else
    if constexpr (IN(4)) for (int rep_ = 0; rep_ < REP4; ++rep_) {
        PHASE_COORDS
        const float* gnw = args.in[8];
        LAS unsigned char* B0 = lds; LAS unsigned char* B1 = lds + 32768; LAS unsigned char* B2 = lds + 65536; LAS unsigned char* B3 = lds + 98304;
        const int g = lane >> 4, fr = lane & 15;
        const int nunit = ((NCHUNK - bx + G - 1) / G) * 4;
        v4u qk[8];
        unsigned gofP[4], gofR[4], lof[4];
#pragma unroll
        for (int i = 0; i < 4; ++i) { const int c_ = tid + NTHREADS * i, row_ = c_ >> 4, ch_ = c_ & 15; gofP[i] = (unsigned)(row_ * INW + ch_ * 8) * 2u; gofR[i] = (unsigned)(row_ * 128 + ch_ * 8) * 2u; lof[i] = off_b(row_, ch_); }
#define P4_CK(n) (bx + G * ((n) >> 2))
#define LDG16(base, off) (*(const v4u*)((const char*)(base) + (off)))
#define P4_ISSUE_QK(n) do { const bf16* pr_ = PROJ + (size_t)(P4_CK(n) * 128) * INW + ((n) & 3) * 128; \
            _Pragma("unroll") for (int i = 0; i < 4; ++i) { qk[i] = LDG16(pr_ + 1024, gofP[i]); qk[4 + i] = LDG16(pr_ + 1536, gofP[i]); } } while (0)
        if (nunit > 0) P4_ISSUE_QK(0);
#pragma unroll 1
        for (int n = 0; n < nunit; ++n) {
            const int ck = P4_CK(n), h = n & 3;
            const int t0 = ck * 128, bb = ck >> 5, cc = ck & 31;
            const float lf2 = log_sigmoid_f(args.in[6][h]) * 1.4426950408889634f, lb2 = log_sigmoid_f(args.in[7][h]) * 1.4426950408889634f;
            const bf16* prow = PROJ + (size_t)t0 * INW + h * 128;
#pragma unroll
            for (int i = 0; i < 4; ++i) { *(LAS v4u*)(B0 + lof[i]) = qk[i]; *(LAS v4u*)(B1 + lof[i]) = qk[4 + i]; }
            v4u vpp[12];
            {
                const bf16* pf_ = PREV + (size_t)((bb * 4 + h) * 32 + cc) * 16384;
#pragma unroll
                for (int i = 0; i < 4; ++i) { vpp[i] = LDG16(prow + 2048, gofP[i]); vpp[4 + i] = LDG16(pf_, gofR[i]); vpp[8 + i] = LDG16(pf_ + (size_t)1024 * 16384, gofR[i]); }
            }
            __syncthreads();
            bf16x8 qf[4];
#pragma unroll
            for (int s = 0; s < 4; ++s) qf[s] = frag_row(B0, lane, wave, s);
            const int l = 16 * wave + fr;
            v2u pw[8];
            {
                f32x4 sacc[8];
#pragma unroll
                for (int nt = 0; nt < 8; ++nt) sacc[nt] = (f32x4){0.f, 0.f, 0.f, 0.f};
#pragma unroll
                for (int nt = 0; nt < 8; ++nt)
                { _Pragma("unroll") for (int s = 0; s < 4; ++s) sacc[nt] = MFMA16(frag_row(B1, lane, nt, s), qf[s], sacc[nt]);
                  if ((nt & 1) == 1) __builtin_amdgcn_sched_barrier(0); }
#pragma unroll
                for (int nt = 0; nt < 8; ++nt) {
                    const int m0 = 16 * nt + 4 * g;
                    float p[4];
#pragma unroll
                    for (int r = 0; r < 4; ++r) { const int m = m0 + r; p[r] = sacc[nt][r] * __builtin_amdgcn_exp2f((float)(l - m) * ((m <= l) ? lf2 : -lb2)); }
                    pw[nt].x = pk2(p[0], p[1]); pw[nt].y = pk2(p[2], p[3]);
                }
            }
            __syncthreads();
#pragma unroll
            for (int nt = 0; nt < 8; ++nt) *(LAS v2u*)(B1 + off_b((unsigned)l, (unsigned)(2 * nt + (g >> 1))) + 8 * (g & 1)) = pw[nt];
#pragma unroll
            for (int i = 0; i < 4; ++i) { *(LAS v4u*)(B2 + lof[i]) = vpp[i]; *(LAS v4u*)(B3 + lof[i]) = vpp[4 + i]; *(LAS v4u*)(B0 + lof[i]) = vpp[8 + i]; }
            if (n + 1 < nunit) P4_ISSUE_QK(n + 1);
            const bf16* grow = PROJ + (size_t)(t0 + l) * INW + 2560 + h * 128;
            __syncthreads();
            f32x4 o[8];
#pragma unroll
            for (int nt = 0; nt < 8; ++nt) o[nt] = (f32x4){0.f, 0.f, 0.f, 0.f};
            const float qwf = __builtin_amdgcn_exp2f((float)(l + 1) * lf2), qwb = __builtin_amdgcn_exp2f((float)(128 - l) * lb2);
#pragma unroll
            for (int nt = 0; nt < 8; ++nt)
#pragma unroll
                for (int s = 0; s < 4; ++s) o[nt] = MFMA16(frag_row(B3, lane, nt, s), qf[s], o[nt]);
            {
                const float ratio = qwf * __builtin_amdgcn_rcpf(qwb);
#pragma unroll
                for (int nt = 0; nt < 8; ++nt) o[nt] = o[nt] * ratio;
            }
#pragma unroll
            for (int nt = 0; nt < 8; ++nt)
#pragma unroll
                for (int s = 0; s < 4; ++s) o[nt] = MFMA16(frag_row(B0, lane, nt, s), qf[s], o[nt]);
#pragma unroll
            for (int nt = 0; nt < 8; ++nt) o[nt] = o[nt] * qwb;
#pragma unroll
            for (int s = 0; s < 4; ++s) {
                const bf16x8 pf = frag_row(B1, lane, wave, s);
#pragma unroll
                for (int nt = 0; nt < 8; ++nt) o[nt] = MFMA16(frag_tr(B2, lane, nt, s), pf, o[nt]);
            }
            float sum = 0.f;
#pragma unroll
            for (int nt = 0; nt < 8; ++nt) sum += (o[nt][0] + o[nt][1]) + (o[nt][2] + o[nt][3]);
            sum += __shfl_xor(sum, 16); sum += __shfl_xor(sum, 32);
            const float mean = sum * (1.0f / 128.0f);
            float sq = 0.f;
#pragma unroll
            for (int nt = 0; nt < 8; ++nt) { o[nt] = o[nt] - mean; sq += (o[nt][0] * o[nt][0] + o[nt][1] * o[nt][1]) + (o[nt][2] * o[nt][2] + o[nt][3] * o[nt][3]); }
            sq += __shfl_xor(sq, 16); sq += __shfl_xor(sq, 32);
            const float rstd = 1.0f / sqrtf(sq * (1.0f / 128.0f) + GN_EPS);
            bf16* yrow = Y + (size_t)(t0 + l) * D + 512 + h * 128;
#pragma unroll
            for (int nt = 0; nt < 8; ++nt) {
                const int dv0 = 16 * nt + 4 * g;
                const f32x4 gn = *(const f32x4*)(gnw + h * 128 + dv0);
                const v2u gt2 = *(const v2u*)(grow + dv0);
                v2u w; w.x = pk2(o[nt][0] * rstd * gn[0] * bflo(gt2.x), o[nt][1] * rstd * gn[1] * bfhi(gt2.x));
                w.y = pk2(o[nt][2] * rstd * gn[2] * bflo(gt2.y), o[nt][3] * rstd * gn[3] * bfhi(gt2.y));
                *(v2u*)(yrow + dv0) = w;
            }
            __syncthreads();
        }
#undef P4_CK
#undef P4_ISSUE_QK
#undef LDG16
    }

#endif
    GRID_BAR(4);

    if constexpr (IN(5)) for (int rep_ = 0; rep_ < REP5; ++rep_) {
        PHASE_COORDS
        pg8::Gemm g{Y, WOUT, M, D, D}; pg8::StaticOrder S; S.init(M, D, G, bx);
        pg8::EpiResBf16 E{XB, Z, D, ALPHA};
        pg8::gemm_phase<pg8::EpiResBf16, pg8::StaticOrder, true, true>(lds, g, S, E);
    }

    GRID_BAR(5);

    if constexpr (IN(6)) for (int rep_ = 0; rep_ < REP6; ++rep_) {
        PHASE_COORDS
        const float* w = args.in[10]; const float* b = args.in[11];
        for (int tb = gw * 2; tb < M; tb += NGW * 2) {
            f32x4 v[2][4]; float s_[2], q_[2], mx_[2];
#pragma unroll
            for (int u = 0; u < 2; ++u) {
                const v2u* zr = (const v2u*)(Z + (size_t)(tb + u) * D) + lane;
#pragma unroll
                for (int j = 0; j < 4; ++j) { const v2u w_ = zr[64 * j]; v[u][j] = (f32x4){bflo(w_.x), bfhi(w_.x), bflo(w_.y), bfhi(w_.y)}; }
            }
#pragma unroll
            for (int u = 0; u < 2; ++u) { s_[u] = 0.f;
#pragma unroll
                for (int j = 0; j < 4; ++j) s_[u] += (v[u][j][0] + v[u][j][1]) + (v[u][j][2] + v[u][j][3]); }
            s_[0] = wave_sum(s_[0]); s_[1] = wave_sum(s_[1]);
#pragma unroll
            for (int u = 0; u < 2; ++u) { const float mean = s_[u] * (1.0f / D); q_[u] = 0.f;
#pragma unroll
                for (int j = 0; j < 4; ++j) { v[u][j] = v[u][j] - mean; q_[u] += (v[u][j][0] * v[u][j][0] + v[u][j][1] * v[u][j][1]) + (v[u][j][2] * v[u][j][2] + v[u][j][3] * v[u][j][3]); } }
            q_[0] = wave_sum(q_[0]); q_[1] = wave_sum(q_[1]);
#pragma unroll
            for (int u = 0; u < 2; ++u) {
                const float rstd = 1.0f / sqrtf(q_[u] * (1.0f / D) + LN_EPS);
                unsigned long long* o8 = (unsigned long long*)(H + (size_t)(tb + u) * D) + lane;
                mx_[u] = 0.f;
#pragma unroll
                for (int j = 0; j < 4; ++j) {
                    const f32x4 wv = *((const f32x4*)w + lane + 64 * j), bv = *((const f32x4*)b + lane + 64 * j);
                    const f32x4 y = v[u][j] * rstd * wv + bv;
                    o8[64 * j] = (unsigned long long)pk2(y[0], y[1]) | ((unsigned long long)pk2(y[2], y[3]) << 32);
                    v[u][j] = y;
                    mx_[u] = fmaxf(mx_[u], fmaxf(fmaxf(fabsf(y[0]), fabsf(y[1])), fmaxf(fabsf(y[2]), fabsf(y[3]))));
                }
            }
            mx_[0] = wave_max(mx_[0]); mx_[1] = wave_max(mx_[1]);
#pragma unroll
            for (int u = 0; u < 2; ++u) {
                const int t = tb + u;
                const float inv = mx_[u] > 0.f ? 127.0f / mx_[u] : 0.f;
#pragma unroll
                for (int j = 0; j < 4; ++j) {
                    const int q0 = (int)rintf(v[u][j][0] * inv), q1 = (int)rintf(v[u][j][1] * inv), q2 = (int)rintf(v[u][j][2] * inv), q3 = (int)rintf(v[u][j][3] * inv);
                    *(unsigned*)(H8 + ((size_t)(2 * j + (lane >> 5)) * M + t) * 128 + 4 * (lane & 31)) = (unsigned)(q0 & 0xff) | ((unsigned)(q1 & 0xff) << 8) | ((unsigned)(q2 & 0xff) << 16) | ((unsigned)(q3 & 0xff) << 24);
                }
                if (lane == 0) SH[t] = mx_[u] * (1.0f / 127.0f);
            }
        }
    }
    GRID_BAR(6);

    if constexpr (IN(7)) for (int rep_ = 0; rep_ < REP7; ++rep_) {
        PHASE_COORDS
        pg8::Gemm g{H, WQ, M, 2048, D}; pg8::StaticOrder S; S.init(M, 2048, G, bx);
        pg8::EpiPlainBf16 E{QP, 2048};
        pg8::gemm_phase<pg8::EpiPlainBf16, pg8::StaticOrder, true, true>(lds, g, S, E);
    }

    GRID_BAR(7);

#if NAIVE_P8
    if constexpr (IN(8)) for (int rep_ = 0; rep_ < REP8; ++rep_) {
        PHASE_COORDS
        const float* keys = args.in[13];
        LAS float* qs = sm;
        LAS float* sc = sm + 64 * 257;
        for (int unit = bx; unit < (M / 64) * PEER_H; unit += G) {
            const int tt0 = (unit >> 3) * 64, hd = unit & 7;
            for (int i = tid; i < 64 * 256; i += NTHREADS) { const int r = i >> 8, c = i & 255; qs[r * 257 + c] = bf2f(QP[(size_t)(tt0 + r) * 2048 + hd * 256 + c]); }
            __syncthreads();
            {
                const int tt = tid & 63, g8 = __builtin_amdgcn_readfirstlane(tid >> 6);
                for (int p = 0; p < 2; ++p) {
                    float acc[16];
#pragma unroll
                    for (int j = 0; j < 16; ++j) acc[j] = 0.f;
                    const float* kp = keys + ((size_t)(hd * 2 + p) * 128 + g8 * 16) * 128;
                    for (int d = 0; d < 128; ++d) {
                        const float qv = qs[tt * 257 + p * 128 + d];
#pragma unroll
                        for (int j = 0; j < 16; ++j) acc[j] += qv * kp[j * 128 + d];
                    }
#pragma unroll
                    for (int j = 0; j < 16; ++j) sc[tt * 257 + p * 128 + g8 * 16 + j] = acc[j];
                }
            }
            __syncthreads();
            LAS float* tops = qs;
            LAS int* topi = (LAS int*)(qs + 2048);
            LAS float* bsc = qs + 4096;
            LAS int* bps = (LAS int*)(qs + 5120);
            if (tid < 128) {
                const int tt = tid & 63, p = tid >> 6;
                LAS float* row = sc + tt * 257 + p * 128;
                for (int r = 0; r < 16; ++r) {
                    float best = -INFINITY; int bi = 0;
                    for (int n = 0; n < 128; ++n) { const float v = row[n]; if (v > best) { best = v; bi = n; } }
                    row[bi] = -INFINITY;
                    tops[(tt * 2 + p) * 16 + r] = best; topi[(tt * 2 + p) * 16 + r] = bi;
                }
            }
            __syncthreads();
            if (tid < 64) {
                const int tt = tid;
                LAS float* cand = sc + tt * 257;
                for (int a = 0; a < 16; ++a) for (int b = 0; b < 16; ++b) cand[a * 16 + b] = tops[(tt * 2) * 16 + a] + tops[(tt * 2 + 1) * 16 + b];
                float mx = -INFINITY;
                for (int r = 0; r < 16; ++r) {
                    float best = -INFINITY; int bi = 0;
                    for (int n = 0; n < 256; ++n) { const float v = cand[n]; if (v > best) { best = v; bi = n; } }
                    cand[bi] = -INFINITY;
                    bsc[tt * 16 + r] = best; bps[tt * 16 + r] = bi;
                    if (r == 0) mx = best;
                }
                float den = 0.f;
                for (int r = 0; r < 16; ++r) den += expf(bsc[tt * 16 + r] - mx);
                const float rden = 1.0f / den;
                for (int r = 0; r < 16; ++r) {
                    const int pos = bps[tt * 16 + r], a = pos >> 4, b = pos & 15;
                    const int e = topi[(tt * 2) * 16 + a] * 128 + topi[(tt * 2 + 1) * 16 + b];
                    IDX[(size_t)(tt0 + tt) * NSEL + hd * 16 + r] = (unsigned short)e;
                    GATE[(size_t)(tt0 + tt) * NSEL + hd * 16 + r] = expf(bsc[tt * 16 + r] - mx) * rden;
                }
            }
            __syncthreads();
        }
    }

#else
    if constexpr (IN(8)) for (int rep_ = 0; rep_ < REP8; ++rep_) {
        PHASE_COORDS
        LAS unsigned char* K0 = lds; LAS unsigned char* K1 = lds + 32768;
        const int g = lane >> 4, fr = lane & 15;
        int cur_hd = -1;
        bf16x8 qnext[2][4];
        {
            const int un = (bx < (M / 128) * PEER_H) ? bx : 0;
            const bf16* qp_ = QP + (size_t)((un >> 3) * 128 + 16 * wave + fr) * 2048 + (un & 7) * 256 + 8 * g;
#pragma unroll
            for (int p = 0; p < 2; ++p)
#pragma unroll
                for (int s = 0; s < 4; ++s) qnext[p][s] = *(const bf16x8*)(qp_ + p * 128 + 32 * s);
        }
        for (int unit = bx; unit < (M / 128) * PEER_H; unit += G) {
            const int hd = unit & 7, tile = unit >> 3;
            if (hd != cur_hd) {
                __syncthreads();
                stage_tile(K0, SKB + (size_t)(hd * 2 + 0) * 16384, 128, tid);
                stage_tile(K1, SKB + (size_t)(hd * 2 + 1) * 16384, 128, tid);
                __syncthreads();
                cur_hd = hd;
            }
            const int t = tile * 128 + 16 * wave + fr;
            bf16x8 qcur[2][4];
#pragma unroll
            for (int p = 0; p < 2; ++p)
#pragma unroll
                for (int s = 0; s < 4; ++s) qcur[p][s] = qnext[p][s];
            {
                const int un = (unit + G < (M / 128) * PEER_H) ? unit + G : unit;
                const bf16* qp_ = QP + (size_t)((un >> 3) * 128 + 16 * wave + fr) * 2048 + (un & 7) * 256 + 8 * g;
#pragma unroll
                for (int p = 0; p < 2; ++p)
#pragma unroll
                    for (int s = 0; s < 4; ++s) qnext[p][s] = *(const bf16x8*)(qp_ + p * 128 + 32 * s);
            }
            int T[2][16];
#pragma unroll
            for (int p = 0; p < 2; ++p) {
                const LAS unsigned char* KT = p ? K1 : K0;
                bf16x8 qf[4];
#pragma unroll
                for (int s = 0; s < 4; ++s) qf[s] = qcur[p][s];
                f32x4 acc[8];
#pragma unroll
                for (int nt = 0; nt < 8; ++nt) acc[nt] = (f32x4){0.f, 0.f, 0.f, 0.f};
#pragma unroll
                for (int nt = 0; nt < 8; ++nt)
#pragma unroll
                    for (int s = 0; s < 4; ++s) acc[nt] = MFMA16(frag_row(KT, lane, nt, s), qf[s], acc[nt]);
                int A[16], Bk[16];
#pragma unroll
                for (int nt = 0; nt < 4; ++nt)
#pragma unroll
                    for (int r = 0; r < 4; ++r) { A[nt * 4 + r] = f2key(acc[nt][r], 16 * nt + 4 * g + r); Bk[nt * 4 + r] = f2key(acc[nt + 4][r], 16 * (nt + 4) + 4 * g + r); }
                sort16_desc(A); sort16_desc(Bk);
#pragma unroll
                for (int i = 0; i < 16; ++i) A[i] = max(A[i], Bk[15 - i]);
                merge16_desc(A);
#pragma unroll
                for (int mask = 16; mask <= 32; mask <<= 1) {
                    int P[16];
#pragma unroll
                    for (int i = 0; i < 16; ++i) P[i] = __shfl_xor(A[15 - i], mask);
#pragma unroll
                    for (int i = 0; i < 16; ++i) A[i] = max(A[i], P[i]);
                    merge16_desc(A);
                }
#pragma unroll
                for (int i = 0; i < 16; ++i) T[p][i] = A[i];
            }
            float F0[16], F1[16];
#pragma unroll
            for (int i = 0; i < 16; ++i) { F0[i] = key2f(T[0][i]); F1[i] = key2f(T[1][i]); }
            int C[16];
#pragma unroll
            for (int j = 0; j < 16; ++j) {
                constexpr int a2[16] = {2, 2, 2, 2, 2, 3, 3, 3, 3, 4, 4, 4, 5, 5, 6, 6}, b2[16] = {0, 1, 2, 3, 4, 0, 1, 2, 3, 0, 1, 2, 0, 1, 0, 1};
                const int a1 = (j < 8) ? 1 : j, b1 = (j < 8) ? j : 0;
                const float s0 = F0[0] + F1[j], s1 = F0[a1] + F1[b1], s2 = F0[a2[j]] + F1[b2[j]];
                const int k0 = f2key(s0, j), k1 = f2key(s1, a1 * 16 + b1), k2 = f2key(s2, a2[j] * 16 + b2[j]);
                const int k3 = (j < 2) ? f2key(F0[7] + F1[j], 7 * 16 + j) : (int)0x80000000;
                C[j] = (g == 0) ? k0 : (g == 1) ? k1 : (g == 2) ? k2 : k3;
            }
            sort16_desc(C);
#pragma unroll
            for (int mask = 16; mask <= 32; mask <<= 1) {
                int P[16];
#pragma unroll
                for (int i = 0; i < 16; ++i) P[i] = __shfl_xor(C[15 - i], mask);
#pragma unroll
                for (int i = 0; i < 16; ++i) C[i] = max(C[i], P[i]);
                merge16_desc(C);
            }
            const float mx = key2f(C[0]);
            int kk[4];
#pragma unroll
            for (int k = 0; k < 4; ++k) kk[k] = (g == 0) ? C[k] : (g == 1) ? C[4 + k] : (g == 2) ? C[8 + k] : C[12 + k];
            unsigned pk0[4], pk1[4];
#pragma unroll
            for (int q = 0; q < 4; ++q) {
                pk0[q] = (unsigned)(T[0][4 * q] & 0x7F) | ((unsigned)(T[0][4 * q + 1] & 0x7F) << 8) | ((unsigned)(T[0][4 * q + 2] & 0x7F) << 16) | ((unsigned)(T[0][4 * q + 3] & 0x7F) << 24);
                pk1[q] = (unsigned)(T[1][4 * q] & 0x7F) | ((unsigned)(T[1][4 * q + 1] & 0x7F) << 8) | ((unsigned)(T[1][4 * q + 2] & 0x7F) << 16) | ((unsigned)(T[1][4 * q + 3] & 0x7F) << 24);
            }
            float ev[4]; int ex[4]; float part = 0.f;
#pragma unroll
            for (int k = 0; k < 4; ++k) {
                ev[k] = __expf(key2f(kk[k]) - mx); part += ev[k];
                const int a = (kk[k] >> 4) & 15, b = kk[k] & 15;
                const unsigned w0 = (a >> 2) == 0 ? pk0[0] : (a >> 2) == 1 ? pk0[1] : (a >> 2) == 2 ? pk0[2] : pk0[3];
                const unsigned w1 = (b >> 2) == 0 ? pk1[0] : (b >> 2) == 1 ? pk1[1] : (b >> 2) == 2 ? pk1[2] : pk1[3];
                ex[k] = (int)(((w0 >> (8 * (a & 3))) & 0xFFu) * 128u + ((w1 >> (8 * (b & 3))) & 0xFFu));
            }
            part += __shfl_xor(part, 16); part += __shfl_xor(part, 32);
            const float rden = 1.0f / part;
            *(v2u*)(IDX + (size_t)t * NSEL + hd * 16 + 4 * g) = (v2u){(unsigned)ex[0] | ((unsigned)ex[1] << 16), (unsigned)ex[2] | ((unsigned)ex[3] << 16)};
            *(f32x4*)(GATE + (size_t)t * NSEL + hd * 16 + 4 * g) = (f32x4){ev[0] * rden, ev[1] * rden, ev[2] * rden, ev[3] * rden};
        }
    }

#endif
    GRID_BAR(8);

    if constexpr (IN(9)) for (int rep_ = 0; rep_ < REP9; ++rep_) {
        PHASE_COORDS
        const bool fast = (G & 7) == 0;
        const int nq = fast ? (G >> 3) * NWAVES : NGW, q0 = fast ? (bx >> 3) * NWAVES + wave : gw;
        const long ntask = fast ? (long)M : 8L * M;
        const int c = lane & 7, pg = lane >> 3;
        for (long task = q0; task < ntask; task += nq) {
            const int t = fast ? (int)task : (int)(task >> 3), x = fast ? (bx & 7) : (int)(task & 7);
            const v4u* ip = (const v4u*)(IDX + (size_t)t * NSEL + 16 * pg);
            const v4u e0 = ip[0], e1 = ip[1];
            const unsigned ee[16] = {e0.x & 0xffffu, e0.x >> 16, e0.y & 0xffffu, e0.y >> 16, e0.z & 0xffffu, e0.z >> 16, e0.w & 0xffffu, e0.w >> 16,
                                     e1.x & 0xffffu, e1.x >> 16, e1.y & 0xffffu, e1.y >> 16, e1.z & 0xffffu, e1.z >> 16, e1.w & 0xffffu, e1.w >> 16};
            const v4u hq = *(const v4u*)(H8 + ((size_t)x * M + t) * 128 + 16 * c);
            const unsigned char* ub = U8 + (size_t)x * NEXP * 128 + 16 * c;
            v4u rows[16];
#pragma unroll
            for (int i = 0; i < 16; ++i) rows[i] = *(const v4u*)(ub + (size_t)ee[i] * 128);
            int acc[16];
#pragma unroll
            for (int i = 0; i < 16; ++i) {
                int a = __builtin_amdgcn_sdot4((int)rows[i].x, (int)hq.x, 0, false);
                a = __builtin_amdgcn_sdot4((int)rows[i].y, (int)hq.y, a, false);
                a = __builtin_amdgcn_sdot4((int)rows[i].z, (int)hq.z, a, false);
                a = __builtin_amdgcn_sdot4((int)rows[i].w, (int)hq.w, a, false);
                a += __builtin_amdgcn_update_dpp(0, a, 0xB1, 0xf, 0xf, false);
                a += __builtin_amdgcn_update_dpp(0, a, 0x4E, 0xf, 0xf, false);
                a += __builtin_amdgcn_update_dpp(0, a, 0x141, 0xf, 0xf, false);
                acc[i] = a;
            }
            if (c == 0) {
                v4u* op = (v4u*)(PDOT + ((size_t)x * M + t) * NSEL + 16 * pg);
                op[0] = (v4u){pk2((float)acc[0], (float)acc[1]), pk2((float)acc[2], (float)acc[3]), pk2((float)acc[4], (float)acc[5]), pk2((float)acc[6], (float)acc[7])};
                op[1] = (v4u){pk2((float)acc[8], (float)acc[9]), pk2((float)acc[10], (float)acc[11]), pk2((float)acc[12], (float)acc[13]), pk2((float)acc[14], (float)acc[15])};
            }
        }
    }
    GRID_BAR(9);

    if constexpr (IN(10)) for (int rep_ = 0; rep_ < REP10; ++rep_) {
        PHASE_COORDS
        for (int tb = gw * 4; tb < M; tb += NGW * 4) {
            int e_[4][2]; float sacc[4][2]; float gate_[4][2], sh_[4];
#pragma unroll
            for (int u = 0; u < 4; ++u) {
                const int t = tb + u; sh_[u] = SH[t];
#pragma unroll
                for (int k = 0; k < 2; ++k) {
                    const int j = 2 * lane + k;
                    e_[u][k] = (int)IDX[(size_t)t * NSEL + j]; gate_[u][k] = GATE[(size_t)t * NSEL + j];
                    float a = 0.f;
#pragma unroll
                    for (int x = 0; x < 8; ++x) a += bf2f(PDOT[((size_t)x * M + t) * NSEL + j]);
                    sacc[u][k] = a;
                }
            }
            float su_[4][2], sv_[4][2];
#pragma unroll
            for (int u = 0; u < 4; ++u)
#pragma unroll
                for (int k = 0; k < 2; ++k) { su_[u][k] = SU[e_[u][k]]; sv_[u][k] = SV[e_[u][k]]; }
            float cp[4][2], mx[4];
#pragma unroll
            for (int u = 0; u < 4; ++u) {
                mx[u] = 0.f;
#pragma unroll
                for (int k = 0; k < 2; ++k) { const float dot = su_[u][k] * sh_[u] * sacc[u][k]; cp[u][k] = gate_[u][k] * gelu_exact(dot) * sv_[u][k]; mx[u] = fmaxf(mx[u], fabsf(cp[u][k])); }
            }
#pragma unroll
            for (int u = 0; u < 4; ++u) mx[u] = wave_max(mx[u]);
            int qs[4];
#pragma unroll
            for (int u = 0; u < 4; ++u) {
                const int t = tb + u;
                const float inv = mx[u] > 0.f ? 32767.0f / mx[u] : 0.f;
                const int q0 = (int)rintf(cp[u][0] * inv), q1 = (int)rintf(cp[u][1] * inv);
                *(unsigned*)(CQ + (size_t)t * NSEL + 2 * lane) = ((unsigned)q0 & 0xffffu) | ((unsigned)q1 << 16);
                qs[u] = q0 + q1;
            }
#pragma unroll
            for (int u = 0; u < 4; ++u) qs[u] = wave_sum_i(qs[u]);
#pragma unroll
            for (int u = 0; u < 4; ++u) if (lane == u) { CS[2 * (tb + u)] = mx[u] * (1.0f / 32767.0f); CS[2 * (tb + u) + 1] = (float)qs[u]; }
        }
    }
    GRID_BAR(10);

    if constexpr (IN(11)) for (int rep_ = 0; rep_ < REP11; ++rep_) {
        PHASE_COORDS
        const bool fast = (G & 7) == 0;
        const int nq = fast ? (G >> 3) * NWAVES : NGW, q0 = fast ? (bx >> 3) * NWAVES + wave : gw;
        const long ntask = fast ? (long)M : 8L * M;
        const int c = lane & 7, pg = lane >> 3;
        const int d0 = 8 * ((lane >> 5) & 1) + 4 * ((lane >> 4) & 1) + 2 * ((lane >> 3) & 1);
        typedef short s16x2 __attribute__((ext_vector_type(2)));
        typedef float f32x2 __attribute__((ext_vector_type(2)));
        for (long task = q0; task < ntask; task += nq) {
            const int t = fast ? (int)task : (int)(task >> 3), x = fast ? (bx & 7) : (int)(task & 7);
            const v4u* ip = (const v4u*)(IDX + (size_t)t * NSEL + 16 * pg);
            const v4u e0 = ip[0], e1 = ip[1];
            const unsigned ee[16] = {e0.x & 0xffffu, e0.x >> 16, e0.y & 0xffffu, e0.y >> 16, e0.z & 0xffffu, e0.z >> 16, e0.w & 0xffffu, e0.w >> 16,
                                     e1.x & 0xffffu, e1.x >> 16, e1.y & 0xffffu, e1.y >> 16, e1.z & 0xffffu, e1.z >> 16, e1.w & 0xffffu, e1.w >> 16};
            const v4u* qp = (const v4u*)(CQ + (size_t)t * NSEL + 16 * pg);
            const v4u cq0 = qp[0], cq1 = qp[1];
            const unsigned cqp[8] = {cq0.x, cq0.y, cq0.z, cq0.w, cq1.x, cq1.y, cq1.z, cq1.w};
            const f32x2 cs2 = *(const f32x2*)(CS + 2 * (size_t)t);
            const int col = 128 * x + 16 * c + d0;
            const unsigned hw = *(const unsigned*)(H + (size_t)t * D + col);
            const unsigned char* vb = V8 + (size_t)x * NEXP * 128 + 16 * c;
            v4u rows[16];
#pragma unroll
            for (int i = 0; i < 16; ++i) rows[i] = *(const v4u*)(vb + (size_t)ee[i] * 128);
            int acc[16];
#pragma unroll
            for (int d = 0; d < 16; ++d) acc[d] = 0;
#pragma unroll
            for (int i = 0; i < 16; i += 2) {
                const unsigned ra[4] = {rows[i].x, rows[i].y, rows[i].z, rows[i].w}, rb[4] = {rows[i + 1].x, rows[i + 1].y, rows[i + 1].z, rows[i + 1].w};
                const s16x2 cpair = __builtin_bit_cast(s16x2, cqp[i >> 1]);
#pragma unroll
                for (int k = 0; k < 4; ++k) {
                    acc[4 * k + 0] = __builtin_amdgcn_sdot2(__builtin_bit_cast(s16x2, __builtin_amdgcn_perm(rb[k], ra[k], 0x0C040C00u)), cpair, acc[4 * k + 0], false);
                    acc[4 * k + 1] = __builtin_amdgcn_sdot2(__builtin_bit_cast(s16x2, __builtin_amdgcn_perm(rb[k], ra[k], 0x0C050C01u)), cpair, acc[4 * k + 1], false);
                    acc[4 * k + 2] = __builtin_amdgcn_sdot2(__builtin_bit_cast(s16x2, __builtin_amdgcn_perm(rb[k], ra[k], 0x0C060C02u)), cpair, acc[4 * k + 2], false);
                    acc[4 * k + 3] = __builtin_amdgcn_sdot2(__builtin_bit_cast(s16x2, __builtin_amdgcn_perm(rb[k], ra[k], 0x0C070C03u)), cpair, acc[4 * k + 3], false);
                }
            }
            int r8[8], r4[4], r2[2];
#pragma unroll
            for (int k = 0; k < 8; ++k) { const auto r_ = __builtin_amdgcn_permlane32_swap((unsigned)acc[k], (unsigned)acc[8 + k], false, false); r8[k] = (int)r_[0] + (int)r_[1]; }
#pragma unroll
            for (int k = 0; k < 4; ++k) { const auto r_ = __builtin_amdgcn_permlane16_swap((unsigned)r8[k], (unsigned)r8[4 + k], false, false); r4[k] = (int)r_[0] + (int)r_[1]; }
            {
                const bool hi = (lane & 8) != 0;
#pragma unroll
                for (int k = 0; k < 2; ++k) {
                    const int slo = r4[k] + __builtin_amdgcn_update_dpp(0, r4[k], 0x128, 0xf, 0xf, false), shi = r4[2 + k] + __builtin_amdgcn_update_dpp(0, r4[2 + k], 0x128, 0xf, 0xf, false);
                    r2[k] = hi ? shi : slo;
                }
            }
            const float off = 128.0f * cs2[1];
            *(unsigned*)(ZB + (size_t)t * D + col) = pk2(ALPHA * bflo(hw) + cs2[0] * ((float)r2[0] - off), ALPHA * bfhi(hw) + cs2[0] * ((float)r2[1] - off));
        }
    }
    GRID_BAR(11);

    if constexpr (IN(12)) for (int rep_ = 0; rep_ < REP12; ++rep_) {
        PHASE_COORDS
        const float* w = args.in[16]; const float* b = args.in[17];
        for (int tb = gw * 2; tb < M; tb += NGW * 2) {
            f32x4 v[2][4]; float s_[2], q_[2];
#pragma unroll
            for (int u = 0; u < 2; ++u) {
                const v2u* zr = (const v2u*)(ZB + (size_t)(tb + u) * D) + lane;
#pragma unroll
                for (int j = 0; j < 4; ++j) { const v2u w_ = zr[64 * j]; v[u][j] = (f32x4){bflo(w_.x), bfhi(w_.x), bflo(w_.y), bfhi(w_.y)}; }
            }
#pragma unroll
            for (int u = 0; u < 2; ++u) { s_[u] = 0.f;
#pragma unroll
                for (int j = 0; j < 4; ++j) s_[u] += (v[u][j][0] + v[u][j][1]) + (v[u][j][2] + v[u][j][3]); }
            s_[0] = wave_sum(s_[0]); s_[1] = wave_sum(s_[1]);
#pragma unroll
            for (int u = 0; u < 2; ++u) { const float mean = s_[u] * (1.0f / D); q_[u] = 0.f;
#pragma unroll
                for (int j = 0; j < 4; ++j) { v[u][j] = v[u][j] - mean; q_[u] += (v[u][j][0] * v[u][j][0] + v[u][j][1] * v[u][j][1]) + (v[u][j][2] * v[u][j][2] + v[u][j][3] * v[u][j][3]); } }
            q_[0] = wave_sum(q_[0]); q_[1] = wave_sum(q_[1]);
#pragma unroll
            for (int u = 0; u < 2; ++u) {
                const float rstd = 1.0f / sqrtf(q_[u] * (1.0f / D) + LN_EPS);
                f32x4* zo = (f32x4*)(args.out + (size_t)(tb + u) * D) + lane;
#pragma unroll
                for (int j = 0; j < 4; ++j) {
                    const f32x4 wv = *((const f32x4*)w + lane + 64 * j), bv = *((const f32x4*)b + lane + 64 * j);
                    zo[64 * j] = v[u][j] * rstd * wv + bv;
                }
            }
        }
    }
#undef IN
#undef BOTH
#undef GRID_BAR
}

extern "C" void kernel_launch(void* const* d_in, const int* in_sizes, int n_in, void* d_out, int out_size, void* d_ws, size_t ws_size, hipStream_t stream) {
    static int grid = 0;
    if (grid == 0) {
        if (n_in != 18 || in_sizes[0] != M * D || out_size != M * D || ws_size < WS_END) {
            fprintf(stderr, "kernel_launch: unexpected shapes: n_in %d in0 %d out %d ws %zu\n", n_in, n_in > 0 ? in_sizes[0] : -1, out_size, ws_size); grid = -1; return; }
        int dev = 0, cus = 0;
        if (hipGetDevice(&dev) != hipSuccess || hipDeviceGetAttribute(&cus, hipDeviceAttributeMultiprocessorCount, dev) != hipSuccess) { grid = -1; return; }
        bool ok = true;
#if N_LAUNCHES == 1
        ok = (hipFuncSetAttribute((const void*)fwd_kernel<0, 13>, hipFuncAttributeMaxDynamicSharedMemorySize, LDS_BYTES) == hipSuccess);
#else
#define SETATTR(k) ok = ok && (hipFuncSetAttribute((const void*)fwd_kernel<k, k + 1>, hipFuncAttributeMaxDynamicSharedMemorySize, LDS_BYTES) == hipSuccess)
        SETATTR(0); SETATTR(1); SETATTR(2); SETATTR(3); SETATTR(4); SETATTR(5); SETATTR(6); SETATTR(7); SETATTR(8); SETATTR(9); SETATTR(10); SETATTR(11); SETATTR(12);
#undef SETATTR
#endif
        if (!ok) { fprintf(stderr, "kernel_launch: hipFuncSetAttribute failed\n"); grid = -1; return; }
        grid = cus;
    }
    if (grid < 0) return;
    (void)hipMemsetAsync((char*)d_ws + WS_CTL, 0, CTL_ZERO_BYTES, stream);
    Args a{};
    for (int i = 0; i < 18; ++i) a.in[i] = (const float*)d_in[i];
    a.out = (float*)d_out; a.ws = (unsigned char*)d_ws;
    a.ph_lo = 0; a.ph_hi = 10;
#if N_LAUNCHES == 1
    hipLaunchKernelGGL((fwd_kernel<0, 13>), dim3(grid), dim3(NTHREADS), LDS_BYTES, stream, a);
#else
#define LAUNCH(k) hipLaunchKernelGGL((fwd_kernel<k, k + 1>), dim3(grid), dim3(NTHREADS), LDS_BYTES, stream, a)
    LAUNCH(0); LAUNCH(1); LAUNCH(2); LAUNCH(3); LAUNCH(4); LAUNCH(5); LAUNCH(6); LAUNCH(7); LAUNCH(8); LAUNCH(9); LAUNCH(10); LAUNCH(11); LAUNCH(12);
#undef LAUNCH
#endif
}
```
